# Optimizing an MI355X kernel written in HIP

```python
import math
import jax
import jax.numpy as jnp
from jax import lax
import numpy as np

D_MODEL = 1024
BATCH = 32
SEQ = 256
DEPTH = 2
DEC_BATCH = 2
DEC_SEQ = 1024
PAST_LEN = 256

GRID_W = 64
POOL_WINDOWS = (2, 4, 8, 16)
POOL_GROUPS = 4
POOL_CH = D_MODEL // 16
POOL_WIDTH = POOL_GROUPS * POOL_CH
FNET_HEADS = 4
FNET_CH = D_MODEL // 16
FNET_WIDTH = FNET_HEADS * FNET_CH
ATTN_HEADS = 4
QK_DIM = D_MODEL // 16
V_DIM = 2 * QK_DIM
Q_WIDTH = ATTN_HEADS * 2 * QK_DIM
ATTN_WIDTH = ATTN_HEADS * V_DIM
IN_WIDTH = POOL_WIDTH + FNET_WIDTH + 2 * Q_WIDTH + ATTN_WIDTH
MIX_WIDTH = POOL_WIDTH + FNET_WIDTH + ATTN_WIDTH
IN_SPLITS = (POOL_WIDTH, POOL_WIDTH + FNET_WIDTH, POOL_WIDTH + FNET_WIDTH + Q_WIDTH, POOL_WIDTH + FNET_WIDTH + 2 * Q_WIDTH)
D_FF = 2816
N_MOD = 9
ROPE_BASE = 10000.0
ROPE_AXIS_DIM = QK_DIM // 2
Q_BLOCK = 128
ATTN_SCALE = QK_DIM ** -0.5
EPS = 1e-6

kernel_name = 'hybrid_pool_fourier_diffattn_prefix_step'


def rmsnorm(x, g):
    xf = x.astype(jnp.float32)
    y = xf * lax.rsqrt(jnp.mean(xf * xf, axis=-1, keepdims=True) + EPS)
    return (y * g.astype(jnp.float32)).astype(x.dtype)


def adaln_params(cond, ada_w, ada_b):
    m = jax.nn.silu(cond) @ ada_w + ada_b
    return m.reshape(cond.shape[:-1] + (N_MOD, D_MODEL))


def mod_norm(x, g, mod, s):
    return rmsnorm(x, g) * (1 + mod[..., 3 * s + 1, :]) + mod[..., 3 * s, :]


def swiglu(h, wi, wo):
    a, b = jnp.split(h @ wi, 2, axis=-1)
    return (jax.nn.silu(a) * b) @ wo


def multiscale_pool(p, pool_w, pool_scale):
    B, L, _ = p.shape
    pf = p.reshape(B, L, POOL_GROUPS, POOL_CH).astype(jnp.float32)
    cs = jnp.concatenate([jnp.zeros_like(pf[:, :1]), jnp.cumsum(pf, axis=1)], axis=1)
    t = np.arange(L)
    outs = []
    for g, w in enumerate(POOL_WINDOWS):
        lo = np.clip(t - w // 2, 0, L)
        hi = np.clip(t + w // 2, 0, L)
        cnt = (hi - lo).astype(np.float32)
        mean = (cs[:, hi, g] - cs[:, lo, g]) / cnt[None, :, None]
        outs.append(mean - pf[:, :, g])
    d = jnp.stack(outs, axis=2).astype(p.dtype)
    y = jnp.einsum('blgc,gcd->blgd', d, pool_w).reshape(B, L, POOL_WIDTH)
    return y * pool_scale


def fourier_mix(f, fnet_w):
    B, L, _ = f.shape
    fg = f.reshape(B, L, FNET_HEADS, FNET_CH).astype(jnp.float32)
    z = jnp.fft.fft2(fg, axes=(1, 3), norm='ortho').real.astype(f.dtype)
    return jnp.einsum('blgc,gcd->blgd', z, fnet_w).reshape(B, L, FNET_WIDTH)


def axial_rope_tables(L):
    rows = L // GRID_W
    row = jnp.repeat(jnp.arange(rows, dtype=jnp.float32), GRID_W)
    col = jnp.tile(jnp.arange(GRID_W, dtype=jnp.float32), rows)
    inv = 1.0 / (ROPE_BASE ** (jnp.arange(0, ROPE_AXIS_DIM, 2, dtype=jnp.float32) / ROPE_AXIS_DIM))
    ang_r = row[:, None] * inv[None, :]
    ang_c = col[:, None] * inv[None, :]
    return (jnp.cos(ang_r), jnp.sin(ang_r), jnp.cos(ang_c), jnp.sin(ang_c))


def _rotate(x, cos, sin):
    cos = cos[:, None, None, :]
    sin = sin[:, None, None, :]
    x1, x2 = jnp.split(x, 2, axis=-1)
    return jnp.concatenate([x1 * cos - x2 * sin, x2 * cos + x1 * sin], axis=-1)


def apply_axial_rope(x, tables):
    cos_r, sin_r, cos_c, sin_c = tables
    xf = x.astype(jnp.float32)
    xr = _rotate(xf[..., :ROPE_AXIS_DIM], cos_r, sin_r)
    xc = _rotate(xf[..., ROPE_AXIS_DIM:], cos_c, sin_c)
    return jnp.concatenate([xr, xc], axis=-1).astype(x.dtype)


def diff_attention(q, k, v, lam):
    B, Lq = q.shape[0], q.shape[1]
    nb = Lq // Q_BLOCK
    qb = jnp.moveaxis(q.reshape((B, nb, Q_BLOCK) + q.shape[2:]), 1, 0)

    def one_block(qblk):
        s = jnp.einsum('bqhcd,bkhcd->bchqk', qblk, k, preferred_element_type=jnp.float32) * ATTN_SCALE
        p = jax.nn.softmax(s, axis=-1)
        w = p[:, 0] - lam * p[:, 1]
        return jnp.einsum('bhqk,bkhd->bqhd', w.astype(v.dtype), v)

    o = lax.map(one_block, qb)
    return jnp.moveaxis(o, 0, 1).reshape((B, Lq) + v.shape[2:])


def token_mix(h, ctx_k, ctx_v, lam, lam_init, w_in, w_out, q_norm_g, k_norm_g, attn_out_g, pool_w, pool_scale, fnet_w):
    B, L, _ = h.shape
    u = h @ w_in
    p, f, q, k, v = jnp.split(u, IN_SPLITS, axis=-1)
    q = rmsnorm(q.reshape(B, L, ATTN_HEADS, 2, QK_DIM), q_norm_g)
    k = rmsnorm(k.reshape(B, L, ATTN_HEADS, 2, QK_DIM), k_norm_g)
    v = v.reshape(B, L, ATTN_HEADS, V_DIM)
    if ctx_k is None:
        o = diff_attention(q, k, v, lam)
    else:
        tables = axial_rope_tables(L)
        q = apply_axial_rope(q, tables)
        k = apply_axial_rope(k, tables)
        ck = ctx_k.reshape(ctx_k.shape[:3] + (2, QK_DIM)).astype(k.dtype)
        k_all = jnp.concatenate([ck, k], axis=1)
        v_all = jnp.concatenate([ctx_v.astype(v.dtype), v], axis=1)
        o = diff_attention(q, k_all, v_all, lam)
    o = rmsnorm(o, attn_out_g) * (1.0 - lam_init)
    mixed = jnp.concatenate([multiscale_pool(p, pool_w, pool_scale), fourier_mix(f, fnet_w), o.reshape(B, L, ATTN_WIDTH)], axis=-1)
    return mixed @ w_out, k.reshape(B, L, ATTN_HEADS, 2 * QK_DIM), v


def trunk_layer(x, mod, ctx_k, ctx_v, lam, lam_init, norm_g, ffn1_wi, ffn1_wo, ffn2_wi, ffn2_wo, w_in, w_out, q_norm_g, k_norm_g, attn_out_g, pool_w, pool_scale, fnet_w):
    h = mod_norm(x, norm_g[0], mod, 0)
    x = x + 0.5 * mod[..., 2, :] * swiglu(h, ffn1_wi, ffn1_wo)
    h = mod_norm(x, norm_g[1], mod, 1)
    y, k, v = token_mix(h, ctx_k, ctx_v, lam, lam_init, w_in, w_out, q_norm_g, k_norm_g, attn_out_g, pool_w, pool_scale, fnet_w)
    x = x + mod[..., 5, :] * y
    h = mod_norm(x, norm_g[2], mod, 2)
    x = x + 0.5 * mod[..., 8, :] * swiglu(h, ffn2_wi, ffn2_wo)
    return x, k, v


def setup_inputs(seed: int = 0) -> dict:
    key = jax.random.key(seed)
    ks = jax.random.split(key, 25)

    def nrm(i, shape, s):
        return jax.random.normal(ks[i], shape, jnp.float32) * s

    return {
        'x_prompt': nrm(0, (BATCH, SEQ, D_MODEL), 1.0),
        'x_sample': nrm(1, (DEC_BATCH, DEC_SEQ, D_MODEL), 1.0),
        'cache_k': nrm(2, (DEC_BATCH, DEPTH, PAST_LEN, ATTN_HEADS, 2 * QK_DIM), 1.0),
        'cache_v': nrm(3, (DEC_BATCH, DEPTH, PAST_LEN, ATTN_HEADS, V_DIM), 1.0),
        'c': nrm(4, (DEC_BATCH, D_MODEL), 1.0),
        'c_ctx': nrm(5, (D_MODEL,), 1.0),
        'norm_g': 1.0 + nrm(6, (DEPTH, 3, D_MODEL), 0.1),
        'ada_w': nrm(7, (DEPTH, D_MODEL, N_MOD * D_MODEL), 0.5 * D_MODEL ** -0.5),
        'ada_b': nrm(8, (DEPTH, N_MOD * D_MODEL), 0.02),
        'ffn1_wi': nrm(9, (DEPTH, D_MODEL, 2 * D_FF), D_MODEL ** -0.5),
        'ffn1_wo': nrm(10, (DEPTH, D_FF, D_MODEL), D_FF ** -0.5),
        'ffn2_wi': nrm(11, (DEPTH, D_MODEL, 2 * D_FF), D_MODEL ** -0.5),
        'ffn2_wo': nrm(12, (DEPTH, D_FF, D_MODEL), D_FF ** -0.5),
        'w_in': nrm(13, (DEPTH, D_MODEL, IN_WIDTH), D_MODEL ** -0.5),
        'w_out': nrm(14, (DEPTH, MIX_WIDTH, D_MODEL), MIX_WIDTH ** -0.5),
        'q_norm_g': 1.0 + nrm(15, (DEPTH, QK_DIM), 0.1),
        'k_norm_g': 1.0 + nrm(16, (DEPTH, QK_DIM), 0.1),
        'lam_q1': nrm(17, (DEPTH, QK_DIM), 0.1),
        'lam_k1': nrm(18, (DEPTH, QK_DIM), 0.1),
        'lam_q2': nrm(19, (DEPTH, QK_DIM), 0.1),
        'lam_k2': nrm(20, (DEPTH, QK_DIM), 0.1),
        'attn_out_g': 1.0 + nrm(21, (DEPTH, V_DIM), 0.1),
        'pool_w': nrm(22, (DEPTH, POOL_GROUPS, POOL_CH, POOL_CH), POOL_CH ** -0.5),
        'pool_scale': 1.0 + nrm(23, (DEPTH, POOL_WIDTH), 0.1),
        'fnet_w': nrm(24, (DEPTH, FNET_HEADS, FNET_CH, FNET_CH), FNET_CH ** -0.5),
    }


def reference(x_prompt, x_sample, cache_k, cache_v, c, c_ctx, norm_g, ada_w, ada_b, ffn1_wi, ffn1_wo, ffn2_wi, ffn2_wo, w_in, w_out, q_norm_g, k_norm_g, lam_q1, lam_k1, lam_q2, lam_k2, attn_out_g, pool_w, pool_scale, fnet_w):
    xp = x_prompt
    xs = x_sample
    ks_new = []
    vs_new = []
    for l in range(DEPTH):
        lam_init = 0.8 - 0.6 * math.exp(-0.3 * l)
        lam = (jnp.exp(jnp.sum(lam_q1[l].astype(jnp.float32) * lam_k1[l].astype(jnp.float32)))
               - jnp.exp(jnp.sum(lam_q2[l].astype(jnp.float32) * lam_k2[l].astype(jnp.float32))) + lam_init)
        lw = (norm_g[l], ffn1_wi[l], ffn1_wo[l], ffn2_wi[l], ffn2_wo[l], w_in[l], w_out[l],
              q_norm_g[l], k_norm_g[l], attn_out_g[l], pool_w[l], pool_scale[l], fnet_w[l])
        mod_ctx = adaln_params(c_ctx, ada_w[l], ada_b[l])
        mod_lat = adaln_params(c, ada_w[l], ada_b[l])[:, None]
        xp, k_l, v_l = trunk_layer(xp, mod_ctx, None, None, lam, lam_init, *lw)
        ks_new.append(k_l)
        vs_new.append(v_l)
        xs, _, _ = trunk_layer(xs, mod_lat, cache_k[:, l], cache_v[:, l], lam, lam_init, *lw)
    new_cache_k = jnp.stack(ks_new, axis=1)
    new_cache_v = jnp.stack(vs_new, axis=1)
    return (xp, xs, new_cache_k, new_cache_v)
```

```cpp
#include <hip/hip_runtime.h>
#include <cstdio>
#include <cstdint>
namespace pg8 {
#define PG8_LAS __attribute__((address_space(3)))
typedef unsigned short bf16_t;
typedef short bf16x8 __attribute__((ext_vector_type(8)));
typedef float f32x4 __attribute__((ext_vector_type(4)));
typedef unsigned u32x4 __attribute__((ext_vector_type(4)));
constexpr int BM = 256, BK = 64, HALF = 128, HTB = HALF * BK * 2  , STAGE_BYTES = 8 * HTB, NXCD = 8, WGM = 8;

__host__ __device__ __forceinline__ int lds_byte(int r, int c) { const int st = (r >> 4) * 2 + (c >> 5), rr = r & 15, cc = c & 31, ob = rr * 64 + cc * 2; return st * 1024 + (ob ^ (((ob >> 9) & 1) << 5)); }
__host__ __device__ __forceinline__ void stage_rc(int b, int& R, int& C) { const int st = b / 1024, sb = b % 1024, swz = sb ^ (((sb >> 9) & 1) << 5); R = (st >> 1) * 16 + swz / 64; C = (st & 1) * 32 + (swz % 64) / 2; }
__host__ __device__ __forceinline__ int perm32(int rho) { const int n = rho >> 4, i = rho & 15; return 8 * (i >> 2) + 4 * n + (i & 3); }

struct Unit { int pm, pn; };
struct Gemm { const bf16_t* A; const bf16_t* Bt; int M, N, K; };

struct StaticOrder {
    int nM, nN, nwg, G, c;
    __host__ __device__ void init(int M, int N, int G_, int c_) { nM = M / BM; nN = N / BM; nwg = nM * nN; G = G_; c = c_; }
    __host__ __device__ bool next(int i, Unit& u) const {
        const long L = (long)i * G + c; if (L >= nwg) return false;
        int wgid = (int)L; { const int q = nwg / NXCD, r = nwg % NXCD, xcd = wgid % NXCD, off = wgid / NXCD; wgid = (xcd < r ? xcd * (q + 1) : r * (q + 1) + (xcd - r) * q) + off; }
        const int nig = WGM * nN, gid = wgid / nig, fm = gid * WGM, gsz = (nM - fm) < WGM ? (nM - fm) : WGM;
        u.pm = fm + ((wgid % nig) % gsz); u.pn = (wgid % nig) / gsz; return true;
    }
    __device__ __forceinline__ void a_ready(const Unit&) const {}
    __device__ __forceinline__ void done(const Unit&) const {}
};

__device__ __forceinline__ unsigned cvt_pk_bf16(float lo, float hi) { unsigned r; asm volatile("v_cvt_pk_bf16_f32 %0, %1, %2" : "=v"(r) : "v"(lo), "v"(hi)); return r; }
typedef float f32x2 __attribute__((ext_vector_type(2)));
template <class Epi, class Sched, bool ALIGN_EPI = false, bool SP2 = false>
__device__ __forceinline__ void gemm_phase(PG8_LAS unsigned char* lds, const Gemm g, const Sched& S, const Epi& E) {
    const int tid = threadIdx.x, wid = __builtin_amdgcn_readfirstlane(tid >> 6), lane = tid & 63, wr = wid >> 2, wc = wid & 3, fr = lane & 15, fq = lane >> 4;
    const int K = g.K, nt = K / BK;
    unsigned voffA[2], voffB[2];
#pragma unroll
    for (int i = 0; i < 2; ++i) { int R, C; stage_rc(tid * 16 + i * 8192, R, C); const int Rb = Epi::PERM ? ((R & ~31) + perm32(R & 31)) : R;
        voffA[i] = (unsigned)(R * K + C) * 2u; voffB[i] = (unsigned)(Rb * K + C) * 2u; }
    const size_t kstep = (size_t)(BK * 2);
    const size_t hstep = (size_t)HALF * K * 2;
    const size_t tstep = 2 * hstep;
    const unsigned ldsw = (unsigned)wid * 1024u;
    const int aoff = lds_byte(wr * 64 + fr, fq * 8), boff = lds_byte(wc * 32 + fr, fq * 8);
#define PG8_SA(b, h) (((b) * 2 + (h)) * HTB)
#define PG8_SB(b, h) ((4 + (b) * 2 + (h)) * HTB)
#define PG8_STAGE(bufoff, gbase, voff) do { _Pragma("unroll") for (int _i = 0; _i < 2; ++_i) \
        __builtin_amdgcn_global_load_lds((const unsigned*)((const char*)(gbase) + (voff)[_i]), (PG8_LAS unsigned*)(lds + (bufoff) + ldsw + _i * 8192), 16, 0, 0); } while (0)
#define PG8_LDA(dst, b, h) do { _Pragma("unroll") for (int m = 0; m < 4; ++m) _Pragma("unroll") for (int k = 0; k < 2; ++k) dst[m][k] = *(const PG8_LAS bf16x8*)(lds + PG8_SA(b, h) + aoff + m * 2048 + k * 1024); } while (0)
#define PG8_LDB(dst, b, h) do { _Pragma("unroll") for (int n = 0; n < 2; ++n) _Pragma("unroll") for (int k = 0; k < 2; ++k) dst[n][k] = *(const PG8_LAS bf16x8*)(lds + PG8_SB(b, h) + boff + n * 2048 + k * 1024); } while (0)
#define PG8_MMA(ai, bj, At, Bt) do { __builtin_amdgcn_s_setprio(1); _Pragma("unroll") for (int m = 0; m < 4; ++m) _Pragma("unroll") for (int n = 0; n < 2; ++n) _Pragma("unroll") for (int k = 0; k < 2; ++k) \
        acc[ai][bj][m][n] = __builtin_amdgcn_mfma_f32_16x16x32_bf16(Bt[n][k], At[m][k], acc[ai][bj][m][n], 0, 0, 0); __builtin_amdgcn_s_setprio(0); } while (0)
#define PG8_WAIT_V(n) asm volatile("s_waitcnt vmcnt(" #n ")" ::: "memory")
#define PG8_WAIT_L(n) asm volatile("s_waitcnt lgkmcnt(" #n ")" ::: "memory")
#define PG8_BAR __builtin_amdgcn_s_barrier()
#define PG8_SCHED __builtin_amdgcn_sched_barrier(0)
    Unit cur, nxt; int ui = 0;
    if (!S.next(0, cur)) return;
    f32x4 acc[2][2][4][2];
#pragma unroll
    for (int a = 0; a < 2; ++a)
#pragma unroll
        for (int b = 0; b < 2; ++b)
#pragma unroll
            for (int m = 0; m < 4; ++m)
#pragma unroll
                for (int n = 0; n < 2; ++n) acc[a][b][m][n] = (f32x4){0.f, 0.f, 0.f, 0.f};
    bf16x8 At[4][2], B0[2][2], B1[2][2];
    const char* cA = (const char*)g.A + (size_t)cur.pm * tstep; const char* cB = (const char*)g.Bt + (size_t)cur.pn * tstep;
    S.a_ready(cur);
    if constexpr (SP2) {
        PG8_STAGE(PG8_SB(0, 0), cB, voffB); PG8_STAGE(PG8_SB(0, 1), cB + hstep, voffB); PG8_STAGE(PG8_SA(0, 0), cA, voffA); PG8_STAGE(PG8_SA(0, 1), cA + hstep, voffA);
        if (wr == 1) PG8_BAR;
        PG8_WAIT_V(2); PG8_BAR;
        PG8_STAGE(PG8_SB(1, 0), cB + kstep, voffB); PG8_STAGE(PG8_SA(1, 0), cA + kstep, voffA); PG8_STAGE(PG8_SB(1, 1), cB + hstep + kstep, voffB);
        PG8_WAIT_V(6); PG8_BAR;
    } else {
        PG8_STAGE(PG8_SB(0, 0), cB, voffB); PG8_STAGE(PG8_SA(0, 0), cA, voffA); PG8_STAGE(PG8_SB(0, 1), cB + hstep, voffB); PG8_STAGE(PG8_SA(0, 1), cA + hstep, voffA);
        if (wr == 1) PG8_BAR;
        PG8_WAIT_V(4); PG8_BAR;
        PG8_STAGE(PG8_SB(1, 0), cB + kstep, voffB); PG8_STAGE(PG8_SA(1, 0), cA + kstep, voffA); PG8_STAGE(PG8_SB(1, 1), cB + hstep + kstep, voffB);
        PG8_WAIT_V(6); PG8_BAR;
    }
    for (;;) {
        const bool has_next = S.next(ui + 1, nxt);
        const char* nA = has_next ? (const char*)g.A + (size_t)nxt.pm * tstep : cA; const char* nB = has_next ? (const char*)g.Bt + (size_t)nxt.pn * tstep : cB;
        for (int t = 0; t < nt; t += 2) {
            const bool last = (t == nt - 2);
            const char* a1 = cA + (size_t)(t + 1) * kstep;
            const char* a2 = last ? nA : cA + (size_t)(t + 2) * kstep; const char* b2 = last ? nB : cB + (size_t)(t + 2) * kstep;
            const char* a3 = a2 + kstep; const char* b3 = b2 + kstep;
            if (last && has_next) S.a_ready(nxt);
            if constexpr (SP2) {
            PG8_LDB(B0, 0, 0); PG8_LDB(B1, 0, 1); PG8_SCHED; PG8_LDA(At, 0, 0); PG8_STAGE(PG8_SA(1, 1), a1 + hstep, voffA);
            PG8_WAIT_V(8); PG8_WAIT_L(0); PG8_BAR; PG8_MMA(0, 0, At, B0); PG8_MMA(0, 1, At, B1); PG8_BAR; PG8_SCHED;
            PG8_LDA(At, 0, 1); PG8_STAGE(PG8_SB(0, 0), b2, voffB); PG8_STAGE(PG8_SB(0, 1), b2 + hstep, voffB); PG8_STAGE(PG8_SA(0, 0), a2, voffA);
            PG8_WAIT_V(8); PG8_WAIT_L(0); PG8_BAR; PG8_MMA(1, 0, At, B0); PG8_MMA(1, 1, At, B1); PG8_BAR; PG8_SCHED;
            PG8_LDB(B0, 1, 0); PG8_LDB(B1, 1, 1); PG8_SCHED; PG8_LDA(At, 1, 0); PG8_STAGE(PG8_SA(0, 1), a2 + hstep, voffA);
            PG8_WAIT_V(8); PG8_WAIT_L(0); PG8_BAR; PG8_MMA(0, 0, At, B0); PG8_MMA(0, 1, At, B1); PG8_BAR; PG8_SCHED;
            PG8_LDA(At, 1, 1); PG8_STAGE(PG8_SB(1, 0), b3, voffB); PG8_STAGE(PG8_SB(1, 1), b3 + hstep, voffB); PG8_STAGE(PG8_SA(1, 0), a3, voffA);
            PG8_WAIT_V(8); PG8_WAIT_L(0); PG8_BAR; PG8_MMA(1, 0, At, B0); PG8_MMA(1, 1, At, B1); PG8_BAR; PG8_SCHED;
            } else {
            PG8_LDB(B0, 0, 0); PG8_SCHED; PG8_LDA(At, 0, 0); PG8_STAGE(PG8_SA(1, 1), a1 + hstep, voffA);
            PG8_WAIT_L(8); PG8_BAR; PG8_WAIT_L(0); PG8_MMA(0, 0, At, B0); PG8_BAR; PG8_SCHED;
            PG8_LDB(B1, 0, 1); PG8_STAGE(PG8_SB(0, 0), b2, voffB);
            PG8_BAR; PG8_WAIT_L(0); PG8_MMA(0, 1, At, B1); PG8_BAR;
            PG8_LDA(At, 0, 1); PG8_STAGE(PG8_SA(0, 0), a2, voffA);
            PG8_BAR; PG8_WAIT_L(0); PG8_MMA(1, 0, At, B0); PG8_BAR; PG8_SCHED;
            PG8_STAGE(PG8_SB(0, 1), b2 + hstep, voffB);
            PG8_WAIT_V(6); PG8_BAR; PG8_MMA(1, 1, At, B1); PG8_BAR;
            PG8_LDB(B0, 1, 0); PG8_SCHED; PG8_LDA(At, 1, 0); PG8_STAGE(PG8_SA(0, 1), a2 + hstep, voffA);
            PG8_WAIT_L(8); PG8_BAR; PG8_WAIT_L(0); PG8_MMA(0, 0, At, B0); PG8_BAR; PG8_SCHED;
            PG8_LDB(B1, 1, 1); PG8_STAGE(PG8_SB(1, 0), b3, voffB);
            PG8_BAR; PG8_WAIT_L(0); PG8_MMA(0, 1, At, B1); PG8_BAR;
            PG8_LDA(At, 1, 1); PG8_STAGE(PG8_SA(1, 0), a3, voffA);
            PG8_BAR; PG8_WAIT_L(0); PG8_MMA(1, 0, At, B0); PG8_BAR; PG8_SCHED;
            PG8_STAGE(PG8_SB(1, 1), b3 + hstep, voffB);
            PG8_WAIT_V(6); PG8_BAR; PG8_MMA(1, 1, At, B1); PG8_BAR;
            }
        }
        if constexpr (ALIGN_EPI) { if (wr == 0) PG8_BAR; }
        if constexpr (!Epi::AFTER_DRAIN) { E(acc, cur, wr, wc, fr, fq); S.done(cur); }
        if (!has_next) break;
#pragma unroll
        for (int a = 0; a < 2; ++a)
#pragma unroll
            for (int b = 0; b < 2; ++b)
#pragma unroll
                for (int m = 0; m < 4; ++m)
#pragma unroll
                    for (int n = 0; n < 2; ++n) acc[a][b][m][n] = (f32x4){0.f, 0.f, 0.f, 0.f};
        cur = nxt; cA = nA; cB = nB; ++ui;
        if constexpr (ALIGN_EPI) { if (wr == 1) PG8_BAR; }
    }
    PG8_WAIT_V(0);
    if constexpr (!ALIGN_EPI) { if (wr == 0) PG8_BAR; }
    PG8_BAR;
    if constexpr (Epi::AFTER_DRAIN) { E.fused(acc, cur, wr, wc, fr, fq, lds, wid, lane); S.done(cur); }
#undef PG8_SA
#undef PG8_SB
#undef PG8_STAGE
#undef PG8_LDA
#undef PG8_LDB
#undef PG8_MMA
#undef PG8_WAIT_V
#undef PG8_WAIT_L
#undef PG8_BAR
#undef PG8_SCHED
}
}
constexpr int M_TOK = 10240, M_CTX = 8192, DM = 1024, FF = 2816, NWI = 5632, NIN = 2048;
constexpr int LCTX = 256, LLAT = 1024, LKLAT = 1280, NSEQ = 34;
constexpr float EPS = 1e-6f;

namespace pg8 {
__device__ __forceinline__ float silu_f(float x) { return x * __builtin_amdgcn_rcpf(1.0f + __builtin_amdgcn_exp2f(-1.4426950408889634f * x)); }
struct EpiSwiglu {
    static constexpr bool PERM = true, AFTER_DRAIN = false;
    bf16_t* O; int ldc;
    __device__ __forceinline__ void operator()(const f32x4 (&acc)[2][2][4][2], const Unit& u, int wr, int wc, int fr, int fq) const {
        const int row0 = u.pm * BM + wr * 64 + fr, col0 = u.pn * HALF + wc * 32 + 8 * fq;
#pragma unroll
        for (int ai = 0; ai < 2; ++ai)
#pragma unroll
            for (int m = 0; m < 4; ++m) { bf16_t* rowp = O + (size_t)(row0 + ai * HALF + m * 16) * ldc + col0;
                const f32x4 a0 = acc[ai][0][m][0], a1 = acc[ai][0][m][1], b0 = acc[ai][1][m][0], b1 = acc[ai][1][m][1];
                u32x4 w;
                w.x = cvt_pk_bf16(silu_f(a0[0]) * b0[0], silu_f(a0[1]) * b0[1]); w.y = cvt_pk_bf16(silu_f(a0[2]) * b0[2], silu_f(a0[3]) * b0[3]);
                w.z = cvt_pk_bf16(silu_f(a1[0]) * b1[0], silu_f(a1[1]) * b1[1]); w.w = cvt_pk_bf16(silu_f(a1[2]) * b1[2], silu_f(a1[3]) * b1[3]);
                *(u32x4*)rowp = w; }
    }
};
struct EpiResGate {
    static constexpr bool PERM = false, AFTER_DRAIN = false;
    const float* base0; const float* base1;
    float* out; const float* mods;
    int idx; float gs;
    __device__ __forceinline__ void operator()(const f32x4 (&acc)[2][2][4][2], const Unit& u, int wr, int wc, int fr, int fq) const {
        const int set = u.pm < 32 ? 0 : 1 + ((u.pm - 32) >> 2);
        const float* mv = mods + (size_t)(set * 9 + idx) * DM;
        const float* bp = u.pm < 32 ? base0 + (size_t)u.pm * BM * DM : base1 + (size_t)(u.pm - 32) * BM * DM;
        float* op = out + (size_t)u.pm * BM * DM;
        const int col0 = u.pn * BM + wc * 32 + 4 * fq;
        f32x4 gv[2][2];
#pragma unroll
        for (int bj = 0; bj < 2; ++bj)
#pragma unroll
            for (int n = 0; n < 2; ++n) gv[bj][n] = *(const f32x4*)(mv + col0 + bj * HALF + n * 16) * gs;
#pragma unroll
        for (int ai = 0; ai < 2; ++ai)
#pragma unroll
            for (int m = 0; m < 4; ++m) { const size_t off = (size_t)(ai * HALF + wr * 64 + m * 16 + fr) * DM + col0;
#pragma unroll
                for (int bj = 0; bj < 2; ++bj)
#pragma unroll
                    for (int n = 0; n < 2; ++n) { const f32x4 b = *(const f32x4*)(bp + off + bj * HALF + n * 16);
                        *(f32x4*)(op + off + bj * HALF + n * 16) = b + gv[bj][n] * acc[ai][bj][m][n]; } }
    }
};
struct EpiU {
    static constexpr bool PERM = true, AFTER_DRAIN = false;
    bf16_t* U; float* outV; int layer;
    __device__ __forceinline__ void operator()(const f32x4 (&acc)[2][2][4][2], const Unit& u, int wr, int wc, int fr, int fq) const {
        const int row0 = u.pm * BM + wr * 64 + fr, col0 = u.pn * BM + wc * 32 + 8 * fq;
        const bool vout = (u.pn >= 6) && (u.pm < 32);
#pragma unroll
        for (int ai = 0; ai < 2; ++ai)
#pragma unroll
            for (int m = 0; m < 4; ++m) { const int row = row0 + ai * HALF + m * 16; bf16_t* rowp = U + (size_t)row * NIN + col0;
#pragma unroll
                for (int bj = 0; bj < 2; ++bj) { const f32x4 v0 = acc[ai][bj][m][0], v1 = acc[ai][bj][m][1];
                    u32x4 w; w.x = cvt_pk_bf16(v0[0], v0[1]); w.y = cvt_pk_bf16(v0[2], v0[3]); w.z = cvt_pk_bf16(v1[0], v1[1]); w.w = cvt_pk_bf16(v1[2], v1[3]);
                    *(u32x4*)(rowp + bj * HALF) = w;
                    if (vout) { float* vp = outV + ((size_t)((row >> 8) * 2 + layer) * 256 + (row & 255)) * 512 + (col0 + bj * HALF - 1536);
                        *(f32x4*)vp = v0; *(f32x4*)(vp + 4) = v1; } } }
    }
};
}
constexpr size_t MiB = 1u << 20;
constexpr size_t WS_CTL = 0, CTL_ZERO_BYTES = 512 * 1024;
constexpr size_t SZ_WI = (size_t)NWI * DM * 2, SZ_WO = (size_t)DM * FF * 2, SZ_WIN = (size_t)NIN * DM * 2, SZ_WOUT = (size_t)DM * DM * 2;
constexpr size_t WS_W = 2 * MiB;
constexpr size_t OFF_WI1 = 0, OFF_WO1 = OFF_WI1 + SZ_WI, OFF_WI2 = OFF_WO1 + SZ_WO, OFF_WO2 = OFF_WI2 + SZ_WI, OFF_WIN = OFF_WO2 + SZ_WO, OFF_WOUT = OFF_WIN + SZ_WIN, SZ_WLAYER = OFF_WOUT + SZ_WOUT;
constexpr size_t WS_TW1024 = 84 * MiB;
constexpr size_t WS_TW256 = 88 * MiB;
constexpr size_t WS_WCS = WS_TW256 + 512 * 1024;
constexpr size_t WS_ROPE = WS_WCS + 256 * 1024;
constexpr size_t WS_SCAL = WS_ROPE + 16 * 1024;
constexpr size_t WS_XN = 90 * MiB;
constexpr size_t WS_MIX = 110 * MiB;
constexpr size_t WS_GB = 130 * MiB;
constexpr size_t WS_U = 130 * MiB;
constexpr size_t WS_QB = 170 * MiB;
constexpr size_t WS_KB = 185 * MiB;
constexpr size_t WS_VTC = 196 * MiB;
constexpr size_t WS_VTL = 204 * MiB;
constexpr size_t WS_YTC = 207 * MiB;
constexpr size_t WS_YTL = 215 * MiB;
constexpr size_t WS_QN = 217 * MiB;
constexpr size_t WS_END = 218 * MiB;
static_assert(WS_W + 2 * SZ_WLAYER <= WS_TW1024 && WS_SCAL + 64 <= WS_XN && WS_GB + (size_t)M_TOK * FF * 2 <= WS_KB && WS_QB + (size_t)M_TOK * 512 * 2 <= WS_KB, "ws map");
constexpr int CW_TMO = 0, CW_BAR = 4096, CW_KMAX = 8192  , CW_MODS = 16384  ;
static_assert((CW_MODS + 2 * 3 * 9 * 1024) * 4 <= (int)CTL_ZERO_BYTES, "ctl");
constexpr int RING_BYTES = 131072, LDSCTL_OFF = RING_BYTES, MISC_OFF = LDSCTL_OFF + 320, LDS_BYTES = 147456;
constexpr int NWAVES = 8;
constexpr int NPHASES = 23;
#define GAS __attribute__((address_space(1)))
#define LAS __attribute__((address_space(3)))
typedef unsigned short bf16;
typedef unsigned v4u __attribute__((ext_vector_type(4)));
typedef float f32x4 __attribute__((ext_vector_type(4)));
typedef short bf16x8 __attribute__((ext_vector_type(8)));
typedef GAS unsigned gu32;
typedef GAS unsigned long long gu64;
#define RLX_AGENT __ATOMIC_RELAXED, __HIP_MEMORY_SCOPE_AGENT
#define LDS_WAIT() asm volatile("s_waitcnt lgkmcnt(0)" ::: "memory")
#define VM_WAIT() asm volatile("s_waitcnt vmcnt(0)" ::: "memory")
__device__ __forceinline__ unsigned long long rt() { return __builtin_amdgcn_s_memrealtime(); }
__device__ __forceinline__ unsigned f2bf(float f) { unsigned u = __builtin_bit_cast(unsigned, f); return (u + 0x7fffu + ((u >> 16) & 1u)) >> 16; }
__device__ __forceinline__ unsigned pk2(float lo, float hi) { return f2bf(lo) | (f2bf(hi) << 16); }
#define XB_TMO      128
#define XB_XCNT(j)  (256  + 64 * (j))
#define XB_XSUB(j)  (1280 + 64 * (j))
#define XB_XGEN(j)  (2304 + 64 * (j))
#define XB_TOP      3328
#define XB_TOPGEN   3392
#define XCD_BAR_WORDS 3456
#define XB_SPIN_CAP (1u << 18)

__device__ __forceinline__ unsigned xb_ld(unsigned* p)              { return __hip_atomic_load(p, __ATOMIC_RELAXED, __HIP_MEMORY_SCOPE_AGENT); }
__device__ __forceinline__ unsigned xb_add(unsigned* p, unsigned v) { return __hip_atomic_fetch_add(p, v, __ATOMIC_RELAXED, __HIP_MEMORY_SCOPE_AGENT); }
__device__ __forceinline__ unsigned xb_xcc_id() { return (unsigned)__builtin_amdgcn_s_getreg((3 << 11) | 20) & 0xFu; }
#define XB_SPIN(cond, bar) do { unsigned _sp = 0; while (cond) { __builtin_amdgcn_s_sleep(1); \
    if ((++_sp & 255u) == 0u) { if (xb_ld(&(bar)[XB_TMO])) break; if (_sp > XB_SPIN_CAP) { atomicAdd(&(bar)[XB_TMO], 1u); break; } } } } while (0)

struct XcdBarrier {
    unsigned* bar; unsigned x;
    volatile LAS unsigned* st;
};

__device__ __forceinline__ XcdBarrier xcd_barrier_post(unsigned* bar, volatile LAS unsigned* st) {
    XcdBarrier b; b.bar = bar; b.x = xb_xcc_id(); b.st = st;
    if (threadIdx.x == 0) (void)xb_add(&bar[XB_XCNT(b.x)], 1u);
    return b;
}
__device__ __forceinline__ void xcd_barrier_complete(unsigned* bar, unsigned x, unsigned& nloc, unsigned& nx) {
    const unsigned G = gridDim.x * gridDim.y * gridDim.z;
    unsigned sum, cnt, mine, sp = 0u;
    for (;;) {
        sum = 0u; cnt = 0u; mine = 0u;
#pragma unroll
        for (unsigned j = 0; j < 16; ++j) { const unsigned c = xb_ld(&bar[XB_XCNT(j)]); sum += c; cnt += (c > 0u) ? 1u : 0u; mine = (j == x) ? c : mine; }
        if (sum == G) break;
        __builtin_amdgcn_s_sleep(1);
        if ((++sp & 255u) == 0u) { if (xb_ld(&bar[XB_TMO])) break; if (sp > XB_SPIN_CAP) { atomicAdd(&bar[XB_TMO], 1u); break; } }
    }
    nloc = mine > 0u ? mine : 1u; nx = cnt > 0u ? cnt : 1u;
}

__device__ __forceinline__ void xcd_barrier(const XcdBarrier& b) {
    asm volatile("s_waitcnt vmcnt(0)" ::: "memory");
    __syncthreads();
    if (threadIdx.x == 0) {
        unsigned* bar = b.bar;
        __builtin_amdgcn_s_waitcnt(0);
        unsigned nloc = b.st[0], nx = b.st[1];
        if (nloc == 0u) { xcd_barrier_complete(bar, b.x, nloc, nx); b.st[0] = nloc; b.st[1] = nx; }
        const unsigned old = xb_add(&bar[XB_XSUB(b.x)], 1u);
        const unsigned gen = old / nloc;
        if (old + 1u == (gen + 1u) * nloc) {
            __builtin_amdgcn_fence(__ATOMIC_RELEASE, "agent");
            asm volatile("s_waitcnt vmcnt(0)" ::: "memory");
            const unsigned og = xb_add(&bar[XB_TOP], 1u);
            const unsigned tg = og / nx;
            if (og + 1u == (tg + 1u) * nx) xb_add(&bar[XB_TOPGEN], 1u);
            else XB_SPIN(xb_ld(&bar[XB_TOPGEN]) == tg, bar);
            __builtin_amdgcn_fence(__ATOMIC_ACQUIRE, "agent");
            xb_add(&bar[XB_XGEN(b.x)], 1u);
            asm volatile("s_waitcnt vmcnt(0)" ::: "memory");
        } else {
            XB_SPIN(xb_ld(&bar[XB_XGEN(b.x)]) == gen, bar);
            __builtin_amdgcn_fence(__ATOMIC_ACQUIRE, "agent");
            asm volatile("s_waitcnt vmcnt(0)" ::: "memory");
        }
    }
    __syncthreads();
}
typedef float f32x16 __attribute__((ext_vector_type(16)));
typedef unsigned u32x2 __attribute__((ext_vector_type(2)));
__device__ __forceinline__ float bf2f(unsigned h) { return __builtin_bit_cast(float, h << 16); }
__device__ __forceinline__ float wave_sum(float v) {
#pragma unroll
    for (int o = 1; o < 64; o <<= 1) v += __shfl_xor(v, o);
    return v;
}
__device__ __forceinline__ int crow(int r, int hi) { return (r & 3) + 8 * (r >> 2) + 4 * hi; }
__device__ __forceinline__ float silu_acc(float x) { return x / (1.0f + expf(-x)); }

struct KArgs { const float* in[25]; float* out; unsigned char* ws; int ph_lo, ph_hi; };
enum { I_XP = 0, I_XS, I_CK, I_CV, I_C, I_CCTX, I_NG, I_ADAW, I_ADAB, I_F1WI, I_F1WO, I_F2WI, I_F2WO, I_WIN, I_WOUT, I_QG, I_KG, I_LQ1, I_LK1, I_LQ2, I_LK2, I_AOG, I_POOLW, I_POOLS, I_FNETW };
constexpr size_t OUT_YS = (size_t)M_CTX * DM, OUT_K = (size_t)M_TOK * DM, OUT_V = OUT_K + (size_t)32 * 2 * 256 * 512;

__device__ __forceinline__ void p0_transpose_item(const float* W, int K, int N, bf16* WT, bool swi, LAS float* scr, int item, int lane) {
    const int nblk = N / 32, kb = item / nblk, nb = item % nblk, k0 = 64 * kb, n0 = 32 * nb;
    int r0 = n0;
    if (swi) { const int half = n0 / FF, jj = n0 % FF; r0 = (jj / 128) * 256 + half * 128 + (jj % 128); }
#pragma unroll 8
    for (int i = 0; i < 32; ++i) { const int kk = 2 * i + (lane >> 5); scr[kk * 33 + (lane & 31)] = W[(size_t)(k0 + kk) * N + n0 + (lane & 31)]; }
    LDS_WAIT(); asm volatile("" ::: "memory");
    const int c = lane & 7;
#pragma unroll
    for (int j = 0; j < 4; ++j) { const int n = (lane >> 3) + 8 * j; const LAS float* s = scr + (8 * c) * 33 + n;
        v4u o; o.x = pk2(s[0 * 33], s[1 * 33]); o.y = pk2(s[2 * 33], s[3 * 33]); o.z = pk2(s[4 * 33], s[5 * 33]); o.w = pk2(s[6 * 33], s[7 * 33]);
        *(GAS v4u*)(WT + (size_t)(r0 + n) * K + k0 + 8 * c) = o; }
    LDS_WAIT(); asm volatile("" ::: "memory");
}
__device__ __forceinline__ void p0_mods_item(const KArgs& A, float* mods, int item, int lane) {
    const int l = item / 576, r = item % 576, kc = r / 36, cb = r % 36;
    const float* W = A.in[I_ADAW] + (size_t)l * DM * 9216 + (size_t)(kc * 64) * 9216 + cb * 256 + lane * 4;
    const int k = kc * 64 + lane;
    const float s0 = silu_acc(A.in[I_CCTX][k]), s1 = silu_acc(A.in[I_C][k]), s2 = silu_acc(A.in[I_C][DM + k]);
    f32x4 a0 = {0.f, 0.f, 0.f, 0.f}, a1 = a0, a2 = a0;
#pragma unroll 8
    for (int kk = 0; kk < 64; ++kk) {
        const f32x4 w = *(const f32x4*)(W + (size_t)kk * 9216);
        const float c0 = __builtin_bit_cast(float, __builtin_amdgcn_readlane(__builtin_bit_cast(int, s0), kk));
        const float c1 = __builtin_bit_cast(float, __builtin_amdgcn_readlane(__builtin_bit_cast(int, s1), kk));
        const float c2 = __builtin_bit_cast(float, __builtin_amdgcn_readlane(__builtin_bit_cast(int, s2), kk));
        a0 += w * c0; a1 += w * c1; a2 += w * c2;
    }
    if (kc == 0) { const f32x4 b = *(const f32x4*)(A.in[I_ADAB] + (size_t)l * 9216 + cb * 256 + lane * 4); a0 += b; a1 += b; a2 += b; }
    float* mp = mods + (size_t)l * 3 * 9216 + cb * 256 + lane * 4;
#pragma unroll
    for (int i = 0; i < 4; ++i) { atomicAdd(mp + i, a0[i]); atomicAdd(mp + 9216 + i, a1[i]); atomicAdd(mp + 2 * 9216 + i, a2[i]); }
}
__device__ __forceinline__ void p0_tw_item(bf16* TW, int L, int item, int lane) {
    const int nseg = (2 * L) / 512, k = item / nseg, seg = item % nseg, kk0 = seg * 512 + lane * 8;
    unsigned w[4];
#pragma unroll
    for (int i = 0; i < 4; ++i) { float v[2];
#pragma unroll
        for (int e = 0; e < 2; ++e) { const int kk = kk0 + 2 * i + e; const bool sn = kk >= L; const int j = (k * (sn ? kk - L : kk)) & (L - 1);
            float s, c; sincospif(2.0f * (float)j / (float)L, &s, &c); v[e] = sn ? s : c; }
        w[i] = pk2(v[0], v[1]); }
    *(GAS v4u*)(TW + (size_t)k * (2 * L) + kk0) = (v4u){w[0], w[1], w[2], w[3]};
}
__device__ __forceinline__ void p0_wcs_item(const KArgs& A, bf16* WCS, int item, int lane) {
    const int lg = item >> 7, n = item & 127, d = n & 63; const bool sn = n >= 64;
    const float* Wf = A.in[I_FNETW] + (size_t)lg * 4096 + d;
    float acc = 0.f;
    for (int m = 0; m < 64; ++m) { float s, c; sincospif(2.0f * (float)((m * lane) & 63) / 64.0f, &s, &c); acc += (sn ? -s : c) * Wf[m * 64]; }
    WCS[(size_t)item * 64 + lane] = (bf16)f2bf(acc);
}
__device__ __forceinline__ void p0_misc_item(const KArgs& A, float* rope, float* scal, int lane) {
    for (int e = lane; e < 1024; e += 64) { const int pos = e >> 4, i = e & 15; const float inv = 1.0f / powf(10000.0f, (float)(2 * i) / 32.0f); const float ang = (float)pos * inv;
        rope[e] = cosf(ang); rope[1024 + e] = sinf(ang); }
#pragma unroll
    for (int l = 0; l < 2; ++l) {
        const float d1 = wave_sum(A.in[I_LQ1][l * 64 + lane] * A.in[I_LK1][l * 64 + lane]), d2 = wave_sum(A.in[I_LQ2][l * 64 + lane] * A.in[I_LK2][l * 64 + lane]);
        const float lam_init = 0.8f - 0.6f * expf(-0.3f * (float)l);
        if (lane == 0) scal[l] = expf(d1) - expf(d2) + lam_init;
    }
}
constexpr int IT_MODS = 2 * 16 * 36, IT_TWI = (DM / 64) * (NWI / 32), IT_TWO = (FF / 64) * (DM / 32), IT_TWIN = (DM / 64) * (NIN / 32), IT_TWOUT = (DM / 64) * (DM / 32);
constexpr int IT_TRL = 2 * IT_TWI + 2 * IT_TWO + IT_TWIN + IT_TWOUT;
constexpr int IT_TW1024 = 1024 * 4, IT_TW256 = 256, IT_WCS = 2 * 4 * 128;
constexpr int P0_ITEMS = IT_MODS + 2 * IT_TRL + IT_TW1024 + IT_TW256 + IT_WCS + 1;
__device__ __forceinline__ void p0_prologue(const KArgs& A, LAS unsigned char* lds, int gw, int NGW, int wave, int lane) {
    LAS float* scr = (LAS float*)(lds + wave * 16384);
    unsigned char* ws = A.ws;
    float* mods = (float*)(ws + WS_CTL) + CW_MODS;
    for (int it = gw; it < P0_ITEMS; it += NGW) {
        int r = it;
        if (r < IT_MODS) { p0_mods_item(A, mods, r, lane); continue; } r -= IT_MODS;
        if (r < 2 * IT_TRL) { const int l = r / IT_TRL; r %= IT_TRL; unsigned char* wl = ws + WS_W + (size_t)l * SZ_WLAYER;
            if (r < IT_TWI) { p0_transpose_item(A.in[I_F1WI] + (size_t)l * DM * NWI, DM, NWI, (bf16*)(wl + OFF_WI1), true, scr, r, lane); continue; } r -= IT_TWI;
            if (r < IT_TWO) { p0_transpose_item(A.in[I_F1WO] + (size_t)l * FF * DM, FF, DM, (bf16*)(wl + OFF_WO1), false, scr, r, lane); continue; } r -= IT_TWO;
            if (r < IT_TWI) { p0_transpose_item(A.in[I_F2WI] + (size_t)l * DM * NWI, DM, NWI, (bf16*)(wl + OFF_WI2), true, scr, r, lane); continue; } r -= IT_TWI;
            if (r < IT_TWO) { p0_transpose_item(A.in[I_F2WO] + (size_t)l * FF * DM, FF, DM, (bf16*)(wl + OFF_WO2), false, scr, r, lane); continue; } r -= IT_TWO;
            if (r < IT_TWIN) { p0_transpose_item(A.in[I_WIN] + (size_t)l * DM * NIN, DM, NIN, (bf16*)(wl + OFF_WIN), false, scr, r, lane); continue; } r -= IT_TWIN;
            p0_transpose_item(A.in[I_WOUT] + (size_t)l * DM * DM, DM, DM, (bf16*)(wl + OFF_WOUT), false, scr, r, lane); continue; }
        r -= 2 * IT_TRL;
        if (r < IT_TW1024) { p0_tw_item((bf16*)(ws + WS_TW1024), 1024, r, lane); continue; } r -= IT_TW1024;
        if (r < IT_TW256) { p0_tw_item((bf16*)(ws + WS_TW256), 256, r, lane); continue; } r -= IT_TW256;
        if (r < IT_WCS) { p0_wcs_item(A, (bf16*)(ws + WS_WCS), r, lane); continue; }
        p0_misc_item(A, (float*)(ws + WS_ROPE), (float*)(ws + WS_SCAL), lane);
    }
}
__device__ __forceinline__ void norm_phase(const float* x0, const float* x1, bf16* XN, const float* g, const float* mods_l, int sub, int gw, int NGW, int lane) {
    for (int m = gw; m < M_TOK; m += NGW) {
        const float* xrow = m < M_CTX ? x0 + (size_t)m * DM : x1 + (size_t)(m - M_CTX) * DM;
        const int set = m < M_CTX ? 0 : 1 + ((m - M_CTX) >> 10);
        const float* shift = mods_l + (size_t)(set * 9 + 3 * sub) * DM; const float* scale = shift + DM;
        const GAS f32x4* xr = (const GAS f32x4*)xrow + lane;
        f32x4 v[4]; float ss = 0.f;
#pragma unroll
        for (int j = 0; j < 4; ++j) { v[j] = xr[64 * j]; ss += (v[j].x * v[j].x + v[j].y * v[j].y) + (v[j].z * v[j].z + v[j].w * v[j].w); }
        const float rstd = 1.0f / sqrtf(wave_sum(ss) * (1.0f / DM) + EPS);
        GAS unsigned long long* o8 = (GAS unsigned long long*)(XN + (size_t)m * DM) + lane;
#pragma unroll
        for (int j = 0; j < 4; ++j) { const f32x4 gg = *((const f32x4*)g + 64 * j + lane), sc = *((const f32x4*)scale + 64 * j + lane), sh = *((const f32x4*)shift + 64 * j + lane);
            const f32x4 h = (v[j] * rstd) * gg * (sc + 1.0f) + sh;
            o8[64 * j] = (unsigned long long)pk2(h.x, h.y) | ((unsigned long long)pk2(h.z, h.w) << 32); }
    }
}
__device__ __forceinline__ void prep_token_item(const KArgs& A, int l, int row, int lane, const bf16* U, bf16* QB, bf16* KB, float* QN, unsigned* kmax, const float* rope) {
    const int j = lane & 7, grp = lane >> 3;
    const bool lat = row >= M_CTX;
    const int t = lat ? (row - M_CTX) & 1023 : row & 255;
    const int seq = lat ? 32 + ((row - M_CTX) >> 10) : row >> 8;
    const float* gq = A.in[I_QG] + l * 64 + 8 * j; const float* gk = A.in[I_KG] + l * 64 + 8 * j;
    const v4u uq = *(const GAS v4u*)(U + (size_t)row * NIN + 512 + lane * 8), uk = *(const GAS v4u*)(U + (size_t)row * NIN + 1024 + lane * 8);
    float q[8], k[8];
    { const unsigned wq[4] = {uq.x, uq.y, uq.z, uq.w}, wk[4] = {uk.x, uk.y, uk.z, uk.w};
#pragma unroll
      for (int i = 0; i < 4; ++i) { q[2 * i] = bf2f(wq[i] & 0xffffu); q[2 * i + 1] = bf2f(wq[i] >> 16); k[2 * i] = bf2f(wk[i] & 0xffffu); k[2 * i + 1] = bf2f(wk[i] >> 16); } }
    float sq = 0.f, sk = 0.f;
#pragma unroll
    for (int i = 0; i < 8; ++i) { sq += q[i] * q[i]; sk += k[i] * k[i]; }
#pragma unroll
    for (int o = 1; o < 8; o <<= 1) { sq += __shfl_xor(sq, o); sk += __shfl_xor(sk, o); }
    const float rq = 1.0f / sqrtf(sq * (1.0f / 64.0f) + EPS), rk = 1.0f / sqrtf(sk * (1.0f / 64.0f) + EPS);
#pragma unroll
    for (int i = 0; i < 8; ++i) { q[i] = q[i] * rq * gq[i]; k[i] = k[i] * rk * gk[i]; }
    if (lat) {
        const int pos = (j < 4) ? (t >> 6) : (t & 63);
        const float* cs = rope + pos * 16 + (j & 1) * 8; const float* sn = cs + 1024;
        const float sgn = (j & 2) ? 1.0f : -1.0f;
#pragma unroll
        for (int i = 0; i < 8; ++i) { const float pq = __shfl_xor(q[i], 2), pk = __shfl_xor(k[i], 2); const float c = cs[i], s = sn[i] * sgn;
            q[i] = q[i] * c + pq * s; k[i] = k[i] * c + pk * s; }
    }
    const float QS = 0.125f * 1.4426950408889634f;
    float nq = 0.f, nk = 0.f;
#pragma unroll
    for (int i = 0; i < 8; ++i) { q[i] *= QS; nq += q[i] * q[i]; nk += k[i] * k[i]; }
#pragma unroll
    for (int o = 1; o < 8; o <<= 1) { nq += __shfl_xor(nq, o); nk += __shfl_xor(nk, o); }
    *(GAS v4u*)(QB + (size_t)row * 512 + lane * 8) = (v4u){pk2(q[0], q[1]), pk2(q[2], q[3]), pk2(q[4], q[5]), pk2(q[6], q[7])};
    const int krow = lat ? M_CTX + (seq - 32) * LKLAT + 256 + t : row;
    *(GAS v4u*)(KB + (size_t)krow * 512 + lane * 8) = (v4u){pk2(k[0], k[1]), pk2(k[2], k[3]), pk2(k[4], k[5]), pk2(k[6], k[7])};
    if (j == 0) { QN[(size_t)row * 8 + grp] = sqrtf(nq) * 1.01f; atomicMax(kmax + seq * 8 + grp, __builtin_bit_cast(unsigned, sqrtf(nk) * 1.01f)); }
    if (!lat) { float* ko = A.out + OUT_K + ((size_t)((row >> 8) * 2 + l) * 256 + t) * 512 + lane * 8;
        *(f32x4*)ko = (f32x4){k[0], k[1], k[2], k[3]}; *(f32x4*)(ko + 4) = (f32x4){k[4], k[5], k[6], k[7]}; }
}
__device__ __forceinline__ void prep_cachek_item(const KArgs& A, int l, int item, int lane, bf16* KB, unsigned* kmax) {
    const int b = item >> 8, jrow = item & 255, grp = lane >> 3;
    const float* src = A.in[I_CK] + ((size_t)(b * 2 + l) * 256 + jrow) * 512 + lane * 8;
    const f32x4 a = *(const f32x4*)src, c = *(const f32x4*)(src + 4);
    float nk = (a.x * a.x + a.y * a.y) + (a.z * a.z + a.w * a.w) + (c.x * c.x + c.y * c.y) + (c.z * c.z + c.w * c.w);
#pragma unroll
    for (int o = 1; o < 8; o <<= 1) nk += __shfl_xor(nk, o);
    *(GAS v4u*)(KB + (size_t)(M_CTX + b * LKLAT + jrow) * 512 + lane * 8) = (v4u){pk2(a.x, a.y), pk2(a.z, a.w), pk2(c.x, c.y), pk2(c.z, c.w)};
    if ((lane & 7) == 0) atomicMax(kmax + (32 + b) * 8 + grp, __builtin_bit_cast(unsigned, sqrtf(nk) * 1.01f));
}
__device__ __forceinline__ void prep_vt_item(const KArgs& A, int l, int kind, int item, int lane, const bf16* U, bf16* VTC, bf16* VTL, LAS unsigned char* scr) {
    LAS bf16* T = (LAS bf16*)scr;
    const int ch = item & (kind == 1 ? 31 : 7), sh = item >> (kind == 1 ? 5 : 3), h = sh & 3, s = sh >> 2;
    bf16* dst; int Lk;
    if (kind == 0) { dst = VTC + (size_t)((s * 4 + h) * 128) * 256 + ch * 32; Lk = 256; }
    else if (kind == 1) { dst = VTL + (size_t)((s * 4 + h) * 128) * LKLAT + 256 + ch * 32; Lk = LKLAT; }
    else { dst = VTL + (size_t)((s * 4 + h) * 128) * LKLAT + ch * 32; Lk = LKLAT; }
    if (kind < 2) { const int row0 = (kind == 0 ? s * 256 : M_CTX + s * 1024) + ch * 32;
        for (int i = 0; i < 32; ++i) { const unsigned w = *(const GAS unsigned*)(U + (size_t)(row0 + i) * NIN + 1536 + h * 128 + 2 * lane);
            T[(2 * lane) * 40 + i] = (bf16)(w & 0xffffu); T[(2 * lane + 1) * 40 + i] = (bf16)(w >> 16); }
    } else { const float* src = A.in[I_CV] + ((size_t)(s * 2 + l) * 256 + ch * 32) * 512 + h * 128 + 2 * lane;
        for (int i = 0; i < 32; ++i) { const float2 w = *(const float2*)(src + (size_t)i * 512);
            T[(2 * lane) * 40 + i] = (bf16)f2bf(w.x); T[(2 * lane + 1) * 40 + i] = (bf16)f2bf(w.y); } }
    LDS_WAIT(); asm volatile("" ::: "memory");
#pragma unroll
    for (int it = 0; it < 8; ++it) { const int x = it * 64 + lane, d = x >> 2, q4 = x & 3;
        const v4u v = *(const LAS v4u*)(scr + d * 80 + q4 * 16);
        *(GAS v4u*)(dst + (size_t)d * Lk + q4 * 8) = v; }
    LDS_WAIT(); asm volatile("" ::: "memory");
}
__device__ __forceinline__ void prep_yt_item(int l, int item, int lane, const bf16* U, const bf16* WCS, bf16* YTC, bf16* YTL) {
    const int g = item & 3, rb = item >> 2, row0 = rb * 32, r32 = lane & 31, hi = lane >> 5;
    bf16* Y; int L, lp0;
    if (row0 < M_CTX) { L = 256; lp0 = row0 & 255; Y = YTC + (size_t)(((row0 >> 8) * 4 + g) * 128) * 256; }
    else { L = 1024; lp0 = (row0 - M_CTX) & 1023; Y = YTL + (size_t)((((row0 - M_CTX) >> 10) * 4 + g) * 128) * 1024; }
    const bf16* xp = U + (size_t)(row0 + r32) * NIN + 256 + g * 64 + hi * 8;
    const bf16* wp = WCS + (size_t)((l * 4 + g) * 128 + r32) * 64 + hi * 8;
    bf16x8 xa[4];
#pragma unroll
    for (int ks = 0; ks < 4; ++ks) xa[ks] = *(const GAS bf16x8*)(xp + ks * 16);
#pragma unroll
    for (int nb = 0; nb < 4; ++nb) { f32x16 acc = {};
#pragma unroll
        for (int ks = 0; ks < 4; ++ks) { const bf16x8 wb = *(const GAS bf16x8*)(wp + (size_t)nb * 32 * 64 + ks * 16); acc = __builtin_amdgcn_mfma_f32_32x32x16_bf16(xa[ks], wb, acc, 0, 0, 0); }
        bf16* yp = Y + (size_t)(nb * 32 + r32) * L + lp0 + 4 * hi;
#pragma unroll
        for (int rg = 0; rg < 4; ++rg) *(GAS u32x2*)(yp + 8 * rg) = (u32x2){pk2(acc[4 * rg], acc[4 * rg + 1]), pk2(acc[4 * rg + 2], acc[4 * rg + 3])}; }
}
constexpr int PR_TOK = M_TOK, PR_CK = 512, PR_VT0 = 32 * 4 * 8, PR_VT1 = 2 * 4 * 32, PR_VT2 = 2 * 4 * 8, PR_YT = (M_TOK / 32) * 4;
constexpr int PR_ITEMS = PR_TOK + PR_CK + PR_VT0 + PR_VT1 + PR_VT2 + PR_YT;
__device__ __forceinline__ void prep_phase(const KArgs& A, int l, LAS unsigned char* lds, int gw, int NGW, int wave, int lane) {
    unsigned char* ws = A.ws;
    const bf16* U = (const bf16*)(ws + WS_U); bf16* QB = (bf16*)(ws + WS_QB); bf16* KB = (bf16*)(ws + WS_KB);
    float* QN = (float*)(ws + WS_QN); unsigned* kmax = (unsigned*)(ws + WS_CTL) + CW_KMAX + l * NSEQ * 8; const float* rope = (const float*)(ws + WS_ROPE);
    LAS unsigned char* scr = lds + wave * 16384;
    for (int it = gw; it < PR_ITEMS; it += NGW) {
        int r = it;
        if (r < PR_YT) { prep_yt_item(l, r, lane, U, (const bf16*)(ws + WS_WCS), (bf16*)(ws + WS_YTC), (bf16*)(ws + WS_YTL)); continue; } r -= PR_YT;
        if (r < PR_VT0) { prep_vt_item(A, l, 0, r, lane, U, (bf16*)(ws + WS_VTC), (bf16*)(ws + WS_VTL), scr); continue; } r -= PR_VT0;
        if (r < PR_VT1) { prep_vt_item(A, l, 1, r, lane, U, (bf16*)(ws + WS_VTC), (bf16*)(ws + WS_VTL), scr); continue; } r -= PR_VT1;
        if (r < PR_VT2) { prep_vt_item(A, l, 2, r, lane, U, (bf16*)(ws + WS_VTC), (bf16*)(ws + WS_VTL), scr); continue; } r -= PR_VT2;
        if (r < PR_CK) { prep_cachek_item(A, l, r, lane, KB, kmax); continue; } r -= PR_CK;
        prep_token_item(A, l, r, lane, U, QB, KB, QN, kmax, rope);
    }
}
#define WG_BAR() do { asm volatile("s_waitcnt vmcnt(0) lgkmcnt(0)" ::: "memory"); __builtin_amdgcn_s_barrier(); asm volatile("" ::: "memory"); } while (0)
__device__ __forceinline__ void lds_fadd(LAS float* p, float v) { (void)__hip_atomic_fetch_add(p, v, __ATOMIC_RELAXED, __HIP_MEMORY_SCOPE_WORKGROUP); }
__device__ __forceinline__ void attn_unit(const KArgs& A, int l, int seq, int h, int qb, LAS unsigned char* lds, int tid, int wave, int lane) {
    unsigned char* ws = A.ws;
    const bf16* QB = (const bf16*)(ws + WS_QB); const bf16* KB = (const bf16*)(ws + WS_KB); const float* QN = (const float*)(ws + WS_QN);
    const unsigned* kmax = (const unsigned*)(ws + WS_CTL) + CW_KMAX + l * NSEQ * 8;
    const bool lat = seq >= 32;
    const int Lk = lat ? LKLAT : 256;
    const int qrow0 = lat ? M_CTX + (seq - 32) * 1024 + qb * 64 : seq * 256 + qb * 64;
    const int krow0 = lat ? M_CTX + (seq - 32) * LKLAT : seq * 256;
    const bf16* VT = lat ? (const bf16*)(ws + WS_VTL) + (size_t)(((seq - 32) * 4 + h) * 128) * LKLAT : (const bf16*)(ws + WS_VTC) + (size_t)((seq * 4 + h) * 128) * 256;
    const int qs = wave & 1, ks = wave >> 1, r32 = lane & 31, hi = lane >> 5;
    const int kq = Lk >> 2, kbeg = ks * kq, ntile = kq >> 5;
    LAS float* OB = (LAS float*)lds;
    LAS float* LB = (LAS float*)(lds + 65536);
    for (int i = tid; i < (65536 + 512) / 16; i += 512) *(LAS v4u*)(lds + i * 16) = (v4u){0u, 0u, 0u, 0u};
    const int qrow = qrow0 + qs * 32 + r32;
    WG_BAR();
#pragma unroll 1
    for (int c = 0; c < 2; ++c) {
        const bf16* qp = QB + (size_t)qrow * 512 + h * 128 + c * 64 + hi * 8;
        bf16x8 qf[4];
#pragma unroll
        for (int ds = 0; ds < 4; ++ds) qf[ds] = *(const GAS bf16x8*)(qp + ds * 16);
        const float nm = -QN[(size_t)qrow * 8 + h * 2 + c] * __builtin_bit_cast(float, kmax[seq * 8 + h * 2 + c]);
        f32x16 O[4];
#pragma unroll
        for (int d = 0; d < 4; ++d) O[d] = (f32x16){};
        float lsum = 0.f;
#pragma unroll 2
        for (int kt = 0; kt < ntile; ++kt) {
            const int kb = kbeg + kt * 32;
            const bf16* kp = KB + (size_t)(krow0 + kb + r32) * 512 + h * 128 + c * 64 + hi * 8;
            f32x16 S;
#pragma unroll
            for (int r = 0; r < 16; ++r) S[r] = nm;
#pragma unroll
            for (int ds = 0; ds < 4; ++ds) { const bf16x8 kf = *(const GAS bf16x8*)(kp + ds * 16); S = __builtin_amdgcn_mfma_f32_32x32x16_bf16(kf, qf[ds], S, 0, 0, 0); }
            bf16x8 pa[2];
#pragma unroll
            for (int s2 = 0; s2 < 2; ++s2) { unsigned w[4];
#pragma unroll
                for (int i = 0; i < 4; ++i) { const float a = __builtin_amdgcn_exp2f(S[8 * s2 + 2 * i]), b = __builtin_amdgcn_exp2f(S[8 * s2 + 2 * i + 1]); lsum += a + b; w[i] = pk2(a, b); }
                pa[s2] = __builtin_bit_cast(bf16x8, (v4u){w[0], w[1], w[2], w[3]}); }
#pragma unroll
            for (int s2 = 0; s2 < 2; ++s2)
#pragma unroll
                for (int d = 0; d < 4; ++d) { const bf16* vp = VT + (size_t)(d * 32 + r32) * Lk + kb + 16 * s2 + 4 * hi;
                    const u32x2 lo = *(const GAS u32x2*)vp, hh = *(const GAS u32x2*)(vp + 8);
                    const bf16x8 vf = __builtin_bit_cast(bf16x8, (v4u){lo.x, lo.y, hh.x, hh.y});
                    O[d] = __builtin_amdgcn_mfma_f32_32x32x16_bf16(pa[s2], vf, O[d], 0, 0, 0); }
        }
        lsum += __shfl_xor(lsum, 32);
        if (hi == 0) lds_fadd(LB + (qs * 32 + r32) * 2 + c, lsum);
#pragma unroll
        for (int d = 0; d < 4; ++d)
#pragma unroll
            for (int r = 0; r < 16; ++r) lds_fadd(OB + ((qs * 32 + crow(r, hi)) * 2 + c) * 128 + d * 32 + r32, O[d][r]);
    }
    WG_BAR();
    {
        const int row = tid >> 3, d0 = (tid & 7) * 16;
        const float lam = ((const float*)(ws + WS_SCAL))[l], lam_init = 0.8f - 0.6f * expf(-0.3f * (float)l);
        const float i0 = 1.0f / LB[row * 2], i1 = lam / LB[row * 2 + 1];
        float o[16]; float ss = 0.f;
#pragma unroll
        for (int i = 0; i < 16; ++i) { o[i] = OB[(row * 2) * 128 + d0 + i] * i0 - OB[(row * 2 + 1) * 128 + d0 + i] * i1; ss += o[i] * o[i]; }
#pragma unroll
        for (int of = 1; of < 8; of <<= 1) ss += __shfl_xor(ss, of);
        const float sc = (1.0f - lam_init) / sqrtf(ss * (1.0f / 128.0f) + EPS);
        const float* g = A.in[I_AOG] + l * 128 + d0;
        unsigned w[8];
#pragma unroll
        for (int i = 0; i < 8; ++i) w[i] = pk2(o[2 * i] * sc * g[2 * i], o[2 * i + 1] * sc * g[2 * i + 1]);
        bf16* mp = (bf16*)(ws + WS_MIX) + (size_t)(qrow0 + row) * DM + 512 + h * 128 + d0;
        *(GAS v4u*)mp = (v4u){w[0], w[1], w[2], w[3]}; *(GAS v4u*)(mp + 8) = (v4u){w[4], w[5], w[6], w[7]};
    }
    WG_BAR();
}
__device__ __forceinline__ void fourier_unit(const KArgs& A, int seq, int g, int rb, LAS unsigned char* lds, int tid, int wave, int lane) {
    unsigned char* ws = A.ws;
    const bool lat = seq >= 32; const int L = lat ? 1024 : 256;
    const bf16* TW = lat ? (const bf16*)(ws + WS_TW1024) : (const bf16*)(ws + WS_TW256);
    const bf16* Y = lat ? (const bf16*)(ws + WS_YTL) + (size_t)(((seq - 32) * 4 + g) * 128) * 1024 : (const bf16*)(ws + WS_YTC) + (size_t)((seq * 4 + g) * 128) * 256;
    const int row0 = (lat ? M_CTX + (seq - 32) * 1024 : seq * 256) + rb * 64;
    const int tile = wave & 3, rt = tile >> 1, dt = tile & 1, kh = wave >> 2, r32 = lane & 31, hi = lane >> 5;
    LAS float* C = (LAS float*)lds;
    for (int i = tid; i < 1024; i += 512) *(LAS v4u*)(lds + i * 16) = (v4u){0u, 0u, 0u, 0u};
    const bf16* ap = TW + (size_t)(rb * 64 + rt * 32 + r32) * (2 * L) + kh * L + hi * 8;
    const bf16* bp = Y + (size_t)(kh * 64 + dt * 32 + r32) * L + hi * 8;
    f32x16 acc = {};
    WG_BAR();
#pragma unroll 4
    for (int ks = 0; ks < L / 16; ++ks) { const bf16x8 a = *(const GAS bf16x8*)(ap + ks * 16), b = *(const GAS bf16x8*)(bp + ks * 16); acc = __builtin_amdgcn_mfma_f32_32x32x16_bf16(a, b, acc, 0, 0, 0); }
#pragma unroll
    for (int r = 0; r < 16; ++r) lds_fadd(C + (rt * 32 + crow(r, hi)) * 64 + dt * 32 + r32, acc[r]);
    WG_BAR();
    { const int row = tid >> 3, d0 = (tid & 7) * 8; const float s = lat ? (1.0f / 256.0f) : (1.0f / 128.0f);
      const LAS float* c = C + row * 64 + d0;
      bf16* mp = (bf16*)(ws + WS_MIX) + (size_t)(row0 + row) * DM + 256 + g * 64 + d0;
      *(GAS v4u*)mp = (v4u){pk2(c[0] * s, c[1] * s), pk2(c[2] * s, c[3] * s), pk2(c[4] * s, c[5] * s), pk2(c[6] * s, c[7] * s)}; }
    WG_BAR();
}
__device__ __forceinline__ void pool_unit(const KArgs& A, int l, int chunk, int g, LAS unsigned char* lds, int tid) {
    unsigned char* ws = A.ws; const bf16* U = (const bf16*)(ws + WS_U);
    const int row0 = chunk * 64;
    int sstart, L; if (row0 < M_CTX) { sstart = row0 & ~255; L = 256; } else { sstart = M_CTX + ((row0 - M_CTX) & ~1023); L = 1024; }
    const int t0 = row0 - sstart, half = 1 << g;
    LAS float* P = (LAS float*)lds;
    LAS float* Dm = P + 80 * 64;
    LAS float* W = Dm + 64 * 65;
    for (int e = tid; e < 80 * 64; e += 512) { const int ri = e >> 6, ch = e & 63, pos = t0 - 8 + ri;
        P[e] = (pos >= 0 && pos < L) ? bf2f(U[(size_t)(sstart + pos) * NIN + g * 64 + ch]) : 0.f; }
    for (int e = tid; e < 4096; e += 512) W[e] = A.in[I_POOLW][(size_t)(l * 4 + g) * 4096 + e];
    WG_BAR();
    for (int e = tid; e < 4096; e += 512) { const int t = e >> 6, ch = e & 63, pos = t0 + t; const int lo = max(pos - half, 0), hh = min(pos + half, L);
        float s = 0.f; for (int jj = lo; jj < hh; ++jj) s += P[(jj - t0 + 8) * 64 + ch];
        Dm[t * 65 + ch] = s / (float)(hh - lo) - P[(t + 8) * 64 + ch]; }
    WG_BAR();
    { const int t = tid >> 3, d0 = (tid & 7) * 8; float o[8];
#pragma unroll
      for (int i = 0; i < 8; ++i) o[i] = 0.f;
      for (int c = 0; c < 64; ++c) { const float dv = Dm[t * 65 + c];
#pragma unroll
          for (int i = 0; i < 8; ++i) o[i] += dv * W[c * 64 + d0 + i]; }
      const float* ps = A.in[I_POOLS] + l * 256 + g * 64 + d0;
      bf16* mp = (bf16*)(ws + WS_MIX) + (size_t)(row0 + t) * DM + g * 64 + d0;
      *(GAS v4u*)mp = (v4u){pk2(o[0] * ps[0], o[1] * ps[1]), pk2(o[2] * ps[2], o[3] * ps[3]), pk2(o[4] * ps[4], o[5] * ps[5]), pk2(o[6] * ps[6], o[7] * ps[7])}; }
    WG_BAR();
}
constexpr int MX_LATT = 2 * 4 * 16, MX_LFOU = 2 * 4 * 16, MX_CATT = 32 * 4 * 4, MX_CFOU = 32 * 4 * 4, MX_POOL = (M_TOK / 64) * 4;
constexpr int MX_ITEMS = MX_LATT + MX_LFOU + MX_CATT + MX_CFOU + MX_POOL;
__device__ __forceinline__ void mix_phase(const KArgs& A, int l, LAS unsigned char* lds, int vcu, int G, int tid, int wave, int lane) {
    for (int it = vcu; it < MX_ITEMS; it += G) {
        int r = it;
        if (r < MX_LATT) { attn_unit(A, l, 32 + (r >> 6), (r >> 4) & 3, r & 15, lds, tid, wave, lane); continue; } r -= MX_LATT;
        if (r < MX_LFOU) { fourier_unit(A, 32 + (r >> 6), (r >> 4) & 3, r & 15, lds, tid, wave, lane); continue; } r -= MX_LFOU;
        if (r < MX_CATT) { attn_unit(A, l, r >> 4, (r >> 2) & 3, r & 3, lds, tid, wave, lane); continue; } r -= MX_CATT;
        if (r < MX_CFOU) { fourier_unit(A, r >> 4, (r >> 2) & 3, r & 3, lds, tid, wave, lane); continue; } r -= MX_CFOU;
        pool_unit(A, l, r >> 2, r & 3, lds, tid);
    }
}
#define CAS __attribute__((address_space(4)))
template <int PH> __device__ __forceinline__ void run_phase(const KArgs& A, LAS unsigned char* lds, int tid, int lane, int wave, int G, int bx, int vcu, int gw, int NGW) {
    unsigned char* ws = A.ws;
    float* X = A.out;
    const float* mods = (const float*)(ws + WS_CTL) + CW_MODS;
    bf16* XN = (bf16*)(ws + WS_XN); bf16* GBUF = (bf16*)(ws + WS_GB); bf16* UB = (bf16*)(ws + WS_U); bf16* MIXB = (bf16*)(ws + WS_MIX);
    if constexpr (PH == 0) {
#ifndef SKIP_P0
        p0_prologue(A, lds, gw, NGW, wave, lane);
#endif
    } else {
        constexpr int l = (PH - 1) / 11, k = (PH - 1) % 11;
        const float* mods_l = mods + (size_t)l * 3 * 9216;
        unsigned char* wl = ws + WS_W + (size_t)l * SZ_WLAYER;
        const float* ng = A.in[I_NG] + (size_t)l * 3 * DM;
        if constexpr (k == 0) { if (l == 0) norm_phase(A.in[I_XP], A.in[I_XS], XN, ng, mods_l, 0, gw, NGW, lane); else norm_phase(X, X + OUT_YS, XN, ng, mods_l, 0, gw, NGW, lane); }
        else if constexpr (k == 3) norm_phase(X, X + OUT_YS, XN, ng + DM, mods_l, 1, gw, NGW, lane);
        else if constexpr (k == 8) norm_phase(X, X + OUT_YS, XN, ng + 2 * DM, mods_l, 2, gw, NGW, lane);
        else if constexpr (k == 1 || k == 9) {
            pg8::Gemm g{XN, (const bf16*)(wl + (k == 1 ? OFF_WI1 : OFF_WI2)), M_TOK, NWI, DM}; pg8::StaticOrder S; S.init(M_TOK, NWI, G, bx);
            pg8::EpiSwiglu E{GBUF, FF};
            pg8::gemm_phase<pg8::EpiSwiglu, pg8::StaticOrder, true, true>(lds, g, S, E);
        } else if constexpr (k == 2 || k == 10) {
            pg8::Gemm g{GBUF, (const bf16*)(wl + (k == 2 ? OFF_WO1 : OFF_WO2)), M_TOK, DM, FF}; pg8::StaticOrder S; S.init(M_TOK, DM, G, bx);
            constexpr bool first = (k == 2 && l == 0);
            pg8::EpiResGate E{first ? A.in[I_XP] : X, first ? A.in[I_XS] : X + OUT_YS, X, mods_l, k == 2 ? 2 : 8, 0.5f};
            pg8::gemm_phase<pg8::EpiResGate, pg8::StaticOrder, true, true>(lds, g, S, E);
        } else if constexpr (k == 4) {
            pg8::Gemm g{XN, (const bf16*)(wl + OFF_WIN), M_TOK, NIN, DM}; pg8::StaticOrder S; S.init(M_TOK, NIN, G, bx);
            pg8::EpiU E{UB, A.out + OUT_V, l};
            pg8::gemm_phase<pg8::EpiU, pg8::StaticOrder, true, true>(lds, g, S, E);
        } else if constexpr (k == 5) {
#ifndef SKIP_PREP
            prep_phase(A, l, lds, gw, NGW, wave, lane);
#endif
        } else if constexpr (k == 6) {
#ifndef SKIP_MIX
            mix_phase(A, l, lds, vcu, G, tid, wave, lane);
#endif
        } else if constexpr (k == 7) {
            pg8::Gemm g{MIXB, (const bf16*)(wl + OFF_WOUT), M_TOK, DM, DM}; pg8::StaticOrder S; S.init(M_TOK, DM, G, bx);
            pg8::EpiResGate E{X, X + OUT_YS, X, mods_l, 5, 1.0f};
            pg8::gemm_phase<pg8::EpiResGate, pg8::StaticOrder, true, true>(lds, g, S, E);
        }
    }
}
__global__ void __launch_bounds__(NWAVES * 64, 2) hyb_fwd(KArgs A) {
    extern __shared__ __attribute__((aligned(16))) unsigned char lds_raw[];
    LAS unsigned char* lds = (LAS unsigned char*)lds_raw;
    volatile LAS unsigned* MISC = (volatile LAS unsigned*)(lds + MISC_OFF);
    const int tid = threadIdx.x, lane = tid & 63, wave = __builtin_amdgcn_readfirstlane(tid >> 6);
    const int G = gridDim.x, bx = blockIdx.x, vcu = (G % 8 == 0) ? (bx % 8) * (G / 8) + bx / 8 : bx;
    const int gw = vcu * NWAVES + wave, NGW = G * NWAVES;
    gu32* ctl = (gu32*)(A.ws + WS_CTL);
    for (int u = tid; u < (LDS_BYTES - LDSCTL_OFF) / 4; u += NWAVES * 64) ((LAS unsigned*)(lds + LDSCTL_OFF))[u] = 0u;
    __syncthreads();
    const int lo = A.ph_lo, hi = A.ph_hi;
    XcdBarrier bar; bar.bar = (unsigned*)(ctl + CW_BAR); bar.x = 0; bar.st = nullptr;
    if (hi - lo > 1) bar = xcd_barrier_post((unsigned*)(ctl + CW_BAR), MISC + 8);
#define PHASE(P) if (lo <= (P) && (P) < hi) { run_phase<P>(A, lds, tid, lane, wave, G, bx, vcu, gw, NGW); if ((P) + 1 < hi) xcd_barrier(bar); }
    PHASE(0) PHASE(1) PHASE(2) PHASE(3) PHASE(4) PHASE(5) PHASE(6) PHASE(7) PHASE(8) PHASE(9) PHASE(10) PHASE(11)
    PHASE(12) PHASE(13) PHASE(14) PHASE(15) PHASE(16) PHASE(17) PHASE(18) PHASE(19) PHASE(20) PHASE(21) PHASE(22)
#undef PHASE
}

#ifndef N_LAUNCH_MODE
#define N_LAUNCH_MODE 1
#endif
extern "C" void kernel_launch(void* const* d_in, const int* in_sizes, int n_in, void* d_out, int out_size, void* d_ws, size_t ws_size, hipStream_t stream) {
    static int grid = 0;
    if (grid == 0) {
        if (n_in != 25 || ws_size < WS_END) { fprintf(stderr, "kernel_launch: unexpected n_in %d / ws %zu\n", n_in, ws_size); grid = -1; return; }
        int dev = 0, cus = 0, per_cu = 0;
        if (hipGetDevice(&dev) != hipSuccess || hipDeviceGetAttribute(&cus, hipDeviceAttributeMultiprocessorCount, dev) != hipSuccess) { grid = -1; return; }
        if (hipFuncSetAttribute((const void*)hyb_fwd, hipFuncAttributeMaxDynamicSharedMemorySize, LDS_BYTES) != hipSuccess) { fprintf(stderr, "kernel_launch: hipFuncSetAttribute failed\n"); grid = -1; return; }
        if (hipOccupancyMaxActiveBlocksPerMultiprocessor(&per_cu, (const void*)hyb_fwd, NWAVES * 64, LDS_BYTES) != hipSuccess || per_cu < 1) { fprintf(stderr, "kernel_launch: occupancy query says %d blocks per CU\n", per_cu); }
        (void)hipGetLastError();
        grid = cus;
    }
    if (grid < 0) return;
    if (hipMemsetAsync((char*)d_ws + WS_CTL, 0, CTL_ZERO_BYTES, stream) != hipSuccess) return;
    KArgs a{};
    for (int i = 0; i < 25; ++i) a.in[i] = (const float*)d_in[i];
    a.out = (float*)d_out; a.ws = (unsigned char*)d_ws;
#if N_LAUNCH_MODE == 0
    for (int p = 0; p < NPHASES; ++p) { a.ph_lo = p; a.ph_hi = p + 1; hipLaunchKernelGGL(hyb_fwd, dim3(grid), dim3(NWAVES * 64), LDS_BYTES, stream, a); }
#else
    a.ph_lo = 0; a.ph_hi = NPHASES; hipLaunchKernelGGL(hyb_fwd, dim3(grid), dim3(NWAVES * 64), LDS_BYTES, stream, a);
#endif
}
```

```cpp
#include <hip/hip_runtime.h>
#include <cstdio>
#include <cstdint>
namespace pg8 {
#define PG8_LAS __attribute__((address_space(3)))
typedef unsigned short bf16_t;
typedef short bf16x8 __attribute__((ext_vector_type(8)));
typedef float f32x4 __attribute__((ext_vector_type(4)));
typedef unsigned u32x4 __attribute__((ext_vector_type(4)));
constexpr int BM = 256, BK = 64, HALF = 128, HTB = HALF * BK * 2  , STAGE_BYTES = 8 * HTB, NXCD = 8, WGM = 8;

__host__ __device__ __forceinline__ int lds_byte(int r, int c) { const int st = (r >> 4) * 2 + (c >> 5), rr = r & 15, cc = c & 31, ob = rr * 64 + cc * 2; return st * 1024 + (ob ^ (((ob >> 9) & 1) << 5)); }
__host__ __device__ __forceinline__ void stage_rc(int b, int& R, int& C) { const int st = b / 1024, sb = b % 1024, swz = sb ^ (((sb >> 9) & 1) << 5); R = (st >> 1) * 16 + swz / 64; C = (st & 1) * 32 + (swz % 64) / 2; }
__host__ __device__ __forceinline__ int perm32(int rho) { const int n = rho >> 4, i = rho & 15; return 8 * (i >> 2) + 4 * n + (i & 3); }

struct Unit { int pm, pn; };
struct Gemm { const bf16_t* A; const bf16_t* Bt; int M, N, K; };

struct StaticOrder {
    int nM, nN, nwg, G, c;
    __host__ __device__ void init(int M, int N, int G_, int c_) { nM = M / BM; nN = N / BM; nwg = nM * nN; G = G_; c = c_; }
    __host__ __device__ bool next(int i, Unit& u) const {
        const long L = (long)i * G + c; if (L >= nwg) return false;
        int wgid = (int)L; { const int q = nwg / NXCD, r = nwg % NXCD, xcd = wgid % NXCD, off = wgid / NXCD; wgid = (xcd < r ? xcd * (q + 1) : r * (q + 1) + (xcd - r) * q) + off; }
        const int nig = WGM * nN, gid = wgid / nig, fm = gid * WGM, gsz = (nM - fm) < WGM ? (nM - fm) : WGM;
        u.pm = fm + ((wgid % nig) % gsz); u.pn = (wgid % nig) / gsz; return true;
    }
    __device__ __forceinline__ void a_ready(const Unit&) const {}
    __device__ __forceinline__ void done(const Unit&) const {}
};

__device__ __forceinline__ unsigned cvt_pk_bf16(float lo, float hi) { unsigned r; asm volatile("v_cvt_pk_bf16_f32 %0, %1, %2" : "=v"(r) : "v"(lo), "v"(hi)); return r; }
typedef float f32x2 __attribute__((ext_vector_type(2)));
template <class Epi, class Sched, bool ALIGN_EPI = false, bool SP2 = false>
__device__ __forceinline__ void gemm_phase(PG8_LAS unsigned char* lds, const Gemm g, const Sched& S, const Epi& E) {
    const int tid = threadIdx.x, wid = __builtin_amdgcn_readfirstlane(tid >> 6), lane = tid & 63, wr = wid >> 2, wc = wid & 3, fr = lane & 15, fq = lane >> 4;
    const int K = g.K, nt = K / BK;
    unsigned voffA[2], voffB[2];
#pragma unroll
    for (int i = 0; i < 2; ++i) { int R, C; stage_rc(tid * 16 + i * 8192, R, C); const int Rb = Epi::PERM ? ((R & ~31) + perm32(R & 31)) : R;
        voffA[i] = (unsigned)(R * K + C) * 2u; voffB[i] = (unsigned)(Rb * K + C) * 2u; }
    const size_t kstep = (size_t)(BK * 2);
    const size_t hstep = (size_t)HALF * K * 2;
    const size_t tstep = 2 * hstep;
    const unsigned ldsw = (unsigned)wid * 1024u;
    const int aoff = lds_byte(wr * 64 + fr, fq * 8), boff = lds_byte(wc * 32 + fr, fq * 8);
#define PG8_SA(b, h) (((b) * 2 + (h)) * HTB)
#define PG8_SB(b, h) ((4 + (b) * 2 + (h)) * HTB)
#define PG8_STAGE(bufoff, gbase, voff) do { _Pragma("unroll") for (int _i = 0; _i < 2; ++_i) \
        __builtin_amdgcn_global_load_lds((const unsigned*)((const char*)(gbase) + (voff)[_i]), (PG8_LAS unsigned*)(lds + (bufoff) + ldsw + _i * 8192), 16, 0, 0); } while (0)
#define PG8_LDA(dst, b, h) do { _Pragma("unroll") for (int m = 0; m < 4; ++m) _Pragma("unroll") for (int k = 0; k < 2; ++k) dst[m][k] = *(const PG8_LAS bf16x8*)(lds + PG8_SA(b, h) + aoff + m * 2048 + k * 1024); } while (0)
#define PG8_LDB(dst, b, h) do { _Pragma("unroll") for (int n = 0; n < 2; ++n) _Pragma("unroll") for (int k = 0; k < 2; ++k) dst[n][k] = *(const PG8_LAS bf16x8*)(lds + PG8_SB(b, h) + boff + n * 2048 + k * 1024); } while (0)
#define PG8_MMA(ai, bj, At, Bt) do { __builtin_amdgcn_s_setprio(1); _Pragma("unroll") for (int m = 0; m < 4; ++m) _Pragma("unroll") for (int n = 0; n < 2; ++n) _Pragma("unroll") for (int k = 0; k < 2; ++k) \
        acc[ai][bj][m][n] = __builtin_amdgcn_mfma_f32_16x16x32_bf16(Bt[n][k], At[m][k], acc[ai][bj][m][n], 0, 0, 0); __builtin_amdgcn_s_setprio(0); } while (0)
#define PG8_WAIT_V(n) asm volatile("s_waitcnt vmcnt(" #n ")" ::: "memory")
#define PG8_WAIT_L(n) asm volatile("s_waitcnt lgkmcnt(" #n ")" ::: "memory")
#define PG8_BAR __builtin_amdgcn_s_barrier()
#define PG8_SCHED __builtin_amdgcn_sched_barrier(0)
    Unit cur, nxt; int ui = 0;
    if (!S.next(0, cur)) return;
    f32x4 acc[2][2][4][2];
#pragma unroll
    for (int a = 0; a < 2; ++a)
#pragma unroll
        for (int b = 0; b < 2; ++b)
#pragma unroll
            for (int m = 0; m < 4; ++m)
#pragma unroll
                for (int n = 0; n < 2; ++n) acc[a][b][m][n] = (f32x4){0.f, 0.f, 0.f, 0.f};
    bf16x8 At[4][2], B0[2][2], B1[2][2];
    const char* cA = (const char*)g.A + (size_t)cur.pm * tstep; const char* cB = (const char*)g.Bt + (size_t)cur.pn * tstep;
    S.a_ready(cur);
    if constexpr (SP2) {
        PG8_STAGE(PG8_SB(0, 0), cB, voffB); PG8_STAGE(PG8_SB(0, 1), cB + hstep, voffB); PG8_STAGE(PG8_SA(0, 0), cA, voffA); PG8_STAGE(PG8_SA(0, 1), cA + hstep, voffA);
        if (wr == 1) PG8_BAR;
        PG8_WAIT_V(2); PG8_BAR;
        PG8_STAGE(PG8_SB(1, 0), cB + kstep, voffB); PG8_STAGE(PG8_SA(1, 0), cA + kstep, voffA); PG8_STAGE(PG8_SB(1, 1), cB + hstep + kstep, voffB);
        PG8_WAIT_V(6); PG8_BAR;
    } else {
        PG8_STAGE(PG8_SB(0, 0), cB, voffB); PG8_STAGE(PG8_SA(0, 0), cA, voffA); PG8_STAGE(PG8_SB(0, 1), cB + hstep, voffB); PG8_STAGE(PG8_SA(0, 1), cA + hstep, voffA);
        if (wr == 1) PG8_BAR;
        PG8_WAIT_V(4); PG8_BAR;
        PG8_STAGE(PG8_SB(1, 0), cB + kstep, voffB); PG8_STAGE(PG8_SA(1, 0), cA + kstep, voffA); PG8_STAGE(PG8_SB(1, 1), cB + hstep + kstep, voffB);
        PG8_WAIT_V(6); PG8_BAR;
    }
    for (;;) {
        const bool has_next = S.next(ui + 1, nxt);
        const char* nA = has_next ? (const char*)g.A + (size_t)nxt.pm * tstep : cA; const char* nB = has_next ? (const char*)g.Bt + (size_t)nxt.pn * tstep : cB;
        for (int t = 0; t < nt; t += 2) {
            const bool last = (t == nt - 2);
            const char* a1 = cA + (size_t)(t + 1) * kstep;
            const char* a2 = last ? nA : cA + (size_t)(t + 2) * kstep; const char* b2 = last ? nB : cB + (size_t)(t + 2) * kstep;
            const char* a3 = a2 + kstep; const char* b3 = b2 + kstep;
            if (last && has_next) S.a_ready(nxt);
            if constexpr (SP2) {
            PG8_LDB(B0, 0, 0); PG8_LDB(B1, 0, 1); PG8_SCHED; PG8_LDA(At, 0, 0); PG8_STAGE(PG8_SA(1, 1), a1 + hstep, voffA);
            PG8_WAIT_V(8); PG8_WAIT_L(0); PG8_BAR; PG8_MMA(0, 0, At, B0); PG8_MMA(0, 1, At, B1); PG8_BAR; PG8_SCHED;
            PG8_LDA(At, 0, 1); PG8_STAGE(PG8_SB(0, 0), b2, voffB); PG8_STAGE(PG8_SB(0, 1), b2 + hstep, voffB); PG8_STAGE(PG8_SA(0, 0), a2, voffA);
            PG8_WAIT_V(8); PG8_WAIT_L(0); PG8_BAR; PG8_MMA(1, 0, At, B0); PG8_MMA(1, 1, At, B1); PG8_BAR; PG8_SCHED;
            PG8_LDB(B0, 1, 0); PG8_LDB(B1, 1, 1); PG8_SCHED; PG8_LDA(At, 1, 0); PG8_STAGE(PG8_SA(0, 1), a2 + hstep, voffA);
            PG8_WAIT_V(8); PG8_WAIT_L(0); PG8_BAR; PG8_MMA(0, 0, At, B0); PG8_MMA(0, 1, At, B1); PG8_BAR; PG8_SCHED;
            PG8_LDA(At, 1, 1); PG8_STAGE(PG8_SB(1, 0), b3, voffB); PG8_STAGE(PG8_SB(1, 1), b3 + hstep, voffB); PG8_STAGE(PG8_SA(1, 0), a3, voffA);
            PG8_WAIT_V(8); PG8_WAIT_L(0); PG8_BAR; PG8_MMA(1, 0, At, B0); PG8_MMA(1, 1, At, B1); PG8_BAR; PG8_SCHED;
            } else {
            PG8_LDB(B0, 0, 0); PG8_SCHED; PG8_LDA(At, 0, 0); PG8_STAGE(PG8_SA(1, 1), a1 + hstep, voffA);
            PG8_WAIT_L(8); PG8_BAR; PG8_WAIT_L(0); PG8_MMA(0, 0, At, B0); PG8_BAR; PG8_SCHED;
            PG8_LDB(B1, 0, 1); PG8_STAGE(PG8_SB(0, 0), b2, voffB);
            PG8_BAR; PG8_WAIT_L(0); PG8_MMA(0, 1, At, B1); PG8_BAR;
            PG8_LDA(At, 0, 1); PG8_STAGE(PG8_SA(0, 0), a2, voffA);
            PG8_BAR; PG8_WAIT_L(0); PG8_MMA(1, 0, At, B0); PG8_BAR; PG8_SCHED;
            PG8_STAGE(PG8_SB(0, 1), b2 + hstep, voffB);
            PG8_WAIT_V(6); PG8_BAR; PG8_MMA(1, 1, At, B1); PG8_BAR;
            PG8_LDB(B0, 1, 0); PG8_SCHED; PG8_LDA(At, 1, 0); PG8_STAGE(PG8_SA(0, 1), a2 + hstep, voffA);
            PG8_WAIT_L(8); PG8_BAR; PG8_WAIT_L(0); PG8_MMA(0, 0, At, B0); PG8_BAR; PG8_SCHED;
            PG8_LDB(B1, 1, 1); PG8_STAGE(PG8_SB(1, 0), b3, voffB);
            PG8_BAR; PG8_WAIT_L(0); PG8_MMA(0, 1, At, B1); PG8_BAR;
            PG8_LDA(At, 1, 1); PG8_STAGE(PG8_SA(1, 0), a3, voffA);
            PG8_BAR; PG8_WAIT_L(0); PG8_MMA(1, 0, At, B0); PG8_BAR; PG8_SCHED;
            PG8_STAGE(PG8_SB(1, 1), b3 + hstep, voffB);
            PG8_WAIT_V(6); PG8_BAR; PG8_MMA(1, 1, At, B1); PG8_BAR;
            }
        }
        if constexpr (ALIGN_EPI) { if (wr == 0) PG8_BAR; }
        if constexpr (!Epi::AFTER_DRAIN) { E(acc, cur, wr, wc, fr, fq); S.done(cur); }
        if (!has_next) break;
#pragma unroll
        for (int a = 0; a < 2; ++a)
#pragma unroll
            for (int b = 0; b < 2; ++b)
#pragma unroll
                for (int m = 0; m < 4; ++m)
#pragma unroll
                    for (int n = 0; n < 2; ++n) acc[a][b][m][n] = (f32x4){0.f, 0.f, 0.f, 0.f};
        cur = nxt; cA = nA; cB = nB; ++ui;
        if constexpr (ALIGN_EPI) { if (wr == 1) PG8_BAR; }
    }
    PG8_WAIT_V(0);
    if constexpr (!ALIGN_EPI) { if (wr == 0) PG8_BAR; }
    PG8_BAR;
    if constexpr (Epi::AFTER_DRAIN) { E.fused(acc, cur, wr, wc, fr, fq, lds, wid, lane); S.done(cur); }
#undef PG8_SA
#undef PG8_SB
#undef PG8_STAGE
#undef PG8_LDA
#undef PG8_LDB
#undef PG8_MMA
#undef PG8_WAIT_V
#undef PG8_WAIT_L
#undef PG8_BAR
#undef PG8_SCHED
}
}
constexpr int M_TOK = 10240, M_CTX = 8192, DM = 1024, FF = 2816, NWI = 5632, NIN = 2048;
constexpr int LCTX = 256, LLAT = 1024, LKLAT = 1280, NSEQ = 34;
constexpr float EPS = 1e-6f;

namespace pg8 {
__device__ __forceinline__ float silu_f(float x) { return x * __builtin_amdgcn_rcpf(1.0f + __builtin_amdgcn_exp2f(-1.4426950408889634f * x)); }
struct EpiSwiglu {
    static constexpr bool PERM = true, AFTER_DRAIN = false;
    bf16_t* O; int ldc;
    __device__ __forceinline__ void operator()(const f32x4 (&acc)[2][2][4][2], const Unit& u, int wr, int wc, int fr, int fq) const {
        const int row0 = u.pm * BM + wr * 64 + fr, col0 = u.pn * HALF + wc * 32 + 8 * fq;
#pragma unroll
        for (int ai = 0; ai < 2; ++ai)
#pragma unroll
            for (int m = 0; m < 4; ++m) { bf16_t* rowp = O + (size_t)(row0 + ai * HALF + m * 16) * ldc + col0;
                const f32x4 a0 = acc[ai][0][m][0], a1 = acc[ai][0][m][1], b0 = acc[ai][1][m][0], b1 = acc[ai][1][m][1];
                u32x4 w;
                w.x = cvt_pk_bf16(silu_f(a0[0]) * b0[0], silu_f(a0[1]) * b0[1]); w.y = cvt_pk_bf16(silu_f(a0[2]) * b0[2], silu_f(a0[3]) * b0[3]);
                w.z = cvt_pk_bf16(silu_f(a1[0]) * b1[0], silu_f(a1[1]) * b1[1]); w.w = cvt_pk_bf16(silu_f(a1[2]) * b1[2], silu_f(a1[3]) * b1[3]);
                *(u32x4*)rowp = w; }
    }
};
struct EpiResGate {
    static constexpr bool PERM = false, AFTER_DRAIN = false;
    const float* base0; const float* base1;
    float* out; const float* mods;
    int idx; float gs;
    __device__ __forceinline__ void operator()(const f32x4 (&acc)[2][2][4][2], const Unit& u, int wr, int wc, int fr, int fq) const {
        const int set = u.pm < 32 ? 0 : 1 + ((u.pm - 32) >> 2);
        const float* mv = mods + (size_t)(set * 9 + idx) * DM;
        const float* bp = u.pm < 32 ? base0 + (size_t)u.pm * BM * DM : base1 + (size_t)(u.pm - 32) * BM * DM;
        float* op = out + (size_t)u.pm * BM * DM;
        const int col0 = u.pn * BM + wc * 32 + 4 * fq;
        f32x4 gv[2][2];
#pragma unroll
        for (int bj = 0; bj < 2; ++bj)
#pragma unroll
            for (int n = 0; n < 2; ++n) gv[bj][n] = *(const f32x4*)(mv + col0 + bj * HALF + n * 16) * gs;
#pragma unroll
        for (int ai = 0; ai < 2; ++ai)
#pragma unroll
            for (int m = 0; m < 4; ++m) { const size_t off = (size_t)(ai * HALF + wr * 64 + m * 16 + fr) * DM + col0;
#pragma unroll
                for (int bj = 0; bj < 2; ++bj)
#pragma unroll
                    for (int n = 0; n < 2; ++n) { const f32x4 b = *(const f32x4*)(bp + off + bj * HALF + n * 16);
                        *(f32x4*)(op + off + bj * HALF + n * 16) = b + gv[bj][n] * acc[ai][bj][m][n]; } }
    }
};
struct EpiU {
    static constexpr bool PERM = true, AFTER_DRAIN = false;
    bf16_t* U; float* outV; int layer;
    __device__ __forceinline__ void operator()(const f32x4 (&acc)[2][2][4][2], const Unit& u, int wr, int wc, int fr, int fq) const {
        const int row0 = u.pm * BM + wr * 64 + fr, col0 = u.pn * BM + wc * 32 + 8 * fq;
        const bool vout = (u.pn >= 6) && (u.pm < 32);
#pragma unroll
        for (int ai = 0; ai < 2; ++ai)
#pragma unroll
            for (int m = 0; m < 4; ++m) { const int row = row0 + ai * HALF + m * 16; bf16_t* rowp = U + (size_t)row * NIN + col0;
#pragma unroll
                for (int bj = 0; bj < 2; ++bj) { const f32x4 v0 = acc[ai][bj][m][0], v1 = acc[ai][bj][m][1];
                    u32x4 w; w.x = cvt_pk_bf16(v0[0], v0[1]); w.y = cvt_pk_bf16(v0[2], v0[3]); w.z = cvt_pk_bf16(v1[0], v1[1]); w.w = cvt_pk_bf16(v1[2], v1[3]);
                    *(u32x4*)(rowp + bj * HALF) = w;
                    if (vout) { float* vp = outV + ((size_t)((row >> 8) * 2 + layer) * 256 + (row & 255)) * 512 + (col0 + bj * HALF - 1536);
                        *(f32x4*)vp = v0; *(f32x4*)(vp + 4) = v1; } } }
    }
};
}
constexpr size_t MiB = 1u << 20;
constexpr size_t WS_CTL = 0, CTL_ZERO_BYTES = 512 * 1024;
constexpr size_t SZ_WI = (size_t)NWI * DM * 2, SZ_WO = (size_t)DM * FF * 2, SZ_WIN = (size_t)NIN * DM * 2, SZ_WOUT = (size_t)DM * DM * 2;
constexpr size_t WS_W = 2 * MiB;
constexpr size_t OFF_WI1 = 0, OFF_WO1 = OFF_WI1 + SZ_WI, OFF_WI2 = OFF_WO1 + SZ_WO, OFF_WO2 = OFF_WI2 + SZ_WI, OFF_WIN = OFF_WO2 + SZ_WO, OFF_WOUT = OFF_WIN + SZ_WIN, SZ_WLAYER = OFF_WOUT + SZ_WOUT;
constexpr size_t WS_TW1024 = 84 * MiB;
constexpr size_t WS_TW256 = 88 * MiB;
constexpr size_t WS_WCS = WS_TW256 + 512 * 1024;
constexpr size_t WS_ROPE = WS_WCS + 256 * 1024;
constexpr size_t WS_SCAL = WS_ROPE + 16 * 1024;
constexpr size_t WS_XN = 90 * MiB;
constexpr size_t WS_MIX = 110 * MiB;
constexpr size_t WS_GB = 130 * MiB;
constexpr size_t WS_U = 130 * MiB;
constexpr size_t WS_QB = 170 * MiB;
constexpr size_t WS_KB = 185 * MiB;
constexpr size_t WS_VTC = 196 * MiB;
constexpr size_t WS_VTL = 204 * MiB;
constexpr size_t WS_YTC = 207 * MiB;
constexpr size_t WS_YTL = 215 * MiB;
constexpr size_t WS_QN = 217 * MiB;
constexpr size_t WS_END = 218 * MiB;
static_assert(WS_W + 2 * SZ_WLAYER <= WS_TW1024 && WS_SCAL + 64 <= WS_XN && WS_GB + (size_t)M_TOK * FF * 2 <= WS_KB && WS_QB + (size_t)M_TOK * 512 * 2 <= WS_KB, "ws map");
constexpr int CW_TMO = 0, CW_BAR = 4096, CW_KMAX = 8192  , CW_MODS = 16384  ;
static_assert((CW_MODS + 2 * 3 * 9 * 1024) * 4 <= (int)CTL_ZERO_BYTES, "ctl");
constexpr int RING_BYTES = 131072, LDSCTL_OFF = RING_BYTES, MISC_OFF = LDSCTL_OFF + 320, LDS_BYTES = 147456;
constexpr int NWAVES = 8;
constexpr int NPHASES = 23;
#define GAS __attribute__((address_space(1)))
#define LAS __attribute__((address_space(3)))
typedef unsigned short bf16;
typedef unsigned v4u __attribute__((ext_vector_type(4)));
typedef float f32x4 __attribute__((ext_vector_type(4)));
typedef short bf16x8 __attribute__((ext_vector_type(8)));
typedef GAS unsigned gu32;
typedef GAS unsigned long long gu64;
#define RLX_AGENT __ATOMIC_RELAXED, __HIP_MEMORY_SCOPE_AGENT
#define LDS_WAIT() asm volatile("s_waitcnt lgkmcnt(0)" ::: "memory")
#define VM_WAIT() asm volatile("s_waitcnt vmcnt(0)" ::: "memory")
__device__ __forceinline__ unsigned long long rt() { return __builtin_amdgcn_s_memrealtime(); }
__device__ __forceinline__ unsigned f2bf(float f) { unsigned u = __builtin_bit_cast(unsigned, f); return (u + 0x7fffu + ((u >> 16) & 1u)) >> 16; }
__device__ __forceinline__ unsigned pk2(float lo, float hi) { return f2bf(lo) | (f2bf(hi) << 16); }
#define XB_TMO      128
#define XB_XCNT(j)  (256  + 64 * (j))
#define XB_XSUB(j)  (1280 + 64 * (j))
#define XB_XGEN(j)  (2304 + 64 * (j))
#define XB_TOP      3328
#define XB_TOPGEN   3392
#define XCD_BAR_WORDS 3456
#define XB_SPIN_CAP (1u << 18)

__device__ __forceinline__ unsigned xb_ld(unsigned* p)              { return __hip_atomic_load(p, __ATOMIC_RELAXED, __HIP_MEMORY_SCOPE_AGENT); }
__device__ __forceinline__ unsigned xb_add(unsigned* p, unsigned v) { return __hip_atomic_fetch_add(p, v, __ATOMIC_RELAXED, __HIP_MEMORY_SCOPE_AGENT); }
__device__ __forceinline__ unsigned xb_xcc_id() { return (unsigned)__builtin_amdgcn_s_getreg((3 << 11) | 20) & 0xFu; }
#define XB_SPIN(cond, bar) do { unsigned _sp = 0; while (cond) { __builtin_amdgcn_s_sleep(1); \
    if ((++_sp & 255u) == 0u) { if (xb_ld(&(bar)[XB_TMO])) break; if (_sp > XB_SPIN_CAP) { atomicAdd(&(bar)[XB_TMO], 1u); break; } } } } while (0)

struct XcdBarrier {
    unsigned* bar; unsigned x;
    volatile LAS unsigned* st;
};

__device__ __forceinline__ XcdBarrier xcd_barrier_post(unsigned* bar, volatile LAS unsigned* st) {
    XcdBarrier b; b.bar = bar; b.x = xb_xcc_id(); b.st = st;
    if (threadIdx.x == 0) (void)xb_add(&bar[XB_XCNT(b.x)], 1u);
    return b;
}
__device__ __forceinline__ void xcd_barrier_complete(unsigned* bar, unsigned x, unsigned& nloc, unsigned& nx) {
    const unsigned G = gridDim.x * gridDim.y * gridDim.z;
    unsigned sum, cnt, mine, sp = 0u;
    for (;;) {
        sum = 0u; cnt = 0u; mine = 0u;
#pragma unroll
        for (unsigned j = 0; j < 16; ++j) { const unsigned c = xb_ld(&bar[XB_XCNT(j)]); sum += c; cnt += (c > 0u) ? 1u : 0u; mine = (j == x) ? c : mine; }
        if (sum == G) break;
        __builtin_amdgcn_s_sleep(1);
        if ((++sp & 255u) == 0u) { if (xb_ld(&bar[XB_TMO])) break; if (sp > XB_SPIN_CAP) { atomicAdd(&bar[XB_TMO], 1u); break; } }
    }
    nloc = mine > 0u ? mine : 1u; nx = cnt > 0u ? cnt : 1u;
}

__device__ __forceinline__ void xcd_barrier(const XcdBarrier& b) {
    asm volatile("s_waitcnt vmcnt(0)" ::: "memory");
    __syncthreads();
    if (threadIdx.x == 0) {
        unsigned* bar = b.bar;
        __builtin_amdgcn_s_waitcnt(0);
        unsigned nloc = b.st[0], nx = b.st[1];
        if (nloc == 0u) { xcd_barrier_complete(bar, b.x, nloc, nx); b.st[0] = nloc; b.st[1] = nx; }
        const unsigned old = xb_add(&bar[XB_XSUB(b.x)], 1u);
        const unsigned gen = old / nloc;
        if (old + 1u == (gen + 1u) * nloc) {
            __builtin_amdgcn_fence(__ATOMIC_RELEASE, "agent");
            asm volatile("s_waitcnt vmcnt(0)" ::: "memory");
            const unsigned og = xb_add(&bar[XB_TOP], 1u);
            const unsigned tg = og / nx;
            if (og + 1u == (tg + 1u) * nx) xb_add(&bar[XB_TOPGEN], 1u);
            else XB_SPIN(xb_ld(&bar[XB_TOPGEN]) == tg, bar);
            __builtin_amdgcn_fence(__ATOMIC_ACQUIRE, "agent");
            xb_add(&bar[XB_XGEN(b.x)], 1u);
            asm volatile("s_waitcnt vmcnt(0)" ::: "memory");
        } else {
            XB_SPIN(xb_ld(&bar[XB_XGEN(b.x)]) == gen, bar);
            __builtin_amdgcn_fence(__ATOMIC_ACQUIRE, "agent");
            asm volatile("s_waitcnt vmcnt(0)" ::: "memory");
        }
    }
    __syncthreads();
}
typedef float f32x16 __attribute__((ext_vector_type(16)));
typedef unsigned u32x2 __attribute__((ext_vector_type(2)));
__device__ __forceinline__ float bf2f(unsigned h) { return __builtin_bit_cast(float, h << 16); }
__device__ __forceinline__ float wave_sum(float v) {
#pragma unroll
    for (int o = 1; o < 64; o <<= 1) v += __shfl_xor(v, o);
    return v;
}
__device__ __forceinline__ int crow(int r, int hi) { return (r & 3) + 8 * (r >> 2) + 4 * hi; }
__device__ __forceinline__ float silu_acc(float x) { return x / (1.0f + expf(-x)); }

struct KArgs { const float* in[25]; float* out; unsigned char* ws; int ph_lo, ph_hi; };
enum { I_XP = 0, I_XS, I_CK, I_CV, I_C, I_CCTX, I_NG, I_ADAW, I_ADAB, I_F1WI, I_F1WO, I_F2WI, I_F2WO, I_WIN, I_WOUT, I_QG, I_KG, I_LQ1, I_LK1, I_LQ2, I_LK2, I_AOG, I_POOLW, I_POOLS, I_FNETW };
constexpr size_t OUT_YS = (size_t)M_CTX * DM, OUT_K = (size_t)M_TOK * DM, OUT_V = OUT_K + (size_t)32 * 2 * 256 * 512;

__device__ __forceinline__ void p0_transpose_item(const float* W, int K, int N, bf16* WT, bool swi, LAS float* scr, int item, int lane) {
    const int nblk = N / 32, kb = item / nblk, nb = item % nblk, k0 = 64 * kb, n0 = 32 * nb;
    int r0 = n0;
    if (swi) { const int half = n0 / FF, jj = n0 % FF; r0 = (jj / 128) * 256 + half * 128 + (jj % 128); }
#pragma unroll 8
    for (int i = 0; i < 32; ++i) { const int kk = 2 * i + (lane >> 5); scr[kk * 33 + (lane & 31)] = W[(size_t)(k0 + kk) * N + n0 + (lane & 31)]; }
    LDS_WAIT(); asm volatile("" ::: "memory");
    const int c = lane & 7;
#pragma unroll
    for (int j = 0; j < 4; ++j) { const int n = (lane >> 3) + 8 * j; const LAS float* s = scr + (8 * c) * 33 + n;
        v4u o; o.x = pk2(s[0 * 33], s[1 * 33]); o.y = pk2(s[2 * 33], s[3 * 33]); o.z = pk2(s[4 * 33], s[5 * 33]); o.w = pk2(s[6 * 33], s[7 * 33]);
        *(GAS v4u*)(WT + (size_t)(r0 + n) * K + k0 + 8 * c) = o; }
    LDS_WAIT(); asm volatile("" ::: "memory");
}
__device__ __forceinline__ void p0_mods_item(const KArgs& A, float* mods, int item, int lane) {
    const int l = item / 576, r = item % 576, kc = r / 36, cb = r % 36;
    const float* W = A.in[I_ADAW] + (size_t)l * DM * 9216 + (size_t)(kc * 64) * 9216 + cb * 256 + lane * 4;
    const int k = kc * 64 + lane;
    const float s0 = silu_acc(A.in[I_CCTX][k]), s1 = silu_acc(A.in[I_C][k]), s2 = silu_acc(A.in[I_C][DM + k]);
    f32x4 a0 = {0.f, 0.f, 0.f, 0.f}, a1 = a0, a2 = a0;
#pragma unroll 8
    for (int kk = 0; kk < 64; ++kk) {
        const f32x4 w = *(const f32x4*)(W + (size_t)kk * 9216);
        const float c0 = __builtin_bit_cast(float, __builtin_amdgcn_readlane(__builtin_bit_cast(int, s0), kk));
        const float c1 = __builtin_bit_cast(float, __builtin_amdgcn_readlane(__builtin_bit_cast(int, s1), kk));
        const float c2 = __builtin_bit_cast(float, __builtin_amdgcn_readlane(__builtin_bit_cast(int, s2), kk));
        a0 += w * c0; a1 += w * c1; a2 += w * c2;
    }
    if (kc == 0) { const f32x4 b = *(const f32x4*)(A.in[I_ADAB] + (size_t)l * 9216 + cb * 256 + lane * 4); a0 += b; a1 += b; a2 += b; }
    float* mp = mods + (size_t)l * 3 * 9216 + cb * 256 + lane * 4;
#pragma unroll
    for (int i = 0; i < 4; ++i) { atomicAdd(mp + i, a0[i]); atomicAdd(mp + 9216 + i, a1[i]); atomicAdd(mp + 2 * 9216 + i, a2[i]); }
}
__device__ __forceinline__ void p0_tw_item(bf16* TW, int L, int item, int lane) {
    const int nks = L / 16, ks = item % nks, kh = (item / nks) & 1, rt = item / (2 * nks), k = 32 * rt + (lane & 31), h = lane >> 5;
    unsigned w[4];
#pragma unroll
    for (int i = 0; i < 4; ++i) { float v[2];
#pragma unroll
        for (int e = 0; e < 2; ++e) { const int j = 2 * i + e, kk = 16 * ks + 8 * (j >> 2) + 4 * h + (j & 3); const int ang = (k * kk) & (L - 1);
            float sn, cs; sincospif(2.0f * (float)ang / (float)L, &sn, &cs); v[e] = kh ? sn : cs; }
        w[i] = pk2(v[0], v[1]); }
    *(GAS v4u*)(TW + (size_t)item * 512 + lane * 8) = (v4u){w[0], w[1], w[2], w[3]};
}
__device__ __forceinline__ void p0_wcs_item(const KArgs& A, bf16* WCS, int item, int lane) {
    const int lg = item >> 7, n = item & 127, d = n & 63; const bool sn = n >= 64;
    const float* Wf = A.in[I_FNETW] + (size_t)lg * 4096 + d;
    float acc = 0.f;
    for (int m = 0; m < 64; ++m) { float s, c; sincospif(2.0f * (float)((m * lane) & 63) / 64.0f, &s, &c); acc += (sn ? -s : c) * Wf[m * 64]; }
    WCS[(size_t)item * 64 + lane] = (bf16)f2bf(acc);
}
__device__ __forceinline__ void p0_misc_item(const KArgs& A, float* rope, float* scal, int lane) {
    for (int e = lane; e < 1024; e += 64) { const int pos = e >> 4, i = e & 15; const float inv = 1.0f / powf(10000.0f, (float)(2 * i) / 32.0f); const float ang = (float)pos * inv;
        rope[e] = cosf(ang); rope[1024 + e] = sinf(ang); }
#pragma unroll
    for (int l = 0; l < 2; ++l) {
        const float d1 = wave_sum(A.in[I_LQ1][l * 64 + lane] * A.in[I_LK1][l * 64 + lane]), d2 = wave_sum(A.in[I_LQ2][l * 64 + lane] * A.in[I_LK2][l * 64 + lane]);
        const float lam_init = 0.8f - 0.6f * expf(-0.3f * (float)l);
        if (lane == 0) scal[l] = expf(d1) - expf(d2) + lam_init;
    }
}
constexpr int IT_MODS = 2 * 16 * 36, IT_TWI = (DM / 64) * (NWI / 32), IT_TWO = (FF / 64) * (DM / 32), IT_TWIN = (DM / 64) * (NIN / 32), IT_TWOUT = (DM / 64) * (DM / 32);
constexpr int IT_TRL = 2 * IT_TWI + 2 * IT_TWO + IT_TWIN + IT_TWOUT;
constexpr int IT_TW1024 = 32 * 2 * 64, IT_TW256 = 8 * 2 * 16, IT_WCS = 2 * 4 * 128;
constexpr int P0_ITEMS = IT_MODS + 2 * IT_TRL + IT_TW1024 + IT_TW256 + IT_WCS + 1;
__device__ __forceinline__ void p0_prologue(const KArgs& A, LAS unsigned char* lds, int gw, int NGW, int wave, int lane, bool skip_mods = false) {
    LAS float* scr = (LAS float*)(lds + wave * 16384);
    unsigned char* ws = A.ws;
    float* mods = (float*)(ws + WS_CTL) + CW_MODS;
    for (int it = gw; it < P0_ITEMS; it += NGW) {
        int r = it;
        if (r < IT_MODS) { if (!skip_mods) p0_mods_item(A, mods, r, lane); continue; } r -= IT_MODS;
        if (r < 2 * IT_TRL) { const int l = r / IT_TRL; r %= IT_TRL; unsigned char* wl = ws + WS_W + (size_t)l * SZ_WLAYER;
            if (r < IT_TWI) { p0_transpose_item(A.in[I_F1WI] + (size_t)l * DM * NWI, DM, NWI, (bf16*)(wl + OFF_WI1), true, scr, r, lane); continue; } r -= IT_TWI;
            if (r < IT_TWO) { p0_transpose_item(A.in[I_F1WO] + (size_t)l * FF * DM, FF, DM, (bf16*)(wl + OFF_WO1), false, scr, r, lane); continue; } r -= IT_TWO;
            if (r < IT_TWI) { p0_transpose_item(A.in[I_F2WI] + (size_t)l * DM * NWI, DM, NWI, (bf16*)(wl + OFF_WI2), true, scr, r, lane); continue; } r -= IT_TWI;
            if (r < IT_TWO) { p0_transpose_item(A.in[I_F2WO] + (size_t)l * FF * DM, FF, DM, (bf16*)(wl + OFF_WO2), false, scr, r, lane); continue; } r -= IT_TWO;
            if (r < IT_TWIN) { p0_transpose_item(A.in[I_WIN] + (size_t)l * DM * NIN, DM, NIN, (bf16*)(wl + OFF_WIN), false, scr, r, lane); continue; } r -= IT_TWIN;
            p0_transpose_item(A.in[I_WOUT] + (size_t)l * DM * DM, DM, DM, (bf16*)(wl + OFF_WOUT), false, scr, r, lane); continue; }
        r -= 2 * IT_TRL;
        if (r < IT_TW1024) { p0_tw_item((bf16*)(ws + WS_TW1024), 1024, r, lane); continue; } r -= IT_TW1024;
        if (r < IT_TW256) { p0_tw_item((bf16*)(ws + WS_TW256), 256, r, lane); continue; } r -= IT_TW256;
        if (r < IT_WCS) { p0_wcs_item(A, (bf16*)(ws + WS_WCS), r, lane); continue; }
        p0_misc_item(A, (float*)(ws + WS_ROPE), (float*)(ws + WS_SCAL), lane);
    }
}
__device__ __forceinline__ void norm_phase(const float* x0, const float* x1, bf16* XN, const float* g, const float* mods_l, int sub, int gw, int NGW, int lane) {
    for (int m = gw; m < M_TOK; m += NGW) {
        const float* xrow = m < M_CTX ? x0 + (size_t)m * DM : x1 + (size_t)(m - M_CTX) * DM;
        const int set = m < M_CTX ? 0 : 1 + ((m - M_CTX) >> 10);
        const float* shift = mods_l + (size_t)(set * 9 + 3 * sub) * DM; const float* scale = shift + DM;
        const GAS f32x4* xr = (const GAS f32x4*)xrow + lane;
        f32x4 v[4]; float ss = 0.f;
#pragma unroll
        for (int j = 0; j < 4; ++j) { v[j] = xr[64 * j]; ss += (v[j].x * v[j].x + v[j].y * v[j].y) + (v[j].z * v[j].z + v[j].w * v[j].w); }
        const float rstd = 1.0f / sqrtf(wave_sum(ss) * (1.0f / DM) + EPS);
        GAS unsigned long long* o8 = (GAS unsigned long long*)(XN + (size_t)m * DM) + lane;
#pragma unroll
        for (int j = 0; j < 4; ++j) { const f32x4 gg = *((const f32x4*)g + 64 * j + lane), sc = *((const f32x4*)scale + 64 * j + lane), sh = *((const f32x4*)shift + 64 * j + lane);
            const f32x4 h = (v[j] * rstd) * gg * (sc + 1.0f) + sh;
            o8[64 * j] = (unsigned long long)pk2(h.x, h.y) | ((unsigned long long)pk2(h.z, h.w) << 32); }
    }
}
__device__ __forceinline__ void prep_token_item(const KArgs& A, int l, int row, int lane, const bf16* U, bf16* QB, bf16* KB, float* QN, unsigned* kmax, const float* rope) {
    const int j = lane & 7, grp = lane >> 3;
    const bool lat = row >= M_CTX;
    const int t = lat ? (row - M_CTX) & 1023 : row & 255;
    const int seq = lat ? 32 + ((row - M_CTX) >> 10) : row >> 8;
    const float* gq = A.in[I_QG] + l * 64 + 8 * j; const float* gk = A.in[I_KG] + l * 64 + 8 * j;
    const v4u uq = *(const GAS v4u*)(U + (size_t)row * NIN + 512 + lane * 8), uk = *(const GAS v4u*)(U + (size_t)row * NIN + 1024 + lane * 8);
    float q[8], k[8];
    { const unsigned wq[4] = {uq.x, uq.y, uq.z, uq.w}, wk[4] = {uk.x, uk.y, uk.z, uk.w};
#pragma unroll
      for (int i = 0; i < 4; ++i) { q[2 * i] = bf2f(wq[i] & 0xffffu); q[2 * i + 1] = bf2f(wq[i] >> 16); k[2 * i] = bf2f(wk[i] & 0xffffu); k[2 * i + 1] = bf2f(wk[i] >> 16); } }
    float sq = 0.f, sk = 0.f;
#pragma unroll
    for (int i = 0; i < 8; ++i) { sq += q[i] * q[i]; sk += k[i] * k[i]; }
#pragma unroll
    for (int o = 1; o < 8; o <<= 1) { sq += __shfl_xor(sq, o); sk += __shfl_xor(sk, o); }
    const float rq = 1.0f / sqrtf(sq * (1.0f / 64.0f) + EPS), rk = 1.0f / sqrtf(sk * (1.0f / 64.0f) + EPS);
#pragma unroll
    for (int i = 0; i < 8; ++i) { q[i] = q[i] * rq * gq[i]; k[i] = k[i] * rk * gk[i]; }
    if (lat) {
        const int pos = (j < 4) ? (t >> 6) : (t & 63);
        const float* cs = rope + pos * 16 + (j & 1) * 8; const float* sn = cs + 1024;
        const float sgn = (j & 2) ? 1.0f : -1.0f;
#pragma unroll
        for (int i = 0; i < 8; ++i) { const float pq = __shfl_xor(q[i], 2), pk = __shfl_xor(k[i], 2); const float c = cs[i], s = sn[i] * sgn;
            q[i] = q[i] * c + pq * s; k[i] = k[i] * c + pk * s; }
    }
    const float QS = 0.125f * 1.4426950408889634f;
    float nq = 0.f, nk = 0.f;
#pragma unroll
    for (int i = 0; i < 8; ++i) { q[i] *= QS; nq += q[i] * q[i]; nk += k[i] * k[i]; }
#pragma unroll
    for (int o = 1; o < 8; o <<= 1) { nq += __shfl_xor(nq, o); nk += __shfl_xor(nk, o); }
    const int hc = grp, key = lat ? 256 + t : t, fo = ((j >> 1) * 64 + (j & 1) * 32) * 8;
    const size_t qchunk = lat ? 2048 + (size_t)((seq - 32) * 8 + hc) * 32 + (t >> 5) : (size_t)(seq * 8 + hc) * 8 + (t >> 5);
    const size_t kchunk = lat ? 2048 + (size_t)((seq - 32) * 8 + hc) * 40 + (key >> 5) : (size_t)(seq * 8 + hc) * 8 + (key >> 5);
    *(GAS v4u*)(QB + qchunk * 2048 + fo + (t & 31) * 8) = (v4u){pk2(q[0], q[1]), pk2(q[2], q[3]), pk2(q[4], q[5]), pk2(q[6], q[7])};
    *(GAS v4u*)(KB + kchunk * 2048 + fo + (key & 31) * 8) = (v4u){pk2(k[0], k[1]), pk2(k[2], k[3]), pk2(k[4], k[5]), pk2(k[6], k[7])};
    if (j == 0) { QN[(size_t)row * 8 + grp] = sqrtf(nq) * 1.01f; atomicMax(kmax + seq * 8 + grp, __builtin_bit_cast(unsigned, sqrtf(nk) * 1.01f)); }
    if (!lat) { float* ko = A.out + OUT_K + ((size_t)((row >> 8) * 2 + l) * 256 + t) * 512 + lane * 8;
        *(f32x4*)ko = (f32x4){k[0], k[1], k[2], k[3]}; *(f32x4*)(ko + 4) = (f32x4){k[4], k[5], k[6], k[7]}; }
}
__device__ __forceinline__ void prep_cachek_item(const KArgs& A, int l, int item, int lane, bf16* KB, unsigned* kmax) {
    const int b = item >> 8, jrow = item & 255, grp = lane >> 3;
    const float* src = A.in[I_CK] + ((size_t)(b * 2 + l) * 256 + jrow) * 512 + lane * 8;
    const f32x4 a = *(const f32x4*)src, c = *(const f32x4*)(src + 4);
    float nk = (a.x * a.x + a.y * a.y) + (a.z * a.z + a.w * a.w) + (c.x * c.x + c.y * c.y) + (c.z * c.z + c.w * c.w);
#pragma unroll
    for (int o = 1; o < 8; o <<= 1) nk += __shfl_xor(nk, o);
    { const int j = lane & 7, fo = ((j >> 1) * 64 + (j & 1) * 32) * 8; const size_t kchunk = 2048 + (size_t)(b * 8 + grp) * 40 + (jrow >> 5);
      *(GAS v4u*)(KB + kchunk * 2048 + fo + (jrow & 31) * 8) = (v4u){pk2(a.x, a.y), pk2(a.z, a.w), pk2(c.x, c.y), pk2(c.z, c.w)}; }
    if ((lane & 7) == 0) atomicMax(kmax + (32 + b) * 8 + grp, __builtin_bit_cast(unsigned, sqrtf(nk) * 1.01f));
}
__device__ __forceinline__ void prep_vt_item(const KArgs& A, int l, int kind, int item, int lane, const bf16* U, bf16* VF, LAS unsigned char* scr) {
    LAS bf16* T = (LAS bf16*)scr;
    const int ch = item & (kind == 1 ? 31 : 7), sh = item >> (kind == 1 ? 5 : 3), h = sh & 3, s = sh >> 2;
    const size_t chunk = kind == 0 ? (size_t)(s * 4 + h) * 8 + ch : 1024 + (size_t)(s * 4 + h) * 40 + (kind == 1 ? 8 + ch : ch);
    if (kind < 2) { const int row0 = (kind == 0 ? s * 256 : M_CTX + s * 1024) + ch * 32;
#pragma unroll 8
        for (int i = 0; i < 32; ++i) { const unsigned w = *(const GAS unsigned*)(U + (size_t)(row0 + i) * NIN + 1536 + h * 128 + 2 * lane);
            T[(2 * lane) * 40 + i] = (bf16)(w & 0xffffu); T[(2 * lane + 1) * 40 + i] = (bf16)(w >> 16); }
    } else { const float* src = A.in[I_CV] + ((size_t)(s * 2 + l) * 256 + ch * 32) * 512 + h * 128 + 2 * lane;
#pragma unroll 8
        for (int i = 0; i < 32; ++i) { const float2 w = *(const float2*)(src + (size_t)i * 512);
            T[(2 * lane) * 40 + i] = (bf16)f2bf(w.x); T[(2 * lane + 1) * 40 + i] = (bf16)f2bf(w.y); } }
    LDS_WAIT(); asm volatile("" ::: "memory");
    const int r32 = lane & 31, hi = lane >> 5;
#pragma unroll
    for (int it = 0; it < 8; ++it) { const int s2 = it >> 2, d = it & 3;
        const LAS unsigned char* tp = scr + (d * 32 + r32) * 80 + (16 * s2 + 4 * hi) * 2;
        const u32x2 lo = *(const LAS u32x2*)tp, hh = *(const LAS u32x2*)(tp + 16);
        *(GAS v4u*)(VF + chunk * 4096 + (size_t)(it * 64 + lane) * 8) = (v4u){lo.x, lo.y, hh.x, hh.y}; }
    LDS_WAIT(); asm volatile("" ::: "memory");
}
__device__ __forceinline__ void prep_yt_item(int l, int item, int lane, const bf16* U, const bf16* WCS, bf16* YTC, bf16* YTL) {
    const int g = item & 3, rb = item >> 2, row0 = rb * 32, r32 = lane & 31, hi = lane >> 5;
    bf16* Y; int L, lp0;
    if (row0 < M_CTX) { L = 256; lp0 = row0 & 255; Y = YTC + (size_t)(((row0 >> 8) * 4 + g) * 128) * 256; }
    else { L = 1024; lp0 = (row0 - M_CTX) & 1023; Y = YTL + (size_t)((((row0 - M_CTX) >> 10) * 4 + g) * 128) * 1024; }
    const bf16* xp = U + (size_t)(row0 + r32) * NIN + 256 + g * 64 + hi * 8;
    const bf16* wp = WCS + (size_t)((l * 4 + g) * 128 + r32) * 64 + hi * 8;
    bf16x8 xa[4];
#pragma unroll
    for (int ks = 0; ks < 4; ++ks) xa[ks] = *(const GAS bf16x8*)(xp + ks * 16);
#pragma unroll
    for (int nb = 0; nb < 4; ++nb) { f32x16 acc = {};
#pragma unroll
        for (int ks = 0; ks < 4; ++ks) { const bf16x8 wb = *(const GAS bf16x8*)(wp + (size_t)nb * 32 * 64 + ks * 16); acc = __builtin_amdgcn_mfma_f32_32x32x16_bf16(xa[ks], wb, acc, 0, 0, 0); }
#pragma unroll
        for (int s2 = 0; s2 < 2; ++s2)
            *(GAS v4u*)(Y + ((size_t)nb * (L >> 4) + (lp0 >> 4) + s2) * 512 + lane * 8) =
                (v4u){pk2(acc[8 * s2], acc[8 * s2 + 1]), pk2(acc[8 * s2 + 2], acc[8 * s2 + 3]), pk2(acc[8 * s2 + 4], acc[8 * s2 + 5]), pk2(acc[8 * s2 + 6], acc[8 * s2 + 7])}; }
}
constexpr int PR_TOK = M_TOK, PR_CK = 512, PR_VT0 = 32 * 4 * 8, PR_VT1 = 2 * 4 * 32, PR_VT2 = 2 * 4 * 8, PR_YT = (M_TOK / 32) * 4;
constexpr int PR_ITEMS = PR_TOK + PR_CK + PR_VT0 + PR_VT1 + PR_VT2 + PR_YT;
__device__ __forceinline__ void prep_phase(const KArgs& A, int l, LAS unsigned char* lds, int gw, int NGW, int wave, int lane) {
    unsigned char* ws = A.ws;
    const bf16* U = (const bf16*)(ws + WS_U); bf16* QB = (bf16*)(ws + WS_QB); bf16* KB = (bf16*)(ws + WS_KB);
    float* QN = (float*)(ws + WS_QN); unsigned* kmax = (unsigned*)(ws + WS_CTL) + CW_KMAX + l * NSEQ * 8; const float* rope = (const float*)(ws + WS_ROPE);
    LAS unsigned char* scr = lds + wave * 16384;
    for (int it = gw; it < PR_ITEMS; it += NGW) {
        int r = it;
        if (r < PR_YT) { prep_yt_item(l, r, lane, U, (const bf16*)(ws + WS_WCS), (bf16*)(ws + WS_YTC), (bf16*)(ws + WS_YTL)); continue; } r -= PR_YT;
        if (r < PR_VT0) { prep_vt_item(A, l, 0, r, lane, U, (bf16*)(ws + WS_VTC), scr); continue; } r -= PR_VT0;
        if (r < PR_VT1) { prep_vt_item(A, l, 1, r, lane, U, (bf16*)(ws + WS_VTC), scr); continue; } r -= PR_VT1;
        if (r < PR_VT2) { prep_vt_item(A, l, 2, r, lane, U, (bf16*)(ws + WS_VTC), scr); continue; } r -= PR_VT2;
        if (r < PR_CK) { prep_cachek_item(A, l, r, lane, KB, kmax); continue; } r -= PR_CK;
        prep_token_item(A, l, r, lane, U, QB, KB, QN, kmax, rope);
    }
}
#define WG_BAR() do { asm volatile("s_waitcnt vmcnt(0) lgkmcnt(0)" ::: "memory"); __builtin_amdgcn_s_barrier(); asm volatile("" ::: "memory"); } while (0)
__device__ __forceinline__ void lds_fadd(LAS float* p, float v) { (void)__hip_atomic_fetch_add(p, v, __ATOMIC_RELAXED, __HIP_MEMORY_SCOPE_WORKGROUP); }
#define ATT_LOADK(dst, kp_) do { _Pragma("unroll") for (int ds_ = 0; ds_ < 4; ++ds_) dst[ds_] = *(const GAS bf16x8*)((kp_) + ds_ * 512); } while (0)
#define ATT_LOADV(dst, vp_) do { _Pragma("unroll") for (int i_ = 0; i_ < 8; ++i_) dst[i_] = *(const GAS bf16x8*)((vp_) + i_ * 512); } while (0)
#define ATT_QK(kf_) f32x16 S_; do { _Pragma("unroll") for (int r_ = 0; r_ < 16; ++r_) S_[r_] = nm; \
        _Pragma("unroll") for (int ds_ = 0; ds_ < 4; ++ds_) S_ = __builtin_amdgcn_mfma_f32_32x32x16_bf16(kf_[ds_], qf[ds_], S_, 0, 0, 0); } while (0)
#define ATT_PV(vf_) do { bf16x8 pa_[2]; \
        _Pragma("unroll") for (int s2_ = 0; s2_ < 2; ++s2_) { unsigned w_[4]; \
            _Pragma("unroll") for (int i_ = 0; i_ < 4; ++i_) { const float a_ = __builtin_amdgcn_exp2f(S_[8 * s2_ + 2 * i_]), b_ = __builtin_amdgcn_exp2f(S_[8 * s2_ + 2 * i_ + 1]); lsum += a_ + b_; w_[i_] = pk2(a_, b_); } \
            pa_[s2_] = __builtin_bit_cast(bf16x8, (v4u){w_[0], w_[1], w_[2], w_[3]}); } \
        _Pragma("unroll") for (int s2_ = 0; s2_ < 2; ++s2_) _Pragma("unroll") for (int d_ = 0; d_ < 4; ++d_) O[d_] = __builtin_amdgcn_mfma_f32_32x32x16_bf16(pa_[s2_], vf_[s2_ * 4 + d_], O[d_], 0, 0, 0); } while (0)
constexpr int LX_OFF = RING_BYTES + 1024;
__device__ __forceinline__ void attn_unit(const KArgs& A, int l, int seq, int h, int qb, LAS unsigned char* lds, int tid, int wave, int lane) {
    unsigned char* ws = A.ws;
    const bf16* QF = (const bf16*)(ws + WS_QB); const bf16* KF = (const bf16*)(ws + WS_KB); const bf16* VF = (const bf16*)(ws + WS_VTC); const float* QN = (const float*)(ws + WS_QN);
    const unsigned* kmax = (const unsigned*)(ws + WS_CTL) + CW_KMAX + l * NSEQ * 8;
    const bool lat = seq >= 32;
    const int qrow0 = lat ? M_CTX + (seq - 32) * 1024 + qb * 64 : seq * 256 + qb * 64;
    const int qs = wave & 1, ks = wave >> 1, r32 = lane & 31, hi = lane >> 5;
    const int nt = lat ? 10 : 2;
    const int qrow = qrow0 + qs * 32 + r32;
    LAS float* PO = (LAS float*)lds + wave * 4096;
    LAS float* PL = (LAS float*)(lds + LX_OFF);
    float acc[16];
#pragma unroll
    for (int i = 0; i < 16; ++i) acc[i] = 0.f;
    const float lam = ((const float*)(ws + WS_SCAL))[l];
#pragma unroll 1
    for (int c = 0; c < 2; ++c) {
        const size_t qchunk = lat ? 2048 + (size_t)((seq - 32) * 8 + h * 2 + c) * 32 + (qb * 2 + qs) : (size_t)(seq * 8 + h * 2 + c) * 8 + (qb * 2 + qs);
        const size_t kchunk = lat ? 2048 + (size_t)((seq - 32) * 8 + h * 2 + c) * 40 + ks * nt : (size_t)(seq * 8 + h * 2 + c) * 8 + ks * nt;
        const size_t vchunk = lat ? 1024 + (size_t)((seq - 32) * 4 + h) * 40 + ks * nt : (size_t)(seq * 4 + h) * 8 + ks * nt;
        const bf16* kp = KF + kchunk * 2048 + lane * 8; const bf16* vp = VF + vchunk * 4096 + lane * 8;
        bf16x8 qf[4], kf[4], vf[8];
        ATT_LOADK(qf, QF + qchunk * 2048 + lane * 8);
        ATT_LOADK(kf, kp); ATT_LOADV(vf, vp);
        const float nm = -QN[(size_t)qrow * 8 + h * 2 + c] * __builtin_bit_cast(float, kmax[seq * 8 + h * 2 + c]);
        f32x16 O[4];
#pragma unroll
        for (int d = 0; d < 4; ++d) O[d] = (f32x16){};
        float lsum = 0.f;
#pragma unroll 1
        for (int t = 0; t < nt; ++t) {
            ATT_QK(kf);
            __builtin_amdgcn_sched_barrier(0);
            if (t + 1 < nt) ATT_LOADK(kf, kp + (size_t)(t + 1) * 2048);
            ATT_PV(vf);
            __builtin_amdgcn_sched_barrier(0);
            if (t + 1 < nt) ATT_LOADV(vf, vp + (size_t)(t + 1) * 4096);
        }
        lsum += __shfl_xor(lsum, 32);
        if (hi == 0) PL[wave * 32 + r32] = lsum;
#pragma unroll
        for (int d = 0; d < 4; ++d)
#pragma unroll
            for (int r = 0; r < 16; ++r) { const int row = crow(r, hi); PO[row * 128 + ((d * 32 + r32) ^ ((row & 1) << 5))] = O[d][r]; }
        WG_BAR();
        {
            const int row = tid >> 3, a = tid & 7, q2 = row >> 5, r5 = row & 31;
            const float lt = (PL[(0 + q2) * 32 + r5] + PL[(2 + q2) * 32 + r5]) + (PL[(4 + q2) * 32 + r5] + PL[(6 + q2) * 32 + r5]);
            const float sc = c == 0 ? 1.0f / lt : -lam / lt;
#pragma unroll
            for (int i = 0; i < 4; ++i) { const int col = (32 * i + 4 * a) ^ ((r5 & 1) << 5);
                f32x4 v = *(const LAS f32x4*)((LAS float*)lds + (0 + q2) * 4096 + r5 * 128 + col);
                v += *(const LAS f32x4*)((LAS float*)lds + (2 + q2) * 4096 + r5 * 128 + col);
                v += *(const LAS f32x4*)((LAS float*)lds + (4 + q2) * 4096 + r5 * 128 + col);
                v += *(const LAS f32x4*)((LAS float*)lds + (6 + q2) * 4096 + r5 * 128 + col);
#pragma unroll
                for (int e = 0; e < 4; ++e) acc[4 * i + e] += v[e] * sc; }
        }
        WG_BAR();
    }
    {
        const int row = tid >> 3, a = tid & 7;
        const float lam_init = 0.8f - 0.6f * expf(-0.3f * (float)l);
        float ss = 0.f;
#pragma unroll
        for (int i = 0; i < 16; ++i) ss += acc[i] * acc[i];
#pragma unroll
        for (int of = 1; of < 8; of <<= 1) ss += __shfl_xor(ss, of);
        const float sc = (1.0f - lam_init) / sqrtf(ss * (1.0f / 128.0f) + EPS);
        const float* g = A.in[I_AOG] + l * 128 + 4 * a;
        bf16* mp = (bf16*)(ws + WS_MIX) + (size_t)(qrow0 + row) * DM + 512 + h * 128 + 4 * a;
#pragma unroll
        for (int i = 0; i < 4; ++i) { const f32x4 gv = *(const f32x4*)(g + 32 * i);
            *(GAS u32x2*)(mp + 32 * i) = (u32x2){pk2(acc[4 * i] * sc * gv[0], acc[4 * i + 1] * sc * gv[1]), pk2(acc[4 * i + 2] * sc * gv[2], acc[4 * i + 3] * sc * gv[3])}; }
    }
}
__device__ __forceinline__ void fourier_unit(const KArgs& A, int seq, int g, int rb, LAS unsigned char* lds, int tid, int wave, int lane) {
    unsigned char* ws = A.ws;
    const bool lat = seq >= 32; const int L = lat ? 1024 : 256, nks = L >> 4;
    const bf16* TW = lat ? (const bf16*)(ws + WS_TW1024) : (const bf16*)(ws + WS_TW256);
    const bf16* Y = lat ? (const bf16*)(ws + WS_YTL) + (size_t)(((seq - 32) * 4 + g) * 128) * 1024 : (const bf16*)(ws + WS_YTC) + (size_t)((seq * 4 + g) * 128) * 256;
    const int row0 = (lat ? M_CTX + (seq - 32) * 1024 : seq * 256) + rb * 128;
    const int rt = wave & 3, kh = wave >> 2, r32 = lane & 31, hi = lane >> 5;
    const bf16* ap = TW + ((size_t)((rb * 4 + rt) * 2 + kh) * nks) * 512 + lane * 8;
    const bf16* bp0 = Y + ((size_t)(kh * 2 + 0) * nks) * 512 + lane * 8;
    const bf16* bp1 = Y + ((size_t)(kh * 2 + 1) * nks) * 512 + lane * 8;
    f32x16 acc0 = {}, acc1 = {};
#pragma unroll 4
    for (int ks = 0; ks < nks; ++ks) { const bf16x8 a = *(const GAS bf16x8*)(ap + (size_t)ks * 512), b0 = *(const GAS bf16x8*)(bp0 + (size_t)ks * 512), b1 = *(const GAS bf16x8*)(bp1 + (size_t)ks * 512);
        acc0 = __builtin_amdgcn_mfma_f32_32x32x16_bf16(a, b0, acc0, 0, 0, 0); acc1 = __builtin_amdgcn_mfma_f32_32x32x16_bf16(a, b1, acc1, 0, 0, 0); }
    LAS float* C = (LAS float*)lds + rt * 2048;
    if (kh == 1) {
#pragma unroll
        for (int r = 0; r < 16; ++r) { C[crow(r, hi) * 64 + r32] = acc0[r]; C[crow(r, hi) * 64 + 32 + r32] = acc1[r]; } }
    WG_BAR();
    if (kh == 0) { const float s = lat ? (1.0f / 256.0f) : (1.0f / 128.0f);
        bf16* mp = (bf16*)(ws + WS_MIX) + (size_t)(row0 + rt * 32) * DM + 256 + g * 64 + r32;
#pragma unroll
        for (int r = 0; r < 16; ++r) { const int row = crow(r, hi);
            mp[(size_t)row * DM] = (bf16)f2bf((acc0[r] + C[row * 64 + r32]) * s); mp[(size_t)row * DM + 32] = (bf16)f2bf((acc1[r] + C[row * 64 + 32 + r32]) * s); } }
    WG_BAR();
}
__device__ __forceinline__ void pool_unit(const KArgs& A, int l, int chunk, int g, LAS unsigned char* lds, int tid) {
    unsigned char* ws = A.ws; const bf16* U = (const bf16*)(ws + WS_U);
    const int row0 = chunk * 64;
    int sstart, L; if (row0 < M_CTX) { sstart = row0 & ~255; L = 256; } else { sstart = M_CTX + ((row0 - M_CTX) & ~1023); L = 1024; }
    const int t0 = row0 - sstart, half = 1 << g;
    LAS float* P = (LAS float*)lds;
    LAS float* Dm = P + 80 * 64;
    LAS float* W = Dm + 64 * 65;
    for (int e = tid; e < 80 * 8; e += 512) { const int ri = e >> 3, c8 = (e & 7) * 8, pos = t0 - 8 + ri;
        v4u w = {0u, 0u, 0u, 0u}; if (pos >= 0 && pos < L) w = *(const GAS v4u*)(U + (size_t)(sstart + pos) * NIN + g * 64 + c8);
        *(LAS f32x4*)(P + ri * 64 + c8) = (f32x4){bf2f(w.x & 0xffffu), bf2f(w.x >> 16), bf2f(w.y & 0xffffu), bf2f(w.y >> 16)};
        *(LAS f32x4*)(P + ri * 64 + c8 + 4) = (f32x4){bf2f(w.z & 0xffffu), bf2f(w.z >> 16), bf2f(w.w & 0xffffu), bf2f(w.w >> 16)}; }
    for (int e = tid; e < 1024; e += 512) *(LAS f32x4*)(W + e * 4) = *(const f32x4*)(A.in[I_POOLW] + (size_t)(l * 4 + g) * 4096 + e * 4);
    WG_BAR();
    for (int e = tid; e < 4096; e += 512) { const int t = e >> 6, ch = e & 63, pos = t0 + t; const int lo = max(pos - half, 0), hh = min(pos + half, L);
        float s = 0.f; for (int jj = lo; jj < hh; ++jj) s += P[(jj - t0 + 8) * 64 + ch];
        Dm[t * 65 + ch] = s / (float)(hh - lo) - P[(t + 8) * 64 + ch]; }
    WG_BAR();
    { const int t = tid >> 3, d0 = (tid & 7) * 8; float o[8];
#pragma unroll
      for (int i = 0; i < 8; ++i) o[i] = 0.f;
      for (int c = 0; c < 64; ++c) { const float dv = Dm[t * 65 + c];
#pragma unroll
          for (int i = 0; i < 8; ++i) o[i] += dv * W[c * 64 + d0 + i]; }
      const float* ps = A.in[I_POOLS] + l * 256 + g * 64 + d0;
      bf16* mp = (bf16*)(ws + WS_MIX) + (size_t)(row0 + t) * DM + g * 64 + d0;
      *(GAS v4u*)mp = (v4u){pk2(o[0] * ps[0], o[1] * ps[1]), pk2(o[2] * ps[2], o[3] * ps[3]), pk2(o[4] * ps[4], o[5] * ps[5]), pk2(o[6] * ps[6], o[7] * ps[7])}; }
    WG_BAR();
}
constexpr int MX_LATT = 2 * 4 * 16, MX_CATT = 32 * 4 * 4, MX_LFOU = 2 * 4 * 8, MX_CFOU = 32 * 4 * 2, MX_POOL = (M_TOK / 64) * 4;
__device__ __forceinline__ void mix_phase(const KArgs& A, int l, LAS unsigned char* lds, int vcu, int G, int tid, int wave, int lane, int sel = 31) {
    if (sel & 5) {
#pragma unroll 1
        for (int it = vcu; it < MX_LATT + MX_CATT; it += G) {
            const bool isl = it < MX_LATT; const int r = it - MX_LATT;
            const int seq = isl ? 32 + (it >> 6) : r >> 4, hh = isl ? (it >> 4) & 3 : (r >> 2) & 3, qb = isl ? it & 15 : r & 3;
            if (sel & (isl ? 1 : 4)) attn_unit(A, l, seq, hh, qb, lds, tid, wave, lane);
        }
    }
    constexpr int O1 = MX_LATT + MX_CATT;
    if (sel & 10) {
#pragma unroll 1
        for (int it = ((vcu - O1) % G + G) % G; it < MX_LFOU + MX_CFOU; it += G) {
            const bool isl = it < MX_LFOU; const int r = it - MX_LFOU;
            const int seq = isl ? 32 + (it >> 5) : r >> 3, gg = isl ? (it >> 3) & 3 : (r >> 1) & 3, rb = isl ? it & 7 : r & 1;
            if (sel & (isl ? 2 : 8)) fourier_unit(A, seq, gg, rb, lds, tid, wave, lane);
        }
    }
    constexpr int O2 = O1 + MX_LFOU + MX_CFOU;
    if (sel & 16) {
#pragma unroll 1
        for (int it = ((vcu - O2) % G + G) % G; it < MX_POOL; it += G) pool_unit(A, l, it >> 2, it & 3, lds, tid);
    }
}
#define CAS __attribute__((address_space(4)))
#ifndef PROBE_KIND
#define PROBE_KIND -1
#endif
#ifndef PROBE_SEL
#define PROBE_SEL 31
#endif
#ifndef PROBE_N
#define PROBE_N 1
#endif
constexpr bool probe_match(int P, int kind) {
    if (kind < 0) return false;
    if (kind == 7) return P < NPHASES - 1;
    if (P == 0) return kind == 0;
    const int l = (P - 1) / 11, k = (P - 1) % 11;
    if (kind == 1) return k == 0 || k == 3 || k == 8;
    if (kind == 2) return k == 1 || k == 9;
    if (kind == 3) return k == 2 && l == 0;
    if (kind == 4) return k == 4;
    if (kind == 5) return k == 5;
    if (kind == 6) return k == 6;
    return false;
}
template <int PH, bool DUP = false> __device__ __forceinline__ void run_phase(const KArgs& A, LAS unsigned char* lds, int tid, int lane, int wave, int G, int bx, int vcu, int gw, int NGW) {
    unsigned char* ws = A.ws;
    float* X = A.out;
    const float* mods = (const float*)(ws + WS_CTL) + CW_MODS;
    bf16* XN = (bf16*)(ws + WS_XN); bf16* GBUF = (bf16*)(ws + WS_GB); bf16* UB = (bf16*)(ws + WS_U); bf16* MIXB = (bf16*)(ws + WS_MIX);
    if constexpr (PH == 0) {
#ifndef SKIP_P0
        p0_prologue(A, lds, gw, NGW, wave, lane, DUP);
#endif
    } else {
        constexpr int l = (PH - 1) / 11, k = (PH - 1) % 11;
        const float* mods_l = mods + (size_t)l * 3 * 9216;
        unsigned char* wl = ws + WS_W + (size_t)l * SZ_WLAYER;
        const float* ng = A.in[I_NG] + (size_t)l * 3 * DM;
        if constexpr (k == 0) { if (l == 0) norm_phase(A.in[I_XP], A.in[I_XS], XN, ng, mods_l, 0, gw, NGW, lane); else norm_phase(X, X + OUT_YS, XN, ng, mods_l, 0, gw, NGW, lane); }
        else if constexpr (k == 3) norm_phase(X, X + OUT_YS, XN, ng + DM, mods_l, 1, gw, NGW, lane);
        else if constexpr (k == 8) norm_phase(X, X + OUT_YS, XN, ng + 2 * DM, mods_l, 2, gw, NGW, lane);
        else if constexpr (k == 1 || k == 9) {
            pg8::Gemm g{XN, (const bf16*)(wl + (k == 1 ? OFF_WI1 : OFF_WI2)), M_TOK, NWI, DM}; pg8::StaticOrder S; S.init(M_TOK, NWI, G, bx);
            pg8::EpiSwiglu E{GBUF, FF};
            pg8::gemm_phase<pg8::EpiSwiglu, pg8::StaticOrder, true, true>(lds, g, S, E);
        } else if constexpr (k == 2 || k == 10) {
            pg8::Gemm g{GBUF, (const bf16*)(wl + (k == 2 ? OFF_WO1 : OFF_WO2)), M_TOK, DM, FF}; pg8::StaticOrder S; S.init(M_TOK, DM, G, bx);
            constexpr bool first = (k == 2 && l == 0);
            pg8::EpiResGate E{first ? A.in[I_XP] : X, first ? A.in[I_XS] : X + OUT_YS, X, mods_l, k == 2 ? 2 : 8, 0.5f};
            pg8::gemm_phase<pg8::EpiResGate, pg8::StaticOrder, true, true>(lds, g, S, E);
        } else if constexpr (k == 4) {
            pg8::Gemm g{XN, (const bf16*)(wl + OFF_WIN), M_TOK, NIN, DM}; pg8::StaticOrder S; S.init(M_TOK, NIN, G, bx);
            pg8::EpiU E{UB, A.out + OUT_V, l};
            pg8::gemm_phase<pg8::EpiU, pg8::StaticOrder, true, true>(lds, g, S, E);
        } else if constexpr (k == 5) {
#ifndef SKIP_PREP
            prep_phase(A, l, lds, gw, NGW, wave, lane);
#endif
        } else if constexpr (k == 6) {
#ifndef SKIP_MIX
            mix_phase(A, l, lds, vcu, G, tid, wave, lane, DUP ? PROBE_SEL : 31);
#endif
        } else if constexpr (k == 7) {
            pg8::Gemm g{MIXB, (const bf16*)(wl + OFF_WOUT), M_TOK, DM, DM}; pg8::StaticOrder S; S.init(M_TOK, DM, G, bx);
            pg8::EpiResGate E{X, X + OUT_YS, X, mods_l, 5, 1.0f};
            pg8::gemm_phase<pg8::EpiResGate, pg8::StaticOrder, true, true>(lds, g, S, E);
        }
    }
}
__global__ void __launch_bounds__(NWAVES * 64, 2) hyb_fwd(KArgs A) {
    extern __shared__ __attribute__((aligned(16))) unsigned char lds_raw[];
    LAS unsigned char* lds = (LAS unsigned char*)lds_raw;
    volatile LAS unsigned* MISC = (volatile LAS unsigned*)(lds + MISC_OFF);
    const int tid = threadIdx.x, lane = tid & 63, wave = __builtin_amdgcn_readfirstlane(tid >> 6);
    const int G = gridDim.x, bx = blockIdx.x, vcu = (G % 8 == 0) ? (bx % 8) * (G / 8) + bx / 8 : bx;
    const int gw = vcu * NWAVES + wave, NGW = G * NWAVES;
    gu32* ctl = (gu32*)(A.ws + WS_CTL);
    for (int u = tid; u < (LDS_BYTES - LDSCTL_OFF) / 4; u += NWAVES * 64) ((LAS unsigned*)(lds + LDSCTL_OFF))[u] = 0u;
    __syncthreads();
    const int lo = A.ph_lo, hi = A.ph_hi;
    XcdBarrier bar; bar.bar = (unsigned*)(ctl + CW_BAR); bar.x = 0; bar.st = nullptr;
    if (hi - lo > 1) bar = xcd_barrier_post((unsigned*)(ctl + CW_BAR), MISC + 8);
#define PHASE(P) if (lo <= (P) && (P) < hi) { run_phase<P>(A, lds, tid, lane, wave, G, bx, vcu, gw, NGW); if ((P) + 1 < hi) xcd_barrier(bar); \
        if constexpr (probe_match(P, PROBE_KIND)) { for (int pn_ = 0; pn_ < PROBE_N; ++pn_) { if constexpr (PROBE_KIND != 7) run_phase<P, true>(A, lds, tid, lane, wave, G, bx, vcu, gw, NGW); xcd_barrier(bar); } } }
    PHASE(0) PHASE(1) PHASE(2) PHASE(3) PHASE(4) PHASE(5) PHASE(6) PHASE(7) PHASE(8) PHASE(9) PHASE(10) PHASE(11)
    PHASE(12) PHASE(13) PHASE(14) PHASE(15) PHASE(16) PHASE(17) PHASE(18) PHASE(19) PHASE(20) PHASE(21) PHASE(22)
#undef PHASE
}

#ifndef N_LAUNCH_MODE
#define N_LAUNCH_MODE 1
#endif
extern "C" void kernel_launch(void* const* d_in, const int* in_sizes, int n_in, void* d_out, int out_size, void* d_ws, size_t ws_size, hipStream_t stream) {
    static int grid = 0;
    if (grid == 0) {
        if (n_in != 25 || ws_size < WS_END) { fprintf(stderr, "kernel_launch: unexpected n_in %d / ws %zu\n", n_in, ws_size); grid = -1; return; }
        int dev = 0, cus = 0, per_cu = 0;
        if (hipGetDevice(&dev) != hipSuccess || hipDeviceGetAttribute(&cus, hipDeviceAttributeMultiprocessorCount, dev) != hipSuccess) { grid = -1; return; }
        if (hipFuncSetAttribute((const void*)hyb_fwd, hipFuncAttributeMaxDynamicSharedMemorySize, LDS_BYTES) != hipSuccess) { fprintf(stderr, "kernel_launch: hipFuncSetAttribute failed\n"); grid = -1; return; }
        if (hipOccupancyMaxActiveBlocksPerMultiprocessor(&per_cu, (const void*)hyb_fwd, NWAVES * 64, LDS_BYTES) != hipSuccess || per_cu < 1) { fprintf(stderr, "kernel_launch: occupancy query says %d blocks per CU\n", per_cu); }
        (void)hipGetLastError();
        grid = cus;
    }
    if (grid < 0) return;
    if (hipMemsetAsync((char*)d_ws + WS_CTL, 0, CTL_ZERO_BYTES, stream) != hipSuccess) return;
    KArgs a{};
    for (int i = 0; i < 25; ++i) a.in[i] = (const float*)d_in[i];
    a.out = (float*)d_out; a.ws = (unsigned char*)d_ws;
#if N_LAUNCH_MODE == 0
    for (int p = 0; p < NPHASES; ++p) { a.ph_lo = p; a.ph_hi = p + 1; hipLaunchKernelGGL(hyb_fwd, dim3(grid), dim3(NWAVES * 64), LDS_BYTES, stream, a); }
#else
    a.ph_lo = 0; a.ph_hi = NPHASES; hipLaunchKernelGGL(hyb_fwd, dim3(grid), dim3(NWAVES * 64), LDS_BYTES, stream, a);
#endif
}
```

```cpp
#include <hip/hip_runtime.h>
#include <cstdio>
#include <cstdint>
namespace pg8 {
#define PG8_LAS __attribute__((address_space(3)))
typedef unsigned short bf16_t;
typedef short bf16x8 __attribute__((ext_vector_type(8)));
typedef float f32x4 __attribute__((ext_vector_type(4)));
typedef unsigned u32x4 __attribute__((ext_vector_type(4)));
constexpr int BM = 256, BK = 64, HALF = 128, HTB = HALF * BK * 2  , STAGE_BYTES = 8 * HTB, NXCD = 8, WGM = 8;

__host__ __device__ __forceinline__ int lds_byte(int r, int c) { const int st = (r >> 4) * 2 + (c >> 5), rr = r & 15, cc = c & 31, ob = rr * 64 + cc * 2; return st * 1024 + (ob ^ (((ob >> 9) & 1) << 5)); }
__host__ __device__ __forceinline__ void stage_rc(int b, int& R, int& C) { const int st = b / 1024, sb = b % 1024, swz = sb ^ (((sb >> 9) & 1) << 5); R = (st >> 1) * 16 + swz / 64; C = (st & 1) * 32 + (swz % 64) / 2; }
__host__ __device__ __forceinline__ int perm32(int rho) { const int n = rho >> 4, i = rho & 15; return 8 * (i >> 2) + 4 * n + (i & 3); }

struct Unit { int pm, pn; };
struct Gemm { const bf16_t* A; const bf16_t* Bt; int M, N, K; };

struct StaticOrder {
    int nM, nN, nwg, G, c;
    __host__ __device__ void init(int M, int N, int G_, int c_) { nM = M / BM; nN = N / BM; nwg = nM * nN; G = G_; c = c_; }
    __host__ __device__ bool next(int i, Unit& u) const {
        const long L = (long)i * G + c; if (L >= nwg) return false;
        int wgid = (int)L; { const int q = nwg / NXCD, r = nwg % NXCD, xcd = wgid % NXCD, off = wgid / NXCD; wgid = (xcd < r ? xcd * (q + 1) : r * (q + 1) + (xcd - r) * q) + off; }
        const int nig = WGM * nN, gid = wgid / nig, fm = gid * WGM, gsz = (nM - fm) < WGM ? (nM - fm) : WGM;
        u.pm = fm + ((wgid % nig) % gsz); u.pn = (wgid % nig) / gsz; return true;
    }
    __device__ __forceinline__ void a_ready(const Unit&) const {}
    __device__ __forceinline__ void done(const Unit&) const {}
};

__device__ __forceinline__ unsigned cvt_pk_bf16(float lo, float hi) { unsigned r; asm volatile("v_cvt_pk_bf16_f32 %0, %1, %2" : "=v"(r) : "v"(lo), "v"(hi)); return r; }
typedef float f32x2 __attribute__((ext_vector_type(2)));
template <class Epi, class Sched, bool ALIGN_EPI = false, bool SP2 = false>
__device__ __forceinline__ void gemm_phase(PG8_LAS unsigned char* lds, const Gemm g, const Sched& S, const Epi& E) {
    const int tid = threadIdx.x, wid = __builtin_amdgcn_readfirstlane(tid >> 6), lane = tid & 63, wr = wid >> 2, wc = wid & 3, fr = lane & 15, fq = lane >> 4;
    const int K = g.K, nt = K / BK;
    unsigned voffA[2], voffB[2];
#pragma unroll
    for (int i = 0; i < 2; ++i) { int R, C; stage_rc(tid * 16 + i * 8192, R, C); const int Rb = Epi::PERM ? ((R & ~31) + perm32(R & 31)) : R;
        voffA[i] = (unsigned)(R * K + C) * 2u; voffB[i] = (unsigned)(Rb * K + C) * 2u; }
    const size_t kstep = (size_t)(BK * 2);
    const size_t hstep = (size_t)HALF * K * 2;
    const size_t tstep = 2 * hstep;
    const unsigned ldsw = (unsigned)wid * 1024u;
    const int aoff = lds_byte(wr * 64 + fr, fq * 8), boff = lds_byte(wc * 32 + fr, fq * 8);
#define PG8_SA(b, h) (((b) * 2 + (h)) * HTB)
#define PG8_SB(b, h) ((4 + (b) * 2 + (h)) * HTB)
#define PG8_STAGE(bufoff, gbase, voff) do { _Pragma("unroll") for (int _i = 0; _i < 2; ++_i) \
        __builtin_amdgcn_global_load_lds((const unsigned*)((const char*)(gbase) + (voff)[_i]), (PG8_LAS unsigned*)(lds + (bufoff) + ldsw + _i * 8192), 16, 0, 0); } while (0)
#define PG8_LDA(dst, b, h) do { _Pragma("unroll") for (int m = 0; m < 4; ++m) _Pragma("unroll") for (int k = 0; k < 2; ++k) dst[m][k] = *(const PG8_LAS bf16x8*)(lds + PG8_SA(b, h) + aoff + m * 2048 + k * 1024); } while (0)
#define PG8_LDB(dst, b, h) do { _Pragma("unroll") for (int n = 0; n < 2; ++n) _Pragma("unroll") for (int k = 0; k < 2; ++k) dst[n][k] = *(const PG8_LAS bf16x8*)(lds + PG8_SB(b, h) + boff + n * 2048 + k * 1024); } while (0)
#define PG8_MMA(ai, bj, At, Bt) do { __builtin_amdgcn_s_setprio(1); _Pragma("unroll") for (int m = 0; m < 4; ++m) _Pragma("unroll") for (int n = 0; n < 2; ++n) _Pragma("unroll") for (int k = 0; k < 2; ++k) \
        acc[ai][bj][m][n] = __builtin_amdgcn_mfma_f32_16x16x32_bf16(Bt[n][k], At[m][k], acc[ai][bj][m][n], 0, 0, 0); __builtin_amdgcn_s_setprio(0); } while (0)
#define PG8_WAIT_V(n) asm volatile("s_waitcnt vmcnt(" #n ")" ::: "memory")
#define PG8_WAIT_L(n) asm volatile("s_waitcnt lgkmcnt(" #n ")" ::: "memory")
#define PG8_BAR __builtin_amdgcn_s_barrier()
#define PG8_SCHED __builtin_amdgcn_sched_barrier(0)
    Unit cur, nxt; int ui = 0;
    if (!S.next(0, cur)) return;
    f32x4 acc[2][2][4][2];
#pragma unroll
    for (int a = 0; a < 2; ++a)
#pragma unroll
        for (int b = 0; b < 2; ++b)
#pragma unroll
            for (int m = 0; m < 4; ++m)
#pragma unroll
                for (int n = 0; n < 2; ++n) acc[a][b][m][n] = (f32x4){0.f, 0.f, 0.f, 0.f};
    bf16x8 At[4][2], B0[2][2], B1[2][2];
    const char* cA = (const char*)g.A + (size_t)cur.pm * tstep; const char* cB = (const char*)g.Bt + (size_t)cur.pn * tstep;
    S.a_ready(cur);
    if constexpr (SP2) {
        PG8_STAGE(PG8_SB(0, 0), cB, voffB); PG8_STAGE(PG8_SB(0, 1), cB + hstep, voffB); PG8_STAGE(PG8_SA(0, 0), cA, voffA); PG8_STAGE(PG8_SA(0, 1), cA + hstep, voffA);
        if (wr == 1) PG8_BAR;
        PG8_WAIT_V(2); PG8_BAR;
        PG8_STAGE(PG8_SB(1, 0), cB + kstep, voffB); PG8_STAGE(PG8_SA(1, 0), cA + kstep, voffA); PG8_STAGE(PG8_SB(1, 1), cB + hstep + kstep, voffB);
        PG8_WAIT_V(6); PG8_BAR;
    } else {
        PG8_STAGE(PG8_SB(0, 0), cB, voffB); PG8_STAGE(PG8_SA(0, 0), cA, voffA); PG8_STAGE(PG8_SB(0, 1), cB + hstep, voffB); PG8_STAGE(PG8_SA(0, 1), cA + hstep, voffA);
        if (wr == 1) PG8_BAR;
        PG8_WAIT_V(4); PG8_BAR;
        PG8_STAGE(PG8_SB(1, 0), cB + kstep, voffB); PG8_STAGE(PG8_SA(1, 0), cA + kstep, voffA); PG8_STAGE(PG8_SB(1, 1), cB + hstep + kstep, voffB);
        PG8_WAIT_V(6); PG8_BAR;
    }
    for (;;) {
        const bool has_next = S.next(ui + 1, nxt);
        const char* nA = has_next ? (const char*)g.A + (size_t)nxt.pm * tstep : cA; const char* nB = has_next ? (const char*)g.Bt + (size_t)nxt.pn * tstep : cB;
        for (int t = 0; t < nt; t += 2) {
            const bool last = (t == nt - 2);
            const char* a1 = cA + (size_t)(t + 1) * kstep;
            const char* a2 = last ? nA : cA + (size_t)(t + 2) * kstep; const char* b2 = last ? nB : cB + (size_t)(t + 2) * kstep;
            const char* a3 = a2 + kstep; const char* b3 = b2 + kstep;
            if (last && has_next) S.a_ready(nxt);
            if constexpr (SP2) {
            PG8_LDB(B0, 0, 0); PG8_LDB(B1, 0, 1); PG8_SCHED; PG8_LDA(At, 0, 0); PG8_STAGE(PG8_SA(1, 1), a1 + hstep, voffA);
            PG8_WAIT_V(8); PG8_WAIT_L(0); PG8_BAR; PG8_MMA(0, 0, At, B0); PG8_MMA(0, 1, At, B1); PG8_BAR; PG8_SCHED;
            PG8_LDA(At, 0, 1); PG8_STAGE(PG8_SB(0, 0), b2, voffB); PG8_STAGE(PG8_SB(0, 1), b2 + hstep, voffB); PG8_STAGE(PG8_SA(0, 0), a2, voffA);
            PG8_WAIT_V(8); PG8_WAIT_L(0); PG8_BAR; PG8_MMA(1, 0, At, B0); PG8_MMA(1, 1, At, B1); PG8_BAR; PG8_SCHED;
            PG8_LDB(B0, 1, 0); PG8_LDB(B1, 1, 1); PG8_SCHED; PG8_LDA(At, 1, 0); PG8_STAGE(PG8_SA(0, 1), a2 + hstep, voffA);
            PG8_WAIT_V(8); PG8_WAIT_L(0); PG8_BAR; PG8_MMA(0, 0, At, B0); PG8_MMA(0, 1, At, B1); PG8_BAR; PG8_SCHED;
            PG8_LDA(At, 1, 1); PG8_STAGE(PG8_SB(1, 0), b3, voffB); PG8_STAGE(PG8_SB(1, 1), b3 + hstep, voffB); PG8_STAGE(PG8_SA(1, 0), a3, voffA);
            PG8_WAIT_V(8); PG8_WAIT_L(0); PG8_BAR; PG8_MMA(1, 0, At, B0); PG8_MMA(1, 1, At, B1); PG8_BAR; PG8_SCHED;
            } else {
            PG8_LDB(B0, 0, 0); PG8_SCHED; PG8_LDA(At, 0, 0); PG8_STAGE(PG8_SA(1, 1), a1 + hstep, voffA);
            PG8_WAIT_L(8); PG8_BAR; PG8_WAIT_L(0); PG8_MMA(0, 0, At, B0); PG8_BAR; PG8_SCHED;
            PG8_LDB(B1, 0, 1); PG8_STAGE(PG8_SB(0, 0), b2, voffB);
            PG8_BAR; PG8_WAIT_L(0); PG8_MMA(0, 1, At, B1); PG8_BAR;
            PG8_LDA(At, 0, 1); PG8_STAGE(PG8_SA(0, 0), a2, voffA);
            PG8_BAR; PG8_WAIT_L(0); PG8_MMA(1, 0, At, B0); PG8_BAR; PG8_SCHED;
            PG8_STAGE(PG8_SB(0, 1), b2 + hstep, voffB);
            PG8_WAIT_V(6); PG8_BAR; PG8_MMA(1, 1, At, B1); PG8_BAR;
            PG8_LDB(B0, 1, 0); PG8_SCHED; PG8_LDA(At, 1, 0); PG8_STAGE(PG8_SA(0, 1), a2 + hstep, voffA);
            PG8_WAIT_L(8); PG8_BAR; PG8_WAIT_L(0); PG8_MMA(0, 0, At, B0); PG8_BAR; PG8_SCHED;
            PG8_LDB(B1, 1, 1); PG8_STAGE(PG8_SB(1, 0), b3, voffB);
            PG8_BAR; PG8_WAIT_L(0); PG8_MMA(0, 1, At, B1); PG8_BAR;
            PG8_LDA(At, 1, 1); PG8_STAGE(PG8_SA(1, 0), a3, voffA);
            PG8_BAR; PG8_WAIT_L(0); PG8_MMA(1, 0, At, B0); PG8_BAR; PG8_SCHED;
            PG8_STAGE(PG8_SB(1, 1), b3 + hstep, voffB);
            PG8_WAIT_V(6); PG8_BAR; PG8_MMA(1, 1, At, B1); PG8_BAR;
            }
        }
        if constexpr (ALIGN_EPI) { if (wr == 0) PG8_BAR; }
        if constexpr (!Epi::AFTER_DRAIN) { E(acc, cur, wr, wc, fr, fq); S.done(cur); }
        if (!has_next) break;
#pragma unroll
        for (int a = 0; a < 2; ++a)
#pragma unroll
            for (int b = 0; b < 2; ++b)
#pragma unroll
                for (int m = 0; m < 4; ++m)
#pragma unroll
                    for (int n = 0; n < 2; ++n) acc[a][b][m][n] = (f32x4){0.f, 0.f, 0.f, 0.f};
        cur = nxt; cA = nA; cB = nB; ++ui;
        if constexpr (ALIGN_EPI) { if (wr == 1) PG8_BAR; }
    }
    PG8_WAIT_V(0);
    if constexpr (!ALIGN_EPI) { if (wr == 0) PG8_BAR; }
    PG8_BAR;
    if constexpr (Epi::AFTER_DRAIN) { E.fused(acc, cur, wr, wc, fr, fq, lds, wid, lane); S.done(cur); }
#undef PG8_SA
#undef PG8_SB
#undef PG8_STAGE
#undef PG8_LDA
#undef PG8_LDB
#undef PG8_MMA
#undef PG8_WAIT_V
#undef PG8_WAIT_L
#undef PG8_BAR
#undef PG8_SCHED
}
}
constexpr int M_TOK = 10240, M_CTX = 8192, DM = 1024, FF = 2816, NWI = 5632, NIN = 2048;
constexpr int LCTX = 256, LLAT = 1024, LKLAT = 1280, NSEQ = 34;
constexpr float EPS = 1e-6f;

namespace pg8 {
__device__ __forceinline__ float silu_f(float x) { return x * __builtin_amdgcn_rcpf(1.0f + __builtin_amdgcn_exp2f(-1.4426950408889634f * x)); }
struct EpiSwiglu {
    static constexpr bool PERM = true, AFTER_DRAIN = false;
    bf16_t* O; int ldc;
    __device__ __forceinline__ void operator()(const f32x4 (&acc)[2][2][4][2], const Unit& u, int wr, int wc, int fr, int fq) const {
        const int row0 = u.pm * BM + wr * 64 + fr, col0 = u.pn * HALF + wc * 32 + 8 * fq;
#pragma unroll
        for (int ai = 0; ai < 2; ++ai)
#pragma unroll
            for (int m = 0; m < 4; ++m) { bf16_t* rowp = O + (size_t)(row0 + ai * HALF + m * 16) * ldc + col0;
                const f32x4 a0 = acc[ai][0][m][0], a1 = acc[ai][0][m][1], b0 = acc[ai][1][m][0], b1 = acc[ai][1][m][1];
                u32x4 w;
                w.x = cvt_pk_bf16(silu_f(a0[0]) * b0[0], silu_f(a0[1]) * b0[1]); w.y = cvt_pk_bf16(silu_f(a0[2]) * b0[2], silu_f(a0[3]) * b0[3]);
                w.z = cvt_pk_bf16(silu_f(a1[0]) * b1[0], silu_f(a1[1]) * b1[1]); w.w = cvt_pk_bf16(silu_f(a1[2]) * b1[2], silu_f(a1[3]) * b1[3]);
                *(u32x4*)rowp = w; }
    }
};
struct EpiResGate {
    static constexpr bool PERM = false, AFTER_DRAIN = false;
    const float* base0; const float* base1;
    float* out; const float* mods;
    int idx; float gs;
    __device__ __forceinline__ void operator()(const f32x4 (&acc)[2][2][4][2], const Unit& u, int wr, int wc, int fr, int fq) const {
        const int set = u.pm < 32 ? 0 : 1 + ((u.pm - 32) >> 2);
        const float* mv = mods + (size_t)(set * 9 + idx) * DM;
        const float* bp = u.pm < 32 ? base0 + (size_t)u.pm * BM * DM : base1 + (size_t)(u.pm - 32) * BM * DM;
        float* op = out + (size_t)u.pm * BM * DM;
        const int col0 = u.pn * BM + wc * 32 + 4 * fq;
        f32x4 gv[2][2];
#pragma unroll
        for (int bj = 0; bj < 2; ++bj)
#pragma unroll
            for (int n = 0; n < 2; ++n) gv[bj][n] = *(const f32x4*)(mv + col0 + bj * HALF + n * 16) * gs;
#pragma unroll
        for (int ai = 0; ai < 2; ++ai)
#pragma unroll
            for (int m = 0; m < 4; ++m) { const size_t off = (size_t)(ai * HALF + wr * 64 + m * 16 + fr) * DM + col0;
#pragma unroll
                for (int bj = 0; bj < 2; ++bj)
#pragma unroll
                    for (int n = 0; n < 2; ++n) { const f32x4 b = *(const f32x4*)(bp + off + bj * HALF + n * 16);
                        *(f32x4*)(op + off + bj * HALF + n * 16) = b + gv[bj][n] * acc[ai][bj][m][n]; } }
    }
};
struct EpiU {
    static constexpr bool PERM = true, AFTER_DRAIN = false;
    bf16_t* U; float* outV; int layer;
    __device__ __forceinline__ void operator()(const f32x4 (&acc)[2][2][4][2], const Unit& u, int wr, int wc, int fr, int fq) const {
        const int row0 = u.pm * BM + wr * 64 + fr, col0 = u.pn * BM + wc * 32 + 8 * fq;
        const bool vout = (u.pn >= 6) && (u.pm < 32);
#pragma unroll
        for (int ai = 0; ai < 2; ++ai)
#pragma unroll
            for (int m = 0; m < 4; ++m) { const int row = row0 + ai * HALF + m * 16; bf16_t* rowp = U + (size_t)row * NIN + col0;
#pragma unroll
                for (int bj = 0; bj < 2; ++bj) { const f32x4 v0 = acc[ai][bj][m][0], v1 = acc[ai][bj][m][1];
                    u32x4 w; w.x = cvt_pk_bf16(v0[0], v0[1]); w.y = cvt_pk_bf16(v0[2], v0[3]); w.z = cvt_pk_bf16(v1[0], v1[1]); w.w = cvt_pk_bf16(v1[2], v1[3]);
                    *(u32x4*)(rowp + bj * HALF) = w;
                    if (vout) { float* vp = outV + ((size_t)((row >> 8) * 2 + layer) * 256 + (row & 255)) * 512 + (col0 + bj * HALF - 1536);
                        *(f32x4*)vp = v0; *(f32x4*)(vp + 4) = v1; } } }
    }
};
}
constexpr size_t MiB = 1u << 20;
constexpr size_t WS_CTL = 0, CTL_ZERO_BYTES = 512 * 1024;
constexpr size_t SZ_WI = (size_t)NWI * DM * 2, SZ_WO = (size_t)DM * FF * 2, SZ_WIN = (size_t)NIN * DM * 2, SZ_WOUT = (size_t)DM * DM * 2;
constexpr size_t WS_W = 2 * MiB;
constexpr size_t OFF_WI1 = 0, OFF_WO1 = OFF_WI1 + SZ_WI, OFF_WI2 = OFF_WO1 + SZ_WO, OFF_WO2 = OFF_WI2 + SZ_WI, OFF_WIN = OFF_WO2 + SZ_WO, OFF_WOUT = OFF_WIN + SZ_WIN, SZ_WLAYER = OFF_WOUT + SZ_WOUT;
constexpr size_t WS_TW1024 = 84 * MiB;
constexpr size_t WS_TW256 = 88 * MiB;
constexpr size_t WS_WCS = WS_TW256 + 512 * 1024;
constexpr size_t WS_ROPE = WS_WCS + 256 * 1024;
constexpr size_t WS_SCAL = WS_ROPE + 16 * 1024;
constexpr size_t WS_XN = 90 * MiB;
constexpr size_t WS_MIX = 110 * MiB;
constexpr size_t WS_GB = 130 * MiB;
constexpr size_t WS_U = 130 * MiB;
constexpr size_t WS_QB = 170 * MiB;
constexpr size_t WS_KB = 185 * MiB;
constexpr size_t WS_VTC = 196 * MiB;
constexpr size_t WS_VTL = 204 * MiB;
constexpr size_t WS_YTC = 207 * MiB;
constexpr size_t WS_YTL = 215 * MiB;
constexpr size_t WS_QN = 217 * MiB;
constexpr size_t WS_END = 218 * MiB;
static_assert(WS_W + 2 * SZ_WLAYER <= WS_TW1024 && WS_SCAL + 64 <= WS_XN && WS_GB + (size_t)M_TOK * FF * 2 <= WS_KB && WS_QB + (size_t)M_TOK * 512 * 2 <= WS_KB, "ws map");
constexpr int CW_TMO = 0, CW_BAR = 4096, CW_KMAX = 8192  , CW_MODS = 16384  ;
static_assert((CW_MODS + 2 * 3 * 9 * 1024) * 4 <= (int)CTL_ZERO_BYTES, "ctl");
constexpr int RING_BYTES = 131072, LDSCTL_OFF = RING_BYTES, MISC_OFF = LDSCTL_OFF + 320, LDS_BYTES = 147456;
constexpr int NWAVES = 8;
constexpr int NPHASES = 23;
#define GAS __attribute__((address_space(1)))
#define LAS __attribute__((address_space(3)))
typedef unsigned short bf16;
typedef unsigned v4u __attribute__((ext_vector_type(4)));
typedef float f32x4 __attribute__((ext_vector_type(4)));
typedef short bf16x8 __attribute__((ext_vector_type(8)));
typedef GAS unsigned gu32;
typedef GAS unsigned long long gu64;
#define RLX_AGENT __ATOMIC_RELAXED, __HIP_MEMORY_SCOPE_AGENT
#define LDS_WAIT() asm volatile("s_waitcnt lgkmcnt(0)" ::: "memory")
#define VM_WAIT() asm volatile("s_waitcnt vmcnt(0)" ::: "memory")
__device__ __forceinline__ unsigned long long rt() { return __builtin_amdgcn_s_memrealtime(); }
__device__ __forceinline__ unsigned f2bf(float f) { unsigned u = __builtin_bit_cast(unsigned, f); return (u + 0x7fffu + ((u >> 16) & 1u)) >> 16; }
typedef float f32x2_t __attribute__((ext_vector_type(2))); typedef __bf16 bf16x2_t __attribute__((ext_vector_type(2)));
__device__ __forceinline__ unsigned pk2(float lo, float hi) { f32x2_t v = {lo, hi}; bf16x2_t b = __builtin_convertvector(v, bf16x2_t); return __builtin_bit_cast(unsigned, b); }
#define XB_TMO      128
#define XB_XCNT(j)  (256  + 64 * (j))
#define XB_XSUB(j)  (1280 + 64 * (j))
#define XB_XGEN(j)  (2304 + 64 * (j))
#define XB_TOP      3328
#define XB_TOPGEN   3392
#define XCD_BAR_WORDS 3456
#define XB_SPIN_CAP (1u << 18)

__device__ __forceinline__ unsigned xb_ld(unsigned* p)              { return __hip_atomic_load(p, __ATOMIC_RELAXED, __HIP_MEMORY_SCOPE_AGENT); }
__device__ __forceinline__ unsigned xb_add(unsigned* p, unsigned v) { return __hip_atomic_fetch_add(p, v, __ATOMIC_RELAXED, __HIP_MEMORY_SCOPE_AGENT); }
__device__ __forceinline__ unsigned xb_xcc_id() { return (unsigned)__builtin_amdgcn_s_getreg((3 << 11) | 20) & 0xFu; }
#define XB_SPIN(cond, bar) do { unsigned _sp = 0; while (cond) { __builtin_amdgcn_s_sleep(1); \
    if ((++_sp & 255u) == 0u) { if (xb_ld(&(bar)[XB_TMO])) break; if (_sp > XB_SPIN_CAP) { atomicAdd(&(bar)[XB_TMO], 1u); break; } } } } while (0)

struct XcdBarrier {
    unsigned* bar; unsigned x;
    volatile LAS unsigned* st;
};

__device__ __forceinline__ XcdBarrier xcd_barrier_post(unsigned* bar, volatile LAS unsigned* st) {
    XcdBarrier b; b.bar = bar; b.x = xb_xcc_id(); b.st = st;
    if (threadIdx.x == 0) (void)xb_add(&bar[XB_XCNT(b.x)], 1u);
    return b;
}
__device__ __forceinline__ void xcd_barrier_complete(unsigned* bar, unsigned x, unsigned& nloc, unsigned& nx) {
    const unsigned G = gridDim.x * gridDim.y * gridDim.z;
    unsigned sum, cnt, mine, sp = 0u;
    for (;;) {
        sum = 0u; cnt = 0u; mine = 0u;
#pragma unroll
        for (unsigned j = 0; j < 16; ++j) { const unsigned c = xb_ld(&bar[XB_XCNT(j)]); sum += c; cnt += (c > 0u) ? 1u : 0u; mine = (j == x) ? c : mine; }
        if (sum == G) break;
        __builtin_amdgcn_s_sleep(1);
        if ((++sp & 255u) == 0u) { if (xb_ld(&bar[XB_TMO])) break; if (sp > XB_SPIN_CAP) { atomicAdd(&bar[XB_TMO], 1u); break; } }
    }
    nloc = mine > 0u ? mine : 1u; nx = cnt > 0u ? cnt : 1u;
}

__device__ __forceinline__ void xcd_barrier(const XcdBarrier& b) {
    asm volatile("s_waitcnt vmcnt(0)" ::: "memory");
    __syncthreads();
    if (threadIdx.x == 0) {
        unsigned* bar = b.bar;
        __builtin_amdgcn_s_waitcnt(0);
        unsigned nloc = b.st[0], nx = b.st[1];
        if (nloc == 0u) { xcd_barrier_complete(bar, b.x, nloc, nx); b.st[0] = nloc; b.st[1] = nx; }
        const unsigned old = xb_add(&bar[XB_XSUB(b.x)], 1u);
        const unsigned gen = old / nloc;
        if (old + 1u == (gen + 1u) * nloc) {
            __builtin_amdgcn_fence(__ATOMIC_RELEASE, "agent");
            asm volatile("s_waitcnt vmcnt(0)" ::: "memory");
            const unsigned og = xb_add(&bar[XB_TOP], 1u);
            const unsigned tg = og / nx;
            if (og + 1u == (tg + 1u) * nx) xb_add(&bar[XB_TOPGEN], 1u);
            else XB_SPIN(xb_ld(&bar[XB_TOPGEN]) == tg, bar);
            __builtin_amdgcn_fence(__ATOMIC_ACQUIRE, "agent");
            xb_add(&bar[XB_XGEN(b.x)], 1u);
            asm volatile("s_waitcnt vmcnt(0)" ::: "memory");
        } else {
            XB_SPIN(xb_ld(&bar[XB_XGEN(b.x)]) == gen, bar);
            __builtin_amdgcn_fence(__ATOMIC_ACQUIRE, "agent");
            asm volatile("s_waitcnt vmcnt(0)" ::: "memory");
        }
    }
    __syncthreads();
}
typedef float f32x16 __attribute__((ext_vector_type(16)));
typedef unsigned u32x2 __attribute__((ext_vector_type(2)));
__device__ __forceinline__ float bf2f(unsigned h) { return __builtin_bit_cast(float, h << 16); }
__device__ __forceinline__ float wave_sum(float v) {
#pragma unroll
    for (int o = 1; o < 64; o <<= 1) v += __shfl_xor(v, o);
    return v;
}
__device__ __forceinline__ int crow(int r, int hi) { return (r & 3) + 8 * (r >> 2) + 4 * hi; }
__device__ __forceinline__ float silu_acc(float x) { return x / (1.0f + expf(-x)); }

struct KArgs { const float* in[25]; float* out; unsigned char* ws; int ph_lo, ph_hi; };
enum { I_XP = 0, I_XS, I_CK, I_CV, I_C, I_CCTX, I_NG, I_ADAW, I_ADAB, I_F1WI, I_F1WO, I_F2WI, I_F2WO, I_WIN, I_WOUT, I_QG, I_KG, I_LQ1, I_LK1, I_LQ2, I_LK2, I_AOG, I_POOLW, I_POOLS, I_FNETW };
constexpr size_t OUT_YS = (size_t)M_CTX * DM, OUT_K = (size_t)M_TOK * DM, OUT_V = OUT_K + (size_t)32 * 2 * 256 * 512;

__device__ __forceinline__ void p0_transpose_item(const float* W, int K, int N, bf16* WT, bool swi, LAS float* scr, int item, int lane) {
    const int nblk = N / 32, kb = item / nblk, nb = item % nblk, k0 = 64 * kb, n0 = 32 * nb;
    int r0 = n0;
    if (swi) { const int half = n0 / FF, jj = n0 % FF; r0 = (jj / 128) * 256 + half * 128 + (jj % 128); }
#pragma unroll 8
    for (int i = 0; i < 32; ++i) { const int kk = 2 * i + (lane >> 5); scr[kk * 33 + (lane & 31)] = W[(size_t)(k0 + kk) * N + n0 + (lane & 31)]; }
    LDS_WAIT(); asm volatile("" ::: "memory");
    const int c = lane & 7;
#pragma unroll
    for (int j = 0; j < 4; ++j) { const int n = (lane >> 3) + 8 * j; const LAS float* s = scr + (8 * c) * 33 + n;
        v4u o; o.x = pk2(s[0 * 33], s[1 * 33]); o.y = pk2(s[2 * 33], s[3 * 33]); o.z = pk2(s[4 * 33], s[5 * 33]); o.w = pk2(s[6 * 33], s[7 * 33]);
        *(GAS v4u*)(WT + (size_t)(r0 + n) * K + k0 + 8 * c) = o; }
    LDS_WAIT(); asm volatile("" ::: "memory");
}
__device__ __forceinline__ void p0_fold_item(const float* Win, const float* PW, bf16* WT, LAS float* scr, int kb, int nb, int lane) {
    const int k0 = 64 * kb, n0 = 32 * nb, g = n0 >> 6, kh = lane >> 5, n = lane & 31;
    for (int kk = 0; kk < 64; ++kk) scr[kk * 64 + lane] = Win[(size_t)(k0 + kk) * NIN + g * 64 + lane];
    LDS_WAIT(); asm volatile("" ::: "memory");
    float acc[32];
#pragma unroll
    for (int i = 0; i < 32; ++i) acc[i] = 0.f;
    const float* pw = PW + (size_t)g * 4096 + (n0 & 63) + n;
#pragma unroll 1
    for (int c4 = 0; c4 < 16; ++c4) {
        const float p0 = pw[(4 * c4) * 64], p1 = pw[(4 * c4 + 1) * 64], p2 = pw[(4 * c4 + 2) * 64], p3 = pw[(4 * c4 + 3) * 64];
#pragma unroll
        for (int i = 0; i < 32; ++i) { const f32x4 a = *(const LAS f32x4*)(scr + (32 * kh + i) * 64 + 4 * c4); acc[i] += (a.x * p0 + a.y * p1) + (a.z * p2 + a.w * p3); }
    }
    bf16* op = WT + (size_t)(n0 + n) * DM + k0 + 32 * kh;
#pragma unroll
    for (int q = 0; q < 4; ++q) *(GAS v4u*)(op + 8 * q) = (v4u){pk2(acc[8 * q], acc[8 * q + 1]), pk2(acc[8 * q + 2], acc[8 * q + 3]), pk2(acc[8 * q + 4], acc[8 * q + 5]), pk2(acc[8 * q + 6], acc[8 * q + 7])};
    LDS_WAIT(); asm volatile("" ::: "memory");
}
__device__ __forceinline__ void p0_mods_item(const KArgs& A, float* mods, int item, int lane) {
    const int l = item / 576, r = item % 576, kc = r / 36, cb = r % 36;
    const float* W = A.in[I_ADAW] + (size_t)l * DM * 9216 + (size_t)(kc * 64) * 9216 + cb * 256 + lane * 4;
    const int k = kc * 64 + lane;
    const float s0 = silu_acc(A.in[I_CCTX][k]), s1 = silu_acc(A.in[I_C][k]), s2 = silu_acc(A.in[I_C][DM + k]);
    f32x4 a0 = {0.f, 0.f, 0.f, 0.f}, a1 = a0, a2 = a0;
#pragma unroll 8
    for (int kk = 0; kk < 64; ++kk) {
        const f32x4 w = *(const f32x4*)(W + (size_t)kk * 9216);
        const float c0 = __builtin_bit_cast(float, __builtin_amdgcn_readlane(__builtin_bit_cast(int, s0), kk));
        const float c1 = __builtin_bit_cast(float, __builtin_amdgcn_readlane(__builtin_bit_cast(int, s1), kk));
        const float c2 = __builtin_bit_cast(float, __builtin_amdgcn_readlane(__builtin_bit_cast(int, s2), kk));
        a0 += w * c0; a1 += w * c1; a2 += w * c2;
    }
    if (kc == 0) { const f32x4 b = *(const f32x4*)(A.in[I_ADAB] + (size_t)l * 9216 + cb * 256 + lane * 4); a0 += b; a1 += b; a2 += b; }
    float* mp = mods + (size_t)l * 3 * 9216 + cb * 256 + lane * 4;
#pragma unroll
    for (int i = 0; i < 4; ++i) { atomicAdd(mp + i, a0[i]); atomicAdd(mp + 9216 + i, a1[i]); atomicAdd(mp + 2 * 9216 + i, a2[i]); }
}
__device__ __forceinline__ void p0_tw_item(bf16* TW, int L, int item, int lane) {
    const int nks = L / 16, ks = item % nks, kh = (item / nks) & 1, rt = item / (2 * nks), k = 32 * rt + (lane & 31), h = lane >> 5;
    unsigned w[4];
#pragma unroll
    for (int i = 0; i < 4; ++i) { float v[2];
#pragma unroll
        for (int e = 0; e < 2; ++e) { const int j = 2 * i + e, kk = 16 * ks + 8 * (j >> 2) + 4 * h + (j & 3); const int ang = (k * kk) & (L - 1);
            float sn, cs; sincospif(2.0f * (float)ang / (float)L, &sn, &cs); v[e] = kh ? sn : cs; }
        w[i] = pk2(v[0], v[1]); }
    *(GAS v4u*)(TW + (size_t)item * 512 + lane * 8) = (v4u){w[0], w[1], w[2], w[3]};
}
__device__ __forceinline__ void p0_wcs_item(const KArgs& A, bf16* WCS, int item, int lane) {
    const int lg = item >> 7, n = item & 127, d = n & 63; const bool sn = n >= 64;
    const float* Wf = A.in[I_FNETW] + (size_t)lg * 4096 + d;
    float acc = 0.f;
    for (int m = 0; m < 64; ++m) { float s, c; sincospif(2.0f * (float)((m * lane) & 63) / 64.0f, &s, &c); acc += (sn ? -s : c) * Wf[m * 64]; }
    WCS[(size_t)item * 64 + lane] = (bf16)f2bf(acc);
}
__device__ __forceinline__ void p0_misc_item(const KArgs& A, float* rope, float* scal, int lane) {
    for (int e = lane; e < 1024; e += 64) { const int pos = e >> 4, i = e & 15; const float inv = 1.0f / powf(10000.0f, (float)(2 * i) / 32.0f); const float ang = (float)pos * inv;
        rope[e] = cosf(ang); rope[1024 + e] = sinf(ang); }
#pragma unroll
    for (int l = 0; l < 2; ++l) {
        const float d1 = wave_sum(A.in[I_LQ1][l * 64 + lane] * A.in[I_LK1][l * 64 + lane]), d2 = wave_sum(A.in[I_LQ2][l * 64 + lane] * A.in[I_LK2][l * 64 + lane]);
        const float lam_init = 0.8f - 0.6f * expf(-0.3f * (float)l);
        if (lane == 0) scal[l] = expf(d1) - expf(d2) + lam_init;
    }
}
constexpr int IT_MODS = 2 * 16 * 36, IT_TWI = (DM / 64) * (NWI / 32), IT_TWO = (FF / 64) * (DM / 32), IT_TWIN = (DM / 64) * (NIN / 32), IT_TWOUT = (DM / 64) * (DM / 32);
constexpr int IT_TRL = 2 * IT_TWI + 2 * IT_TWO + IT_TWIN + IT_TWOUT;
constexpr int IT_TW1024 = 32 * 2 * 64, IT_TW256 = 8 * 2 * 16, IT_WCS = 2 * 4 * 128;
constexpr int P0_ITEMS = IT_MODS + 2 * IT_TRL + IT_TW1024 + IT_TW256 + IT_WCS + 1;
__device__ __forceinline__ void p0_prologue(const KArgs& A, LAS unsigned char* lds, int gw, int NGW, int wave, int lane, bool skip_mods = false) {
    LAS float* scr = (LAS float*)(lds + wave * 16384);
    unsigned char* ws = A.ws;
    float* mods = (float*)(ws + WS_CTL) + CW_MODS;
    for (int it = gw; it < P0_ITEMS; it += NGW) {
        int r = it;
        if (r < IT_MODS) { if (!skip_mods) p0_mods_item(A, mods, r, lane); continue; } r -= IT_MODS;
        if (r < 2 * IT_TRL) { const int l = r / IT_TRL; r %= IT_TRL; unsigned char* wl = ws + WS_W + (size_t)l * SZ_WLAYER;
            if (r < IT_TWI) { p0_transpose_item(A.in[I_F1WI] + (size_t)l * DM * NWI, DM, NWI, (bf16*)(wl + OFF_WI1), true, scr, r, lane); continue; } r -= IT_TWI;
            if (r < IT_TWO) { p0_transpose_item(A.in[I_F1WO] + (size_t)l * FF * DM, FF, DM, (bf16*)(wl + OFF_WO1), false, scr, r, lane); continue; } r -= IT_TWO;
            if (r < IT_TWI) { p0_transpose_item(A.in[I_F2WI] + (size_t)l * DM * NWI, DM, NWI, (bf16*)(wl + OFF_WI2), true, scr, r, lane); continue; } r -= IT_TWI;
            if (r < IT_TWO) { p0_transpose_item(A.in[I_F2WO] + (size_t)l * FF * DM, FF, DM, (bf16*)(wl + OFF_WO2), false, scr, r, lane); continue; } r -= IT_TWO;
            if (r < IT_TWIN) { const int nblk = NIN / 32, kb = r / nblk, nb = r % nblk;
                if (nb < 8) p0_fold_item(A.in[I_WIN] + (size_t)l * DM * NIN, A.in[I_POOLW] + (size_t)l * 4 * 4096, (bf16*)(wl + OFF_WIN), scr, kb, nb, lane);
                else p0_transpose_item(A.in[I_WIN] + (size_t)l * DM * NIN, DM, NIN, (bf16*)(wl + OFF_WIN), false, scr, r, lane);
                continue; } r -= IT_TWIN;
            p0_transpose_item(A.in[I_WOUT] + (size_t)l * DM * DM, DM, DM, (bf16*)(wl + OFF_WOUT), false, scr, r, lane); continue; }
        r -= 2 * IT_TRL;
        if (r < IT_TW1024) { p0_tw_item((bf16*)(ws + WS_TW1024), 1024, r, lane); continue; } r -= IT_TW1024;
        if (r < IT_TW256) { p0_tw_item((bf16*)(ws + WS_TW256), 256, r, lane); continue; } r -= IT_TW256;
        if (r < IT_WCS) { p0_wcs_item(A, (bf16*)(ws + WS_WCS), r, lane); continue; }
        p0_misc_item(A, (float*)(ws + WS_ROPE), (float*)(ws + WS_SCAL), lane);
    }
}
__device__ __forceinline__ void norm_phase(const float* x0, const float* x1, bf16* XN, const float* g, const float* mods_l, int sub, int gw, int NGW, int lane) {
    for (int m = gw; m < M_TOK; m += NGW) {
        const float* xrow = m < M_CTX ? x0 + (size_t)m * DM : x1 + (size_t)(m - M_CTX) * DM;
        const int set = m < M_CTX ? 0 : 1 + ((m - M_CTX) >> 10);
        const float* shift = mods_l + (size_t)(set * 9 + 3 * sub) * DM; const float* scale = shift + DM;
        const GAS f32x4* xr = (const GAS f32x4*)xrow + lane;
        f32x4 v[4]; float ss = 0.f;
#pragma unroll
        for (int j = 0; j < 4; ++j) { v[j] = xr[64 * j]; ss += (v[j].x * v[j].x + v[j].y * v[j].y) + (v[j].z * v[j].z + v[j].w * v[j].w); }
        const float rstd = 1.0f / sqrtf(wave_sum(ss) * (1.0f / DM) + EPS);
        GAS unsigned long long* o8 = (GAS unsigned long long*)(XN + (size_t)m * DM) + lane;
#pragma unroll
        for (int j = 0; j < 4; ++j) { const f32x4 gg = *((const f32x4*)g + 64 * j + lane), sc = *((const f32x4*)scale + 64 * j + lane), sh = *((const f32x4*)shift + 64 * j + lane);
            const f32x4 h = (v[j] * rstd) * gg * (sc + 1.0f) + sh;
            o8[64 * j] = (unsigned long long)pk2(h.x, h.y) | ((unsigned long long)pk2(h.z, h.w) << 32); }
    }
}
__device__ __forceinline__ void prep_token_item(const KArgs& A, int l, int row, int lane, const bf16* U, bf16* QB, bf16* KB, float* QN, unsigned* kmax, const float* rope) {
    const int j = lane & 7, grp = lane >> 3;
    const bool lat = row >= M_CTX;
    const int t = lat ? (row - M_CTX) & 1023 : row & 255;
    const int seq = lat ? 32 + ((row - M_CTX) >> 10) : row >> 8;
    const float* gq = A.in[I_QG] + l * 64 + 8 * j; const float* gk = A.in[I_KG] + l * 64 + 8 * j;
    const v4u uq = *(const GAS v4u*)(U + (size_t)row * NIN + 512 + lane * 8), uk = *(const GAS v4u*)(U + (size_t)row * NIN + 1024 + lane * 8);
    float q[8], k[8];
    { const unsigned wq[4] = {uq.x, uq.y, uq.z, uq.w}, wk[4] = {uk.x, uk.y, uk.z, uk.w};
#pragma unroll
      for (int i = 0; i < 4; ++i) { q[2 * i] = bf2f(wq[i] & 0xffffu); q[2 * i + 1] = bf2f(wq[i] >> 16); k[2 * i] = bf2f(wk[i] & 0xffffu); k[2 * i + 1] = bf2f(wk[i] >> 16); } }
    float sq = 0.f, sk = 0.f;
#pragma unroll
    for (int i = 0; i < 8; ++i) { sq += q[i] * q[i]; sk += k[i] * k[i]; }
#pragma unroll
    for (int o = 1; o < 8; o <<= 1) { sq += __shfl_xor(sq, o); sk += __shfl_xor(sk, o); }
    const float rq = 1.0f / sqrtf(sq * (1.0f / 64.0f) + EPS), rk = 1.0f / sqrtf(sk * (1.0f / 64.0f) + EPS);
#pragma unroll
    for (int i = 0; i < 8; ++i) { q[i] = q[i] * rq * gq[i]; k[i] = k[i] * rk * gk[i]; }
    if (lat) {
        const int pos = (j < 4) ? (t >> 6) : (t & 63);
        const float* cs = rope + pos * 16 + (j & 1) * 8; const float* sn = cs + 1024;
        const float sgn = (j & 2) ? 1.0f : -1.0f;
#pragma unroll
        for (int i = 0; i < 8; ++i) { const float pq = __shfl_xor(q[i], 2), pk = __shfl_xor(k[i], 2); const float c = cs[i], s = sn[i] * sgn;
            q[i] = q[i] * c + pq * s; k[i] = k[i] * c + pk * s; }
    }
    const float QS = 0.125f * 1.4426950408889634f;
    float nq = 0.f, nk = 0.f;
#pragma unroll
    for (int i = 0; i < 8; ++i) { q[i] *= QS; nq += q[i] * q[i]; nk += k[i] * k[i]; }
#pragma unroll
    for (int o = 1; o < 8; o <<= 1) { nq += __shfl_xor(nq, o); nk += __shfl_xor(nk, o); }
    const int hc = grp, key = lat ? 256 + t : t, fo = ((j >> 1) * 64 + (j & 1) * 32) * 8;
    const size_t qchunk = lat ? 2048 + (size_t)((seq - 32) * 8 + hc) * 32 + (t >> 5) : (size_t)(seq * 8 + hc) * 8 + (t >> 5);
    const size_t kchunk = lat ? 2048 + (size_t)((seq - 32) * 8 + hc) * 40 + (key >> 5) : (size_t)(seq * 8 + hc) * 8 + (key >> 5);
    *(GAS v4u*)(QB + qchunk * 2048 + fo + (t & 31) * 8) = (v4u){pk2(q[0], q[1]), pk2(q[2], q[3]), pk2(q[4], q[5]), pk2(q[6], q[7])};
    *(GAS v4u*)(KB + kchunk * 2048 + fo + (key & 31) * 8) = (v4u){pk2(k[0], k[1]), pk2(k[2], k[3]), pk2(k[4], k[5]), pk2(k[6], k[7])};
    if (j == 0) { QN[(size_t)row * 8 + grp] = sqrtf(nq) * 1.01f; atomicMax(kmax + seq * 8 + grp, __builtin_bit_cast(unsigned, sqrtf(nk) * 1.01f)); }
    if (!lat) { float* ko = A.out + OUT_K + ((size_t)((row >> 8) * 2 + l) * 256 + t) * 512 + lane * 8;
        *(f32x4*)ko = (f32x4){k[0], k[1], k[2], k[3]}; *(f32x4*)(ko + 4) = (f32x4){k[4], k[5], k[6], k[7]}; }
}
__device__ __forceinline__ void prep_cachek_item(const KArgs& A, int l, int item, int lane, bf16* KB, unsigned* kmax) {
    const int b = item >> 8, jrow = item & 255, grp = lane >> 3;
    const float* src = A.in[I_CK] + ((size_t)(b * 2 + l) * 256 + jrow) * 512 + lane * 8;
    const f32x4 a = *(const f32x4*)src, c = *(const f32x4*)(src + 4);
    float nk = (a.x * a.x + a.y * a.y) + (a.z * a.z + a.w * a.w) + (c.x * c.x + c.y * c.y) + (c.z * c.z + c.w * c.w);
#pragma unroll
    for (int o = 1; o < 8; o <<= 1) nk += __shfl_xor(nk, o);
    { const int j = lane & 7, fo = ((j >> 1) * 64 + (j & 1) * 32) * 8; const size_t kchunk = 2048 + (size_t)(b * 8 + grp) * 40 + (jrow >> 5);
      *(GAS v4u*)(KB + kchunk * 2048 + fo + (jrow & 31) * 8) = (v4u){pk2(a.x, a.y), pk2(a.z, a.w), pk2(c.x, c.y), pk2(c.z, c.w)}; }
    if ((lane & 7) == 0) atomicMax(kmax + (32 + b) * 8 + grp, __builtin_bit_cast(unsigned, sqrtf(nk) * 1.01f));
}
__device__ __forceinline__ void prep_vt_item(const KArgs& A, int l, int kind, int item, int lane, const bf16* U, bf16* VF, LAS unsigned char* scr) {
    LAS bf16* T = (LAS bf16*)scr;
    const int ch = item & (kind == 1 ? 31 : 7), sh = item >> (kind == 1 ? 5 : 3), h = sh & 3, s = sh >> 2;
    const size_t chunk = kind == 0 ? (size_t)(s * 4 + h) * 8 + ch : 1024 + (size_t)(s * 4 + h) * 40 + (kind == 1 ? 8 + ch : ch);
    if (kind < 2) { const int row0 = (kind == 0 ? s * 256 : M_CTX + s * 1024) + ch * 32;
#pragma unroll 8
        for (int i = 0; i < 32; ++i) { const unsigned w = *(const GAS unsigned*)(U + (size_t)(row0 + i) * NIN + 1536 + h * 128 + 2 * lane);
            T[(2 * lane) * 40 + i] = (bf16)(w & 0xffffu); T[(2 * lane + 1) * 40 + i] = (bf16)(w >> 16); }
    } else { const float* src = A.in[I_CV] + ((size_t)(s * 2 + l) * 256 + ch * 32) * 512 + h * 128 + 2 * lane;
#pragma unroll 8
        for (int i = 0; i < 32; ++i) { const float2 w = *(const float2*)(src + (size_t)i * 512);
            T[(2 * lane) * 40 + i] = (bf16)f2bf(w.x); T[(2 * lane + 1) * 40 + i] = (bf16)f2bf(w.y); } }
    LDS_WAIT(); asm volatile("" ::: "memory");
    const int r32 = lane & 31, hi = lane >> 5;
#pragma unroll
    for (int it = 0; it < 8; ++it) { const int s2 = it >> 2, d = it & 3;
        const LAS unsigned char* tp = scr + (d * 32 + r32) * 80 + (16 * s2 + 4 * hi) * 2;
        const u32x2 lo = *(const LAS u32x2*)tp, hh = *(const LAS u32x2*)(tp + 16);
        *(GAS v4u*)(VF + chunk * 4096 + (size_t)(it * 64 + lane) * 8) = (v4u){lo.x, lo.y, hh.x, hh.y}; }
    LDS_WAIT(); asm volatile("" ::: "memory");
}
__device__ __forceinline__ void prep_yt_item(int l, int item, int lane, const bf16* U, const bf16* WCS, bf16* YTC, bf16* YTL) {
    const int g = item & 3, rb = item >> 2, row0 = rb * 32, r32 = lane & 31, hi = lane >> 5;
    bf16* Y; int L, lp0;
    if (row0 < M_CTX) { L = 256; lp0 = row0 & 255; Y = YTC + (size_t)(((row0 >> 8) * 4 + g) * 128) * 256; }
    else { L = 1024; lp0 = (row0 - M_CTX) & 1023; Y = YTL + (size_t)((((row0 - M_CTX) >> 10) * 4 + g) * 128) * 1024; }
    const bf16* xp = U + (size_t)(row0 + r32) * NIN + 256 + g * 64 + hi * 8;
    const bf16* wp = WCS + (size_t)((l * 4 + g) * 128 + r32) * 64 + hi * 8;
    bf16x8 xa[4];
#pragma unroll
    for (int ks = 0; ks < 4; ++ks) xa[ks] = *(const GAS bf16x8*)(xp + ks * 16);
#pragma unroll
    for (int nb = 0; nb < 4; ++nb) { f32x16 acc = {};
#pragma unroll
        for (int ks = 0; ks < 4; ++ks) { const bf16x8 wb = *(const GAS bf16x8*)(wp + (size_t)nb * 32 * 64 + ks * 16); acc = __builtin_amdgcn_mfma_f32_32x32x16_bf16(xa[ks], wb, acc, 0, 0, 0); }
#pragma unroll
        for (int s2 = 0; s2 < 2; ++s2)
            *(GAS v4u*)(Y + ((size_t)nb * (L >> 4) + (lp0 >> 4) + s2) * 512 + lane * 8) =
                (v4u){pk2(acc[8 * s2], acc[8 * s2 + 1]), pk2(acc[8 * s2 + 2], acc[8 * s2 + 3]), pk2(acc[8 * s2 + 4], acc[8 * s2 + 5]), pk2(acc[8 * s2 + 6], acc[8 * s2 + 7])}; }
}
constexpr int PR_TOK = M_TOK, PR_CK = 512, PR_VT0 = 32 * 4 * 8, PR_VT1 = 2 * 4 * 32, PR_VT2 = 2 * 4 * 8, PR_YT = (M_TOK / 32) * 4;
constexpr int PR_ITEMS = PR_TOK + PR_CK + PR_VT0 + PR_VT1 + PR_VT2 + PR_YT;
__device__ __forceinline__ void prep_phase(const KArgs& A, int l, LAS unsigned char* lds, int gw, int NGW, int wave, int lane) {
    unsigned char* ws = A.ws;
    const bf16* U = (const bf16*)(ws + WS_U); bf16* QB = (bf16*)(ws + WS_QB); bf16* KB = (bf16*)(ws + WS_KB);
    float* QN = (float*)(ws + WS_QN); unsigned* kmax = (unsigned*)(ws + WS_CTL) + CW_KMAX + l * NSEQ * 8; const float* rope = (const float*)(ws + WS_ROPE);
    LAS unsigned char* scr = lds + wave * 16384;
    for (int it = gw; it < PR_ITEMS; it += NGW) {
        int r = it;
        if (r < PR_YT) { prep_yt_item(l, r, lane, U, (const bf16*)(ws + WS_WCS), (bf16*)(ws + WS_YTC), (bf16*)(ws + WS_YTL)); continue; } r -= PR_YT;
        if (r < PR_VT0) { prep_vt_item(A, l, 0, r, lane, U, (bf16*)(ws + WS_VTC), scr); continue; } r -= PR_VT0;
        if (r < PR_VT1) { prep_vt_item(A, l, 1, r, lane, U, (bf16*)(ws + WS_VTC), scr); continue; } r -= PR_VT1;
        if (r < PR_VT2) { prep_vt_item(A, l, 2, r, lane, U, (bf16*)(ws + WS_VTC), scr); continue; } r -= PR_VT2;
        if (r < PR_CK) { prep_cachek_item(A, l, r, lane, KB, kmax); continue; } r -= PR_CK;
        prep_token_item(A, l, r, lane, U, QB, KB, QN, kmax, rope);
    }
}
#define WG_BAR() do { asm volatile("s_waitcnt vmcnt(0) lgkmcnt(0)" ::: "memory"); __builtin_amdgcn_s_barrier(); asm volatile("" ::: "memory"); } while (0)
__device__ __forceinline__ void lds_fadd(LAS float* p, float v) { (void)__hip_atomic_fetch_add(p, v, __ATOMIC_RELAXED, __HIP_MEMORY_SCOPE_WORKGROUP); }
#define ATT_LOADK(dst, kp_) do { _Pragma("unroll") for (int ds_ = 0; ds_ < 4; ++ds_) dst[ds_] = *(const GAS bf16x8*)((kp_) + ds_ * 512); } while (0)
#define ATT_LOADV(dst, vp_) do { _Pragma("unroll") for (int i_ = 0; i_ < 8; ++i_) dst[i_] = *(const GAS bf16x8*)((vp_) + i_ * 512); } while (0)
#define ATT_QK(kf_) f32x16 S_; do { _Pragma("unroll") for (int r_ = 0; r_ < 16; ++r_) S_[r_] = nm; \
        _Pragma("unroll") for (int ds_ = 0; ds_ < 4; ++ds_) S_ = __builtin_amdgcn_mfma_f32_32x32x16_bf16(kf_[ds_], qf[ds_], S_, 0, 0, 0); } while (0)
#define ATT_PV(vf_) do { bf16x8 pa_[2]; \
        _Pragma("unroll") for (int s2_ = 0; s2_ < 2; ++s2_) { unsigned w_[4]; \
            _Pragma("unroll") for (int i_ = 0; i_ < 4; ++i_) { const float a_ = __builtin_amdgcn_exp2f(S_[8 * s2_ + 2 * i_]), b_ = __builtin_amdgcn_exp2f(S_[8 * s2_ + 2 * i_ + 1]); lsum += a_ + b_; w_[i_] = pk2(a_, b_); } \
            pa_[s2_] = __builtin_bit_cast(bf16x8, (v4u){w_[0], w_[1], w_[2], w_[3]}); } \
        _Pragma("unroll") for (int s2_ = 0; s2_ < 2; ++s2_) _Pragma("unroll") for (int d_ = 0; d_ < 4; ++d_) O[d_] = __builtin_amdgcn_mfma_f32_32x32x16_bf16(pa_[s2_], vf_[s2_ * 4 + d_], O[d_], 0, 0, 0); } while (0)
constexpr int LX_OFF = RING_BYTES + 1024;
__device__ __forceinline__ void attn_unit(const KArgs& A, int l, int seq, int h, int qb, LAS unsigned char* lds, int tid, int wave, int lane) {
    asm volatile("" : "+v"(tid), "+v"(lane));
    unsigned char* ws = A.ws; asm volatile("" : "+s"(ws));
    const bf16* QF = (const bf16*)(ws + WS_QB); const bf16* KF = (const bf16*)(ws + WS_KB); const bf16* VF = (const bf16*)(ws + WS_VTC); const float* QN = (const float*)(ws + WS_QN);
    const unsigned* kmax = (const unsigned*)(ws + WS_CTL) + CW_KMAX + l * NSEQ * 8;
    const bool lat = seq >= 32;
    const int qrow0 = lat ? M_CTX + (seq - 32) * 1024 + qb * 64 : seq * 256 + qb * 64;
    const int qs = wave & 1, ks = wave >> 1, r32 = lane & 31, hi = lane >> 5;
    const int nt = lat ? 10 : 2;
    const int qrow = qrow0 + qs * 32 + r32;
    LAS float* PO = (LAS float*)lds + wave * 4096;
    LAS float* PL = (LAS float*)(lds + LX_OFF);
    float acc[16];
#pragma unroll
    for (int i = 0; i < 16; ++i) acc[i] = 0.f;
    const float lam = ((const float*)(ws + WS_SCAL))[l];
#pragma unroll 1
    for (int c = 0; c < 2; ++c) {
        const size_t qchunk = lat ? 2048 + (size_t)((seq - 32) * 8 + h * 2 + c) * 32 + (qb * 2 + qs) : (size_t)(seq * 8 + h * 2 + c) * 8 + (qb * 2 + qs);
        const size_t kchunk = lat ? 2048 + (size_t)((seq - 32) * 8 + h * 2 + c) * 40 + ks * nt : (size_t)(seq * 8 + h * 2 + c) * 8 + ks * nt;
        const size_t vchunk = lat ? 1024 + (size_t)((seq - 32) * 4 + h) * 40 + ks * nt : (size_t)(seq * 4 + h) * 8 + ks * nt;
        const bf16* kp = KF + kchunk * 2048 + lane * 8; const bf16* vp = VF + vchunk * 4096 + lane * 8;
        bf16x8 qf[4], kf[4], vf[8];
        ATT_LOADK(qf, QF + qchunk * 2048 + lane * 8);
        ATT_LOADK(kf, kp); ATT_LOADV(vf, vp);
        const float nm = -QN[(size_t)qrow * 8 + h * 2 + c] * __builtin_bit_cast(float, kmax[seq * 8 + h * 2 + c]);
        f32x16 O[4];
#pragma unroll
        for (int d = 0; d < 4; ++d) O[d] = (f32x16){};
        float lsum = 0.f;
#pragma unroll 1
        for (int t = 0; t < nt; ++t) {
            ATT_QK(kf);
            __builtin_amdgcn_sched_barrier(0);
            if (t + 1 < nt) ATT_LOADK(kf, kp + (size_t)(t + 1) * 2048);
            ATT_PV(vf);
            __builtin_amdgcn_sched_barrier(0);
            if (t + 1 < nt) ATT_LOADV(vf, vp + (size_t)(t + 1) * 4096);
        }
        lsum += __shfl_xor(lsum, 32);
        if (hi == 0) PL[wave * 32 + r32] = lsum;
#pragma unroll
        for (int d = 0; d < 4; ++d)
#pragma unroll
            for (int r = 0; r < 16; ++r) { const int row = crow(r, hi); PO[row * 128 + ((d * 32 + r32) ^ ((row & 1) << 5))] = O[d][r]; }
        WG_BAR();
        {
            const int row = tid >> 3, a = tid & 7, q2 = row >> 5, r5 = row & 31;
            const float lt = (PL[(0 + q2) * 32 + r5] + PL[(2 + q2) * 32 + r5]) + (PL[(4 + q2) * 32 + r5] + PL[(6 + q2) * 32 + r5]);
            const float sc = c == 0 ? 1.0f / lt : -lam / lt;
#pragma unroll
            for (int i = 0; i < 4; ++i) { const int col = (32 * i + 4 * a) ^ ((r5 & 1) << 5);
                f32x4 v = *(const LAS f32x4*)((LAS float*)lds + (0 + q2) * 4096 + r5 * 128 + col);
                v += *(const LAS f32x4*)((LAS float*)lds + (2 + q2) * 4096 + r5 * 128 + col);
                v += *(const LAS f32x4*)((LAS float*)lds + (4 + q2) * 4096 + r5 * 128 + col);
                v += *(const LAS f32x4*)((LAS float*)lds + (6 + q2) * 4096 + r5 * 128 + col);
#pragma unroll
                for (int e = 0; e < 4; ++e) acc[4 * i + e] += v[e] * sc; }
        }
        WG_BAR();
    }
    {
        const int row = tid >> 3, a = tid & 7;
        const float lam_init = 0.8f - 0.6f * expf(-0.3f * (float)l);
        float ss = 0.f;
#pragma unroll
        for (int i = 0; i < 16; ++i) ss += acc[i] * acc[i];
#pragma unroll
        for (int of = 1; of < 8; of <<= 1) ss += __shfl_xor(ss, of);
        const float sc = (1.0f - lam_init) / sqrtf(ss * (1.0f / 128.0f) + EPS);
        const float* g = A.in[I_AOG] + l * 128 + 4 * a;
        bf16* mp = (bf16*)(ws + WS_MIX) + (size_t)(qrow0 + row) * DM + 512 + h * 128 + 4 * a;
#pragma unroll
        for (int i = 0; i < 4; ++i) { const f32x4 gv = *(const f32x4*)(g + 32 * i);
            *(GAS u32x2*)(mp + 32 * i) = (u32x2){pk2(acc[4 * i] * sc * gv[0], acc[4 * i + 1] * sc * gv[1]), pk2(acc[4 * i + 2] * sc * gv[2], acc[4 * i + 3] * sc * gv[3])}; }
    }
}
__device__ __forceinline__ void fourier_unit(const KArgs& A, int seq, int g, int rb, LAS unsigned char* lds, int tid, int wave, int lane) {
    asm volatile("" : "+v"(tid), "+v"(lane));
    unsigned char* ws = A.ws; asm volatile("" : "+s"(ws));
    const bool lat = seq >= 32; const int L = lat ? 1024 : 256, nks = L >> 4;
    const bf16* TW = lat ? (const bf16*)(ws + WS_TW1024) : (const bf16*)(ws + WS_TW256);
    const bf16* Y = lat ? (const bf16*)(ws + WS_YTL) + (size_t)(((seq - 32) * 4 + g) * 128) * 1024 : (const bf16*)(ws + WS_YTC) + (size_t)((seq * 4 + g) * 128) * 256;
    const int row0 = (lat ? M_CTX + (seq - 32) * 1024 : seq * 256) + rb * 128;
    const int rt = wave & 3, kh = wave >> 2, r32 = lane & 31, hi = lane >> 5;
    const bf16* ap = TW + ((size_t)((rb * 4 + rt) * 2 + kh) * nks) * 512 + lane * 8;
    const bf16* bp0 = Y + ((size_t)(kh * 2 + 0) * nks) * 512 + lane * 8;
    const bf16* bp1 = Y + ((size_t)(kh * 2 + 1) * nks) * 512 + lane * 8;
    f32x16 acc0 = {}, acc1 = {};
#pragma unroll 4
    for (int ks = 0; ks < nks; ++ks) { const bf16x8 a = *(const GAS bf16x8*)(ap + (size_t)ks * 512), b0 = *(const GAS bf16x8*)(bp0 + (size_t)ks * 512), b1 = *(const GAS bf16x8*)(bp1 + (size_t)ks * 512);
        acc0 = __builtin_amdgcn_mfma_f32_32x32x16_bf16(a, b0, acc0, 0, 0, 0); acc1 = __builtin_amdgcn_mfma_f32_32x32x16_bf16(a, b1, acc1, 0, 0, 0); }
    LAS float* C = (LAS float*)lds + rt * 2048;
    if (kh == 1) {
#pragma unroll
        for (int r = 0; r < 16; ++r) { C[crow(r, hi) * 64 + r32] = acc0[r]; C[crow(r, hi) * 64 + 32 + r32] = acc1[r]; } }
    WG_BAR();
    if (kh == 0) { const float s = lat ? (1.0f / 256.0f) : (1.0f / 128.0f);
        bf16* mp = (bf16*)(ws + WS_MIX) + (size_t)(row0 + rt * 32) * DM + 256 + g * 64 + r32;
#pragma unroll
        for (int r = 0; r < 16; ++r) { const int row = crow(r, hi);
            mp[(size_t)row * DM] = (bf16)f2bf((acc0[r] + C[row * 64 + r32]) * s); mp[(size_t)row * DM + 32] = (bf16)f2bf((acc1[r] + C[row * 64 + 32 + r32]) * s); } }
    WG_BAR();
}
template <int HALF> __device__ __forceinline__ void pool_item_g(const KArgs& A, int l, int chunk, int g, int lane, unsigned char* ws) {
    const bf16* U = (const bf16*)(ws + WS_U);
    const int row0 = chunk * 64;
    int sstart, L; if (row0 < M_CTX) { sstart = row0 & ~255; L = 256; } else { sstart = M_CTX + ((row0 - M_CTX) & ~1023); L = 1024; }
    const int sub = lane >> 4, c4 = (lane & 15) * 4, p0 = row0 - sstart + 16 * sub;
    constexpr int NR = 16 + 2 * HALF;
    f32x4 z[NR];
#pragma unroll
    for (int i = 0; i < NR; ++i) { const int pos = p0 - HALF + i; u32x2 w = {0u, 0u};
        if (pos >= 0 && pos < L) w = *(const GAS u32x2*)(U + (size_t)(sstart + pos) * NIN + g * 64 + c4);
        z[i] = (f32x4){bf2f(w.x & 0xffffu), bf2f(w.x >> 16), bf2f(w.y & 0xffffu), bf2f(w.y >> 16)}; }
    const f32x4 sc = *(const f32x4*)(A.in[I_POOLS] + l * 256 + g * 64 + c4);
    f32x4 run = {0.f, 0.f, 0.f, 0.f};
#pragma unroll
    for (int i = 0; i < 2 * HALF; ++i) run += z[i];
    bf16* mp = (bf16*)(ws + WS_MIX) + (size_t)(sstart + p0) * DM + g * 64 + c4;
#pragma unroll
    for (int t = 0; t < 16; ++t) { const int pos = p0 + t; const int cnt = min(pos + HALF, L) - max(pos - HALF, 0);
        const f32x4 y = (run * (1.0f / (float)cnt) - z[t + HALF]) * sc;
        *(GAS u32x2*)(mp + (size_t)t * DM) = (u32x2){pk2(y.x, y.y), pk2(y.z, y.w)};
        if (t < 15) run += z[t + 2 * HALF] - z[t]; }
}
__device__ __forceinline__ void pool_item(const KArgs& A, int l, int item, int lane) {
    asm volatile("" : "+v"(lane));
    unsigned char* ws = A.ws; asm volatile("" : "+s"(ws));
    const int g = item & 3, chunk = item >> 2;
    if (g == 0) pool_item_g<1>(A, l, chunk, 0, lane, ws); else if (g == 1) pool_item_g<2>(A, l, chunk, 1, lane, ws);
    else if (g == 2) pool_item_g<4>(A, l, chunk, 2, lane, ws); else pool_item_g<8>(A, l, chunk, 3, lane, ws);
}
constexpr int MX_LATT = 2 * 4 * 16, MX_CATT = 32 * 4 * 4, MX_LFOU = 2 * 4 * 8, MX_CFOU = 32 * 4 * 2, MX_POOL = (M_TOK / 64) * 4;
__device__ __forceinline__ void mix_phase(const KArgs& A, int l, LAS unsigned char* lds, int vcu, int G, int tid, int wave, int lane, int sel = 31) {
    if (sel & 5) {
#pragma unroll 1
        for (int it = vcu; it < MX_LATT + MX_CATT; it += G) {
            const bool isl = it < MX_LATT; const int r = it - MX_LATT;
            const int seq = isl ? 32 + (it >> 6) : r >> 4, hh = isl ? (it >> 4) & 3 : (r >> 2) & 3, qb = isl ? it & 15 : r & 3;
            if (sel & (isl ? 1 : 4)) attn_unit(A, l, seq, hh, qb, lds, tid, wave, lane);
        }
    }
    constexpr int O1 = MX_LATT + MX_CATT;
    if (sel & 10) {
#pragma unroll 1
        for (int it = ((vcu - O1) % G + G) % G; it < MX_LFOU + MX_CFOU; it += G) {
            const bool isl = it < MX_LFOU; const int r = it - MX_LFOU;
            const int seq = isl ? 32 + (it >> 5) : r >> 3, gg = isl ? (it >> 3) & 3 : (r >> 1) & 3, rb = isl ? it & 7 : r & 1;
            if (sel & (isl ? 2 : 8)) fourier_unit(A, seq, gg, rb, lds, tid, wave, lane);
        }
    }
    constexpr int O2 = O1 + MX_LFOU + MX_CFOU;
    if (sel & 16) {
        const int gw2 = (((vcu - O2) % G + G) % G) * NWAVES + wave;
#pragma unroll 1
        for (int it = gw2; it < MX_POOL; it += G * NWAVES) pool_item(A, l, it, lane);
    }
}
#define CAS __attribute__((address_space(4)))
#ifndef PROBE_KIND
#define PROBE_KIND -1
#endif
#ifndef PROBE_SEL
#define PROBE_SEL 31
#endif
#ifndef PROBE_N
#define PROBE_N 1
#endif
constexpr bool probe_match(int P, int kind) {
    if (kind < 0) return false;
    if (kind == 7) return P < NPHASES - 1;
    if (P == 0) return kind == 0;
    const int l = (P - 1) / 11, k = (P - 1) % 11;
    if (kind == 1) return k == 0 || k == 3 || k == 8;
    if (kind == 2) return k == 1 || k == 9;
    if (kind == 3) return k == 2 && l == 0;
    if (kind == 4) return k == 4;
    if (kind == 5) return k == 5;
    if (kind == 6) return k == 6;
    return false;
}
template <int PH> __device__ __forceinline__ void run_phase(const bool DUP, const KArgs& A, LAS unsigned char* lds, int tid, int lane, int wave, int G, int bx, int vcu, int gw, int NGW) {
    unsigned char* ws = A.ws;
    float* X = A.out;
    const float* mods = (const float*)(ws + WS_CTL) + CW_MODS;
    bf16* XN = (bf16*)(ws + WS_XN); bf16* GBUF = (bf16*)(ws + WS_GB); bf16* UB = (bf16*)(ws + WS_U); bf16* MIXB = (bf16*)(ws + WS_MIX);
    if constexpr (PH == 0) {
#ifndef SKIP_P0
        p0_prologue(A, lds, gw, NGW, wave, lane, DUP);
#endif
    } else {
        constexpr int l = (PH - 1) / 11, k = (PH - 1) % 11;
        const float* mods_l = mods + (size_t)l * 3 * 9216;
        unsigned char* wl = ws + WS_W + (size_t)l * SZ_WLAYER;
        const float* ng = A.in[I_NG] + (size_t)l * 3 * DM;
        if constexpr (k == 0) { if (l == 0) norm_phase(A.in[I_XP], A.in[I_XS], XN, ng, mods_l, 0, gw, NGW, lane); else norm_phase(X, X + OUT_YS, XN, ng, mods_l, 0, gw, NGW, lane); }
        else if constexpr (k == 3) norm_phase(X, X + OUT_YS, XN, ng + DM, mods_l, 1, gw, NGW, lane);
        else if constexpr (k == 8) norm_phase(X, X + OUT_YS, XN, ng + 2 * DM, mods_l, 2, gw, NGW, lane);
        else if constexpr (k == 1 || k == 9) {
            pg8::Gemm g{XN, (const bf16*)(wl + (k == 1 ? OFF_WI1 : OFF_WI2)), M_TOK, NWI, DM}; pg8::StaticOrder S; S.init(M_TOK, NWI, G, bx);
            pg8::EpiSwiglu E{GBUF, FF};
            pg8::gemm_phase<pg8::EpiSwiglu, pg8::StaticOrder, true, true>(lds, g, S, E);
        } else if constexpr (k == 2 || k == 10) {
            pg8::Gemm g{GBUF, (const bf16*)(wl + (k == 2 ? OFF_WO1 : OFF_WO2)), M_TOK, DM, FF}; pg8::StaticOrder S; S.init(M_TOK, DM, G, bx);
            constexpr bool first = (k == 2 && l == 0);
            pg8::EpiResGate E{first ? A.in[I_XP] : X, first ? A.in[I_XS] : X + OUT_YS, X, mods_l, k == 2 ? 2 : 8, 0.5f};
            pg8::gemm_phase<pg8::EpiResGate, pg8::StaticOrder, true, true>(lds, g, S, E);
        } else if constexpr (k == 4) {
            pg8::Gemm g{XN, (const bf16*)(wl + OFF_WIN), M_TOK, NIN, DM}; pg8::StaticOrder S; S.init(M_TOK, NIN, G, bx);
            pg8::EpiU E{UB, A.out + OUT_V, l};
            pg8::gemm_phase<pg8::EpiU, pg8::StaticOrder, true, true>(lds, g, S, E);
        } else if constexpr (k == 5) {
#ifndef SKIP_PREP
            prep_phase(A, l, lds, gw, NGW, wave, lane);
#endif
        } else if constexpr (k == 6) {
#ifndef SKIP_MIX
            mix_phase(A, l, lds, vcu, G, tid, wave, lane, DUP ? PROBE_SEL : 31);
#endif
        } else if constexpr (k == 7) {
            pg8::Gemm g{MIXB, (const bf16*)(wl + OFF_WOUT), M_TOK, DM, DM}; pg8::StaticOrder S; S.init(M_TOK, DM, G, bx);
            pg8::EpiResGate E{X, X + OUT_YS, X, mods_l, 5, 1.0f};
            pg8::gemm_phase<pg8::EpiResGate, pg8::StaticOrder, true, true>(lds, g, S, E);
        }
    }
}
__global__ void __launch_bounds__(NWAVES * 64, 2) hyb_fwd(KArgs A) {
    extern __shared__ __attribute__((aligned(16))) unsigned char lds_raw[];
    LAS unsigned char* lds = (LAS unsigned char*)lds_raw;
    volatile LAS unsigned* MISC = (volatile LAS unsigned*)(lds + MISC_OFF);
    const int tid = threadIdx.x, lane = tid & 63, wave = __builtin_amdgcn_readfirstlane(tid >> 6);
    const int G = gridDim.x, bx = blockIdx.x, vcu = (G % 8 == 0) ? (bx % 8) * (G / 8) + bx / 8 : bx;
    const int gw = vcu * NWAVES + wave, NGW = G * NWAVES;
    gu32* ctl = (gu32*)(A.ws + WS_CTL);
    for (int u = tid; u < (LDS_BYTES - LDSCTL_OFF) / 4; u += NWAVES * 64) ((LAS unsigned*)(lds + LDSCTL_OFF))[u] = 0u;
    __syncthreads();
    const int lo = A.ph_lo, hi = A.ph_hi;
    XcdBarrier bar; bar.bar = (unsigned*)(ctl + CW_BAR); bar.x = 0; bar.st = nullptr;
    if (hi - lo > 1) bar = xcd_barrier_post((unsigned*)(ctl + CW_BAR), MISC + 8);
#define PHASE(P) if (lo <= (P) && (P) < hi) { _Pragma("unroll 1") for (int rep_ = 0; rep_ < (probe_match(P, PROBE_KIND) ? 1 + PROBE_N : 1); ++rep_) { \
        if (PROBE_KIND != 7 || rep_ == 0) run_phase<P>(rep_ > 0, A, lds, tid, lane, wave, G, bx, vcu, gw, NGW); if ((P) + 1 < hi || rep_ + 1 < (probe_match(P, PROBE_KIND) ? 1 + PROBE_N : 1)) xcd_barrier(bar); } }
    PHASE(0) PHASE(1) PHASE(2) PHASE(3) PHASE(4) PHASE(5) PHASE(6) PHASE(7) PHASE(8) PHASE(9) PHASE(10) PHASE(11)
    PHASE(12) PHASE(13) PHASE(14) PHASE(15) PHASE(16) PHASE(17) PHASE(18) PHASE(19) PHASE(20) PHASE(21) PHASE(22)
#undef PHASE
}

#ifndef N_LAUNCH_MODE
#define N_LAUNCH_MODE 1
#endif
extern "C" void kernel_launch(void* const* d_in, const int* in_sizes, int n_in, void* d_out, int out_size, void* d_ws, size_t ws_size, hipStream_t stream) {
    static int grid = 0;
    if (grid == 0) {
        if (n_in != 25 || ws_size < WS_END) { fprintf(stderr, "kernel_launch: unexpected n_in %d / ws %zu\n", n_in, ws_size); grid = -1; return; }
        int dev = 0, cus = 0, per_cu = 0;
        if (hipGetDevice(&dev) != hipSuccess || hipDeviceGetAttribute(&cus, hipDeviceAttributeMultiprocessorCount, dev) != hipSuccess) { grid = -1; return; }
        if (hipFuncSetAttribute((const void*)hyb_fwd, hipFuncAttributeMaxDynamicSharedMemorySize, LDS_BYTES) != hipSuccess) { fprintf(stderr, "kernel_launch: hipFuncSetAttribute failed\n"); grid = -1; return; }
        if (hipOccupancyMaxActiveBlocksPerMultiprocessor(&per_cu, (const void*)hyb_fwd, NWAVES * 64, LDS_BYTES) != hipSuccess || per_cu < 1) { fprintf(stderr, "kernel_launch: occupancy query says %d blocks per CU\n", per_cu); }
        (void)hipGetLastError();
        grid = cus;
    }
    if (grid < 0) return;
    if (hipMemsetAsync((char*)d_ws + WS_CTL, 0, CTL_ZERO_BYTES, stream) != hipSuccess) return;
    KArgs a{};
    for (int i = 0; i < 25; ++i) a.in[i] = (const float*)d_in[i];
    a.out = (float*)d_out; a.ws = (unsigned char*)d_ws;
#if N_LAUNCH_MODE == 0
    for (int p = 0; p < NPHASES; ++p) { a.ph_lo = p; a.ph_hi = p + 1; hipLaunchKernelGGL(hyb_fwd, dim3(grid), dim3(NWAVES * 64), LDS_BYTES, stream, a); }
#else
    a.ph_lo = 0; a.ph_hi = NPHASES; hipLaunchKernelGGL(hyb_fwd, dim3(grid), dim3(NWAVES * 64), LDS_BYTES, stream, a);
#endif
}
```

```cpp
#include <hip/hip_runtime.h>
#include <cstdio>
#include <cstdint>
namespace pg8 {
#define PG8_LAS __attribute__((address_space(3)))
typedef unsigned short bf16_t;
typedef short bf16x8 __attribute__((ext_vector_type(8)));
typedef float f32x4 __attribute__((ext_vector_type(4)));
typedef unsigned u32x4 __attribute__((ext_vector_type(4)));
constexpr int BM = 256, BK = 64, HALF = 128, HTB = HALF * BK * 2  , STAGE_BYTES = 8 * HTB, NXCD = 8, WGM = 8;

__host__ __device__ __forceinline__ int lds_byte(int r, int c) { const int st = (r >> 4) * 2 + (c >> 5), rr = r & 15, cc = c & 31, ob = rr * 64 + cc * 2; return st * 1024 + (ob ^ (((ob >> 9) & 1) << 5)); }
__host__ __device__ __forceinline__ void stage_rc(int b, int& R, int& C) { const int st = b / 1024, sb = b % 1024, swz = sb ^ (((sb >> 9) & 1) << 5); R = (st >> 1) * 16 + swz / 64; C = (st & 1) * 32 + (swz % 64) / 2; }
__host__ __device__ __forceinline__ int perm32(int rho) { const int n = rho >> 4, i = rho & 15; return 8 * (i >> 2) + 4 * n + (i & 3); }

struct Unit { int pm, pn; };
struct Gemm { const bf16_t* A; const bf16_t* Bt; int M, N, K; };

struct StaticOrder {
    int nM, nN, nwg, G, c;
    __host__ __device__ void init(int M, int N, int G_, int c_, int TM = BM) { nM = M / TM; nN = N / BM; nwg = nM * nN; G = G_; c = c_; }
    __host__ __device__ bool next(int i, Unit& u) const {
        const long L = (long)i * G + c; if (L >= nwg) return false;
        int wgid = (int)L; { const int q = nwg / NXCD, r = nwg % NXCD, xcd = wgid % NXCD, off = wgid / NXCD; wgid = (xcd < r ? xcd * (q + 1) : r * (q + 1) + (xcd - r) * q) + off; }
        const int nig = WGM * nN, gid = wgid / nig, fm = gid * WGM, gsz = (nM - fm) < WGM ? (nM - fm) : WGM;
        u.pm = fm + ((wgid % nig) % gsz); u.pn = (wgid % nig) / gsz; return true;
    }
    __device__ __forceinline__ void a_ready(const Unit&) const {}
    __device__ __forceinline__ void done(const Unit&) const {}
};

__device__ __forceinline__ unsigned cvt_pk_bf16(float lo, float hi) { unsigned r; asm volatile("v_cvt_pk_bf16_f32 %0, %1, %2" : "=v"(r) : "v"(lo), "v"(hi)); return r; }
typedef float f32x2 __attribute__((ext_vector_type(2)));
template <class Epi, class Sched, bool ALIGN_EPI = false, bool SP2 = false, int M1 = 4>
__device__ __forceinline__ void gemm_phase(PG8_LAS unsigned char* lds, const Gemm g, const Sched& S, const Epi& E) {
    const int tid = threadIdx.x, wid = __builtin_amdgcn_readfirstlane(tid >> 6), lane = tid & 63, wr = wid >> 2, wc = wid & 3, fr = lane & 15, fq = lane >> 4;
    const int K = g.K, nt = K / BK;
    unsigned voffA[2], voffB[2];
#pragma unroll
    for (int i = 0; i < 2; ++i) { int R, C; stage_rc(tid * 16 + i * 8192, R, C); const int Rb = Epi::PERM ? ((R & ~31) + perm32(R & 31)) : R;
        voffA[i] = (unsigned)(R * K + C) * 2u; voffB[i] = (unsigned)(Rb * K + C) * 2u; }
    unsigned voffA1[2], ldsA1[2];
#pragma unroll
    for (int i = 0; i < 2; ++i) { if (M1 == 4) { voffA1[i] = voffA[i]; ldsA1[i] = (unsigned)wid * 1024u + i * 8192u; }
        else { int R, C; stage_rc((wid & 3) * 1024 + lane * 16, R, C); voffA1[i] = (unsigned)(R * K + C) * 2u; ldsA1[i] = (unsigned)(wid & 3) * 1024u; } }
    const size_t kstep = (size_t)(BK * 2);
    const size_t hstep = (size_t)HALF * K * 2;
    const size_t tstep = 2 * hstep;
    const size_t tstepA = (size_t)(HALF + 32 * M1) * K * 2;
    const unsigned ldsw = (unsigned)wid * 1024u;
    const int aoff = lds_byte(wr * 64 + fr, fq * 8), boff = lds_byte(wc * 32 + fr, fq * 8), aoff1 = lds_byte(wr * 16 * M1 + fr, fq * 8);
#define PG8_SA(b, h) (((b) * 2 + (h)) * HTB)
#define PG8_SB(b, h) ((4 + (b) * 2 + (h)) * HTB)
#define PG8_STAGE(bufoff, gbase, voff) do { _Pragma("unroll") for (int _i = 0; _i < 2; ++_i) \
        __builtin_amdgcn_global_load_lds((const unsigned*)((const char*)(gbase) + (voff)[_i]), (PG8_LAS unsigned*)(lds + (bufoff) + ldsw + _i * 8192), 16, 0, 0); } while (0)
#define PG8_STAGE_A1(bufoff, gbase) do { _Pragma("unroll") for (int _i = 0; _i < 2; ++_i) \
        __builtin_amdgcn_global_load_lds((const unsigned*)((const char*)(gbase) + voffA1[_i]), (PG8_LAS unsigned*)(lds + (bufoff) + ldsA1[_i]), 16, 0, 0); } while (0)
#define PG8_LDA(dst, b, h) do { _Pragma("unroll") for (int m = 0; m < ((h) ? M1 : 4); ++m) _Pragma("unroll") for (int k = 0; k < 2; ++k) dst[m][k] = *(const PG8_LAS bf16x8*)(lds + PG8_SA(b, h) + ((h) ? aoff1 : aoff) + m * 2048 + k * 1024); } while (0)
#define PG8_LDB(dst, b, h) do { _Pragma("unroll") for (int n = 0; n < 2; ++n) _Pragma("unroll") for (int k = 0; k < 2; ++k) dst[n][k] = *(const PG8_LAS bf16x8*)(lds + PG8_SB(b, h) + boff + n * 2048 + k * 1024); } while (0)
#define PG8_MMA(ai, bj, At, Bt) do { __builtin_amdgcn_s_setprio(1); _Pragma("unroll") for (int m = 0; m < ((ai) ? M1 : 4); ++m) _Pragma("unroll") for (int n = 0; n < 2; ++n) _Pragma("unroll") for (int k = 0; k < 2; ++k) \
        acc[ai][bj][m][n] = __builtin_amdgcn_mfma_f32_16x16x32_bf16(Bt[n][k], At[m][k], acc[ai][bj][m][n], 0, 0, 0); __builtin_amdgcn_s_setprio(0); } while (0)
#define PG8_WAIT_V(n) asm volatile("s_waitcnt vmcnt(" #n ")" ::: "memory")
#define PG8_WAIT_L(n) asm volatile("s_waitcnt lgkmcnt(" #n ")" ::: "memory")
#define PG8_BAR __builtin_amdgcn_s_barrier()
#define PG8_SCHED __builtin_amdgcn_sched_barrier(0)
    Unit cur, nxt; int ui = 0;
    if (!S.next(0, cur)) return;
    f32x4 acc[2][2][4][2];
#pragma unroll
    for (int a = 0; a < 2; ++a)
#pragma unroll
        for (int b = 0; b < 2; ++b)
#pragma unroll
            for (int m = 0; m < 4; ++m)
#pragma unroll
                for (int n = 0; n < 2; ++n) acc[a][b][m][n] = (f32x4){0.f, 0.f, 0.f, 0.f};
    bf16x8 At[4][2], B0[2][2], B1[2][2];
    const char* cA = (const char*)g.A + (size_t)cur.pm * tstepA; const char* cB = (const char*)g.Bt + (size_t)cur.pn * tstep;
    S.a_ready(cur);
    if constexpr (SP2) {
        PG8_STAGE(PG8_SB(0, 0), cB, voffB); PG8_STAGE(PG8_SB(0, 1), cB + hstep, voffB); PG8_STAGE(PG8_SA(0, 0), cA, voffA); PG8_STAGE_A1(PG8_SA(0, 1), cA + hstep);
        if (wr == 1) PG8_BAR;
        PG8_WAIT_V(2); PG8_BAR;
        PG8_STAGE(PG8_SB(1, 0), cB + kstep, voffB); PG8_STAGE(PG8_SA(1, 0), cA + kstep, voffA); PG8_STAGE(PG8_SB(1, 1), cB + hstep + kstep, voffB);
        PG8_WAIT_V(6); PG8_BAR;
    } else {
        PG8_STAGE(PG8_SB(0, 0), cB, voffB); PG8_STAGE(PG8_SA(0, 0), cA, voffA); PG8_STAGE(PG8_SB(0, 1), cB + hstep, voffB); PG8_STAGE_A1(PG8_SA(0, 1), cA + hstep);
        if (wr == 1) PG8_BAR;
        PG8_WAIT_V(4); PG8_BAR;
        PG8_STAGE(PG8_SB(1, 0), cB + kstep, voffB); PG8_STAGE(PG8_SA(1, 0), cA + kstep, voffA); PG8_STAGE(PG8_SB(1, 1), cB + hstep + kstep, voffB);
        PG8_WAIT_V(6); PG8_BAR;
    }
    for (;;) {
        const bool has_next = S.next(ui + 1, nxt);
        const char* nA = has_next ? (const char*)g.A + (size_t)nxt.pm * tstepA : cA; const char* nB = has_next ? (const char*)g.Bt + (size_t)nxt.pn * tstep : cB;
        for (int t = 0; t < nt; t += 2) {
            const bool last = (t == nt - 2);
            const char* a1 = cA + (size_t)(t + 1) * kstep;
            const char* a2 = last ? nA : cA + (size_t)(t + 2) * kstep; const char* b2 = last ? nB : cB + (size_t)(t + 2) * kstep;
            const char* a3 = a2 + kstep; const char* b3 = b2 + kstep;
            if (last && has_next) S.a_ready(nxt);
            if constexpr (SP2) {
            PG8_LDB(B0, 0, 0); PG8_LDB(B1, 0, 1); PG8_SCHED; PG8_LDA(At, 0, 0); PG8_STAGE_A1(PG8_SA(1, 1), a1 + hstep);
            PG8_WAIT_V(8); PG8_WAIT_L(0); PG8_BAR; PG8_MMA(0, 0, At, B0); PG8_MMA(0, 1, At, B1); PG8_BAR; PG8_SCHED;
            PG8_LDA(At, 0, 1); PG8_STAGE(PG8_SB(0, 0), b2, voffB); PG8_STAGE(PG8_SB(0, 1), b2 + hstep, voffB); PG8_STAGE(PG8_SA(0, 0), a2, voffA);
            PG8_WAIT_V(8); PG8_WAIT_L(0); PG8_BAR; PG8_MMA(1, 0, At, B0); PG8_MMA(1, 1, At, B1); PG8_BAR; PG8_SCHED;
            PG8_LDB(B0, 1, 0); PG8_LDB(B1, 1, 1); PG8_SCHED; PG8_LDA(At, 1, 0); PG8_STAGE_A1(PG8_SA(0, 1), a2 + hstep);
            PG8_WAIT_V(8); PG8_WAIT_L(0); PG8_BAR; PG8_MMA(0, 0, At, B0); PG8_MMA(0, 1, At, B1); PG8_BAR; PG8_SCHED;
            PG8_LDA(At, 1, 1); PG8_STAGE(PG8_SB(1, 0), b3, voffB); PG8_STAGE(PG8_SB(1, 1), b3 + hstep, voffB); PG8_STAGE(PG8_SA(1, 0), a3, voffA);
            PG8_WAIT_V(8); PG8_WAIT_L(0); PG8_BAR; PG8_MMA(1, 0, At, B0); PG8_MMA(1, 1, At, B1); PG8_BAR; PG8_SCHED;
            } else {
            PG8_LDB(B0, 0, 0); PG8_SCHED; PG8_LDA(At, 0, 0); PG8_STAGE_A1(PG8_SA(1, 1), a1 + hstep);
            PG8_WAIT_L(8); PG8_BAR; PG8_WAIT_L(0); PG8_MMA(0, 0, At, B0); PG8_BAR; PG8_SCHED;
            PG8_LDB(B1, 0, 1); PG8_STAGE(PG8_SB(0, 0), b2, voffB);
            PG8_BAR; PG8_WAIT_L(0); PG8_MMA(0, 1, At, B1); PG8_BAR;
            PG8_LDA(At, 0, 1); PG8_STAGE(PG8_SA(0, 0), a2, voffA);
            PG8_BAR; PG8_WAIT_L(0); PG8_MMA(1, 0, At, B0); PG8_BAR; PG8_SCHED;
            PG8_STAGE(PG8_SB(0, 1), b2 + hstep, voffB);
            PG8_WAIT_V(6); PG8_BAR; PG8_MMA(1, 1, At, B1); PG8_BAR;
            PG8_LDB(B0, 1, 0); PG8_SCHED; PG8_LDA(At, 1, 0); PG8_STAGE_A1(PG8_SA(0, 1), a2 + hstep);
            PG8_WAIT_L(8); PG8_BAR; PG8_WAIT_L(0); PG8_MMA(0, 0, At, B0); PG8_BAR; PG8_SCHED;
            PG8_LDB(B1, 1, 1); PG8_STAGE(PG8_SB(1, 0), b3, voffB);
            PG8_BAR; PG8_WAIT_L(0); PG8_MMA(0, 1, At, B1); PG8_BAR;
            PG8_LDA(At, 1, 1); PG8_STAGE(PG8_SA(1, 0), a3, voffA);
            PG8_BAR; PG8_WAIT_L(0); PG8_MMA(1, 0, At, B0); PG8_BAR; PG8_SCHED;
            PG8_STAGE(PG8_SB(1, 1), b3 + hstep, voffB);
            PG8_WAIT_V(6); PG8_BAR; PG8_MMA(1, 1, At, B1); PG8_BAR;
            }
        }
        if constexpr (ALIGN_EPI) { if (wr == 0) PG8_BAR; }
        if constexpr (!Epi::AFTER_DRAIN) { E(acc, cur, wr, wc, fr, fq); S.done(cur); }
        if (!has_next) break;
#pragma unroll
        for (int a = 0; a < 2; ++a)
#pragma unroll
            for (int b = 0; b < 2; ++b)
#pragma unroll
                for (int m = 0; m < 4; ++m)
#pragma unroll
                    for (int n = 0; n < 2; ++n) acc[a][b][m][n] = (f32x4){0.f, 0.f, 0.f, 0.f};
        cur = nxt; cA = nA; cB = nB; ++ui;
        if constexpr (ALIGN_EPI) { if (wr == 1) PG8_BAR; }
    }
    PG8_WAIT_V(0);
    if constexpr (!ALIGN_EPI) { if (wr == 0) PG8_BAR; }
    PG8_BAR;
    if constexpr (Epi::AFTER_DRAIN) { E.fused(acc, cur, wr, wc, fr, fq, lds, wid, lane); S.done(cur); }
#undef PG8_SA
#undef PG8_SB
#undef PG8_STAGE
#undef PG8_STAGE_A1
#undef PG8_LDA
#undef PG8_LDB
#undef PG8_MMA
#undef PG8_WAIT_V
#undef PG8_WAIT_L
#undef PG8_BAR
#undef PG8_SCHED
}
}
constexpr int M_TOK = 10240, M_CTX = 8192, DM = 1024, FF = 2816, NWI = 5632, NIN = 2048;
constexpr int LCTX = 256, LLAT = 1024, LKLAT = 1280, NSEQ = 34;
constexpr float EPS = 1e-6f;

namespace pg8 {
__device__ __forceinline__ float silu_f(float x) { return x * __builtin_amdgcn_rcpf(1.0f + __builtin_amdgcn_exp2f(-1.4426950408889634f * x)); }
struct EpiSwiglu {
    static constexpr bool PERM = true, AFTER_DRAIN = false;
    bf16_t* O; int ldc;
    __device__ __forceinline__ void operator()(const f32x4 (&acc)[2][2][4][2], const Unit& u, int wr, int wc, int fr, int fq) const {
        const int row0 = u.pm * BM + wr * 64 + fr, col0 = u.pn * HALF + wc * 32 + 8 * fq;
#pragma unroll
        for (int ai = 0; ai < 2; ++ai)
#pragma unroll
            for (int m = 0; m < 4; ++m) { bf16_t* rowp = O + (size_t)(row0 + ai * HALF + m * 16) * ldc + col0;
                const f32x4 a0 = acc[ai][0][m][0], a1 = acc[ai][0][m][1], b0 = acc[ai][1][m][0], b1 = acc[ai][1][m][1];
                u32x4 w;
                w.x = cvt_pk_bf16(silu_f(a0[0]) * b0[0], silu_f(a0[1]) * b0[1]); w.y = cvt_pk_bf16(silu_f(a0[2]) * b0[2], silu_f(a0[3]) * b0[3]);
                w.z = cvt_pk_bf16(silu_f(a1[0]) * b1[0], silu_f(a1[1]) * b1[1]); w.w = cvt_pk_bf16(silu_f(a1[2]) * b1[2], silu_f(a1[3]) * b1[3]);
                *(u32x4*)rowp = w; }
    }
};
template <int M1> struct EpiResGate {
    static constexpr bool PERM = false, AFTER_DRAIN = false;
    static constexpr int TM = HALF + 32 * M1;
    const float* base0; const float* base1;
    float* out; const float* mods;
    int idx; float gs;
    __device__ __forceinline__ void operator()(const f32x4 (&acc)[2][2][4][2], const Unit& u, int wr, int wc, int fr, int fq) const {
        const int col0 = u.pn * BM + wc * 32 + 4 * fq;
#pragma unroll
        for (int ai = 0; ai < 2; ++ai)
#pragma unroll
            for (int m = 0; m < (ai ? M1 : 4); ++m) {
                const int rb = u.pm * TM + (ai ? HALF + wr * 16 * M1 : wr * 64) + m * 16;
                const int set = rb < M_CTX ? 0 : 1 + ((rb - M_CTX) >> 10);
                const float* mv = mods + (size_t)(set * 9 + idx) * DM + col0;
                const float* bp = (rb < M_CTX ? base0 + (size_t)rb * DM : base1 + (size_t)(rb - M_CTX) * DM) + (size_t)fr * DM + col0;
                float* op = out + (size_t)(rb + fr) * DM + col0;
#pragma unroll
                for (int bj = 0; bj < 2; ++bj)
#pragma unroll
                    for (int n = 0; n < 2; ++n) { const f32x4 gv = *(const f32x4*)(mv + bj * HALF + n * 16) * gs; const f32x4 b = *(const f32x4*)(bp + bj * HALF + n * 16);
                        *(f32x4*)(op + bj * HALF + n * 16) = b + gv * acc[ai][bj][m][n]; } }
    }
};
template <int M1> struct EpiU {
    static constexpr bool PERM = true, AFTER_DRAIN = false;
    static constexpr int TM = HALF + 32 * M1;
    bf16_t* U; float* outV; int layer;
    __device__ __forceinline__ void operator()(const f32x4 (&acc)[2][2][4][2], const Unit& u, int wr, int wc, int fr, int fq) const {
        const int col0 = u.pn * BM + wc * 32 + 8 * fq;
#pragma unroll
        for (int ai = 0; ai < 2; ++ai)
#pragma unroll
            for (int m = 0; m < (ai ? M1 : 4); ++m) { const int rb = u.pm * TM + (ai ? HALF + wr * 16 * M1 : wr * 64) + m * 16, row = rb + fr; bf16_t* rowp = U + (size_t)row * NIN + col0;
                const bool vout = (u.pn >= 6) && (rb < M_CTX);
#pragma unroll
                for (int bj = 0; bj < 2; ++bj) { const f32x4 v0 = acc[ai][bj][m][0], v1 = acc[ai][bj][m][1];
                    u32x4 w; w.x = cvt_pk_bf16(v0[0], v0[1]); w.y = cvt_pk_bf16(v0[2], v0[3]); w.z = cvt_pk_bf16(v1[0], v1[1]); w.w = cvt_pk_bf16(v1[2], v1[3]);
                    *(u32x4*)(rowp + bj * HALF) = w;
                    if (vout) { float* vp = outV + ((size_t)((row >> 8) * 2 + layer) * 256 + (row & 255)) * 512 + (col0 + bj * HALF - 1536);
                        *(f32x4*)vp = v0; *(f32x4*)(vp + 4) = v1; } } }
    }
};
}
constexpr size_t MiB = 1u << 20;
constexpr size_t WS_CTL = 0, CTL_ZERO_BYTES = 512 * 1024;
constexpr size_t SZ_WI = (size_t)NWI * DM * 2, SZ_WO = (size_t)DM * FF * 2, SZ_WIN = (size_t)NIN * DM * 2, SZ_WOUT = (size_t)DM * DM * 2;
constexpr size_t WS_W = 2 * MiB;
constexpr size_t OFF_WI1 = 0, OFF_WO1 = OFF_WI1 + SZ_WI, OFF_WI2 = OFF_WO1 + SZ_WO, OFF_WO2 = OFF_WI2 + SZ_WI, OFF_WIN = OFF_WO2 + SZ_WO, OFF_WOUT = OFF_WIN + SZ_WIN, SZ_WLAYER = OFF_WOUT + SZ_WOUT;
constexpr size_t WS_TW1024 = 84 * MiB;
constexpr size_t WS_TW256 = 88 * MiB;
constexpr size_t WS_WCS = WS_TW256 + 512 * 1024;
constexpr size_t WS_ROPE = WS_WCS + 256 * 1024;
constexpr size_t WS_SCAL = WS_ROPE + 16 * 1024;
constexpr size_t WS_XN = 90 * MiB;
constexpr size_t WS_MIX = 110 * MiB;
constexpr size_t WS_GB = 130 * MiB;
constexpr size_t WS_U = 130 * MiB;
constexpr size_t WS_QB = 170 * MiB;
constexpr size_t WS_KB = 185 * MiB;
constexpr size_t WS_VTC = 196 * MiB;
constexpr size_t WS_VTL = 204 * MiB;
constexpr size_t WS_YTC = 207 * MiB;
constexpr size_t WS_YTL = 215 * MiB;
constexpr size_t WS_QN = 217 * MiB;
constexpr size_t WS_END = 218 * MiB;
static_assert(WS_W + 2 * SZ_WLAYER <= WS_TW1024 && WS_SCAL + 64 <= WS_XN && WS_GB + (size_t)M_TOK * FF * 2 <= WS_KB && WS_QB + (size_t)M_TOK * 512 * 2 <= WS_KB, "ws map");
constexpr int CW_TMO = 0, CW_BAR = 4096, CW_KMAX = 8192  , CW_MODS = 16384  ;
static_assert((CW_MODS + 2 * 3 * 9 * 1024) * 4 <= (int)CTL_ZERO_BYTES, "ctl");
constexpr int RING_BYTES = 131072, LDSCTL_OFF = RING_BYTES, MISC_OFF = LDSCTL_OFF + 320, LDS_BYTES = 147456;
constexpr int NWAVES = 8;
constexpr int NPHASES = 23;
#define GAS __attribute__((address_space(1)))
#define LAS __attribute__((address_space(3)))
typedef unsigned short bf16;
typedef unsigned v4u __attribute__((ext_vector_type(4)));
typedef float f32x4 __attribute__((ext_vector_type(4)));
typedef short bf16x8 __attribute__((ext_vector_type(8)));
typedef GAS unsigned gu32;
typedef GAS unsigned long long gu64;
#define RLX_AGENT __ATOMIC_RELAXED, __HIP_MEMORY_SCOPE_AGENT
#define LDS_WAIT() asm volatile("s_waitcnt lgkmcnt(0)" ::: "memory")
#define VM_WAIT() asm volatile("s_waitcnt vmcnt(0)" ::: "memory")
__device__ __forceinline__ unsigned long long rt() { return __builtin_amdgcn_s_memrealtime(); }
__device__ __forceinline__ unsigned f2bf(float f) { unsigned u = __builtin_bit_cast(unsigned, f); return (u + 0x7fffu + ((u >> 16) & 1u)) >> 16; }
typedef float f32x2_t __attribute__((ext_vector_type(2))); typedef __bf16 bf16x2_t __attribute__((ext_vector_type(2)));
__device__ __forceinline__ unsigned pk2(float lo, float hi) { f32x2_t v = {lo, hi}; bf16x2_t b = __builtin_convertvector(v, bf16x2_t); return __builtin_bit_cast(unsigned, b); }
#define XB_TMO      128
#define XB_XCNT(j)  (256  + 64 * (j))
#define XB_XSUB(j)  (1280 + 64 * (j))
#define XB_XGEN(j)  (2304 + 64 * (j))
#define XB_TOP      3328
#define XB_TOPGEN   3392
#define XCD_BAR_WORDS 3456
#define XB_SPIN_CAP (1u << 18)

__device__ __forceinline__ unsigned xb_ld(unsigned* p)              { return __hip_atomic_load(p, __ATOMIC_RELAXED, __HIP_MEMORY_SCOPE_AGENT); }
__device__ __forceinline__ unsigned xb_add(unsigned* p, unsigned v) { return __hip_atomic_fetch_add(p, v, __ATOMIC_RELAXED, __HIP_MEMORY_SCOPE_AGENT); }
__device__ __forceinline__ unsigned xb_xcc_id() { return (unsigned)__builtin_amdgcn_s_getreg((3 << 11) | 20) & 0xFu; }
#define XB_SPIN(cond, bar) do { unsigned _sp = 0; while (cond) { __builtin_amdgcn_s_sleep(1); \
    if ((++_sp & 255u) == 0u) { if (xb_ld(&(bar)[XB_TMO])) break; if (_sp > XB_SPIN_CAP) { atomicAdd(&(bar)[XB_TMO], 1u); break; } } } } while (0)

struct XcdBarrier {
    unsigned* bar; unsigned x;
    volatile LAS unsigned* st;
};

__device__ __forceinline__ XcdBarrier xcd_barrier_post(unsigned* bar, volatile LAS unsigned* st) {
    XcdBarrier b; b.bar = bar; b.x = xb_xcc_id(); b.st = st;
    if (threadIdx.x == 0) (void)xb_add(&bar[XB_XCNT(b.x)], 1u);
    return b;
}
__device__ __forceinline__ void xcd_barrier_complete(unsigned* bar, unsigned x, unsigned& nloc, unsigned& nx) {
    const unsigned G = gridDim.x * gridDim.y * gridDim.z;
    unsigned sum, cnt, mine, sp = 0u;
    for (;;) {
        sum = 0u; cnt = 0u; mine = 0u;
#pragma unroll
        for (unsigned j = 0; j < 16; ++j) { const unsigned c = xb_ld(&bar[XB_XCNT(j)]); sum += c; cnt += (c > 0u) ? 1u : 0u; mine = (j == x) ? c : mine; }
        if (sum == G) break;
        __builtin_amdgcn_s_sleep(1);
        if ((++sp & 255u) == 0u) { if (xb_ld(&bar[XB_TMO])) break; if (sp > XB_SPIN_CAP) { atomicAdd(&bar[XB_TMO], 1u); break; } }
    }
    nloc = mine > 0u ? mine : 1u; nx = cnt > 0u ? cnt : 1u;
}

__device__ __forceinline__ void xcd_barrier(const XcdBarrier& b) {
    asm volatile("s_waitcnt vmcnt(0)" ::: "memory");
    __syncthreads();
    if (threadIdx.x == 0) {
        unsigned* bar = b.bar;
        __builtin_amdgcn_s_waitcnt(0);
        unsigned nloc = b.st[0], nx = b.st[1];
        if (nloc == 0u) { xcd_barrier_complete(bar, b.x, nloc, nx); b.st[0] = nloc; b.st[1] = nx; }
        const unsigned old = xb_add(&bar[XB_XSUB(b.x)], 1u);
        const unsigned gen = old / nloc;
        if (old + 1u == (gen + 1u) * nloc) {
            __builtin_amdgcn_fence(__ATOMIC_RELEASE, "agent");
            asm volatile("s_waitcnt vmcnt(0)" ::: "memory");
            const unsigned og = xb_add(&bar[XB_TOP], 1u);
            const unsigned tg = og / nx;
            if (og + 1u == (tg + 1u) * nx) xb_add(&bar[XB_TOPGEN], 1u);
            else XB_SPIN(xb_ld(&bar[XB_TOPGEN]) == tg, bar);
            __builtin_amdgcn_fence(__ATOMIC_ACQUIRE, "agent");
            xb_add(&bar[XB_XGEN(b.x)], 1u);
            asm volatile("s_waitcnt vmcnt(0)" ::: "memory");
        } else {
            XB_SPIN(xb_ld(&bar[XB_XGEN(b.x)]) == gen, bar);
            __builtin_amdgcn_fence(__ATOMIC_ACQUIRE, "agent");
            asm volatile("s_waitcnt vmcnt(0)" ::: "memory");
        }
    }
    __syncthreads();
}
typedef float f32x16 __attribute__((ext_vector_type(16)));
typedef unsigned u32x2 __attribute__((ext_vector_type(2)));
__device__ __forceinline__ float bf2f(unsigned h) { return __builtin_bit_cast(float, h << 16); }
__device__ __forceinline__ float wave_sum(float v) {
#pragma unroll
    for (int o = 1; o < 64; o <<= 1) v += __shfl_xor(v, o);
    return v;
}
__device__ __forceinline__ int crow(int r, int hi) { return (r & 3) + 8 * (r >> 2) + 4 * hi; }
__device__ __forceinline__ float silu_acc(float x) { return x / (1.0f + expf(-x)); }

struct KArgs { const float* in[25]; float* out; unsigned char* ws; int ph_lo, ph_hi; };
enum { I_XP = 0, I_XS, I_CK, I_CV, I_C, I_CCTX, I_NG, I_ADAW, I_ADAB, I_F1WI, I_F1WO, I_F2WI, I_F2WO, I_WIN, I_WOUT, I_QG, I_KG, I_LQ1, I_LK1, I_LQ2, I_LK2, I_AOG, I_POOLW, I_POOLS, I_FNETW };
constexpr size_t OUT_YS = (size_t)M_CTX * DM, OUT_K = (size_t)M_TOK * DM, OUT_V = OUT_K + (size_t)32 * 2 * 256 * 512;

__device__ __forceinline__ void p0_transpose_item(const float* W, int K, int N, bf16* WT, bool swi, LAS float* scr, int item, int lane) {
    const int nblk = N / 32, kb = item / nblk, nb = item % nblk, k0 = 64 * kb, n0 = 32 * nb;
    int r0 = n0;
    if (swi) { const int half = n0 / FF, jj = n0 % FF; r0 = (jj / 128) * 256 + half * 128 + (jj % 128); }
#pragma unroll 8
    for (int i = 0; i < 32; ++i) { const int kk = 2 * i + (lane >> 5); scr[kk * 33 + (lane & 31)] = W[(size_t)(k0 + kk) * N + n0 + (lane & 31)]; }
    LDS_WAIT(); asm volatile("" ::: "memory");
    const int c = lane & 7;
#pragma unroll
    for (int j = 0; j < 4; ++j) { const int n = (lane >> 3) + 8 * j; const LAS float* s = scr + (8 * c) * 33 + n;
        v4u o; o.x = pk2(s[0 * 33], s[1 * 33]); o.y = pk2(s[2 * 33], s[3 * 33]); o.z = pk2(s[4 * 33], s[5 * 33]); o.w = pk2(s[6 * 33], s[7 * 33]);
        *(GAS v4u*)(WT + (size_t)(r0 + n) * K + k0 + 8 * c) = o; }
    LDS_WAIT(); asm volatile("" ::: "memory");
}
__device__ __forceinline__ void p0_fold_item(const float* Win, const float* PW, bf16* WT, LAS float* scr, int kb, int nb, int lane) {
    const int k0 = 64 * kb, n0 = 32 * nb, g = n0 >> 6, kh = lane >> 5, n = lane & 31;
    for (int kk = 0; kk < 64; ++kk) scr[kk * 64 + lane] = Win[(size_t)(k0 + kk) * NIN + g * 64 + lane];
    LDS_WAIT(); asm volatile("" ::: "memory");
    float acc[32];
#pragma unroll
    for (int i = 0; i < 32; ++i) acc[i] = 0.f;
    const float* pw = PW + (size_t)g * 4096 + (n0 & 63) + n;
#pragma unroll 1
    for (int c4 = 0; c4 < 16; ++c4) {
        const float p0 = pw[(4 * c4) * 64], p1 = pw[(4 * c4 + 1) * 64], p2 = pw[(4 * c4 + 2) * 64], p3 = pw[(4 * c4 + 3) * 64];
#pragma unroll
        for (int i = 0; i < 32; ++i) { const f32x4 a = *(const LAS f32x4*)(scr + (32 * kh + i) * 64 + 4 * c4); acc[i] += (a.x * p0 + a.y * p1) + (a.z * p2 + a.w * p3); }
    }
    bf16* op = WT + (size_t)(n0 + n) * DM + k0 + 32 * kh;
#pragma unroll
    for (int q = 0; q < 4; ++q) *(GAS v4u*)(op + 8 * q) = (v4u){pk2(acc[8 * q], acc[8 * q + 1]), pk2(acc[8 * q + 2], acc[8 * q + 3]), pk2(acc[8 * q + 4], acc[8 * q + 5]), pk2(acc[8 * q + 6], acc[8 * q + 7])};
    LDS_WAIT(); asm volatile("" ::: "memory");
}
__device__ __forceinline__ void p0_mods_item(const KArgs& A, float* mods, int item, int lane) {
    const int l = item / 576, r = item % 576, kc = r / 36, cb = r % 36;
    const float* W = A.in[I_ADAW] + (size_t)l * DM * 9216 + (size_t)(kc * 64) * 9216 + cb * 256 + lane * 4;
    const int k = kc * 64 + lane;
    const float s0 = silu_acc(A.in[I_CCTX][k]), s1 = silu_acc(A.in[I_C][k]), s2 = silu_acc(A.in[I_C][DM + k]);
    f32x4 a0 = {0.f, 0.f, 0.f, 0.f}, a1 = a0, a2 = a0;
#pragma unroll 8
    for (int kk = 0; kk < 64; ++kk) {
        const f32x4 w = *(const f32x4*)(W + (size_t)kk * 9216);
        const float c0 = __builtin_bit_cast(float, __builtin_amdgcn_readlane(__builtin_bit_cast(int, s0), kk));
        const float c1 = __builtin_bit_cast(float, __builtin_amdgcn_readlane(__builtin_bit_cast(int, s1), kk));
        const float c2 = __builtin_bit_cast(float, __builtin_amdgcn_readlane(__builtin_bit_cast(int, s2), kk));
        a0 += w * c0; a1 += w * c1; a2 += w * c2;
    }
    if (kc == 0) { const f32x4 b = *(const f32x4*)(A.in[I_ADAB] + (size_t)l * 9216 + cb * 256 + lane * 4); a0 += b; a1 += b; a2 += b; }
    float* mp = mods + (size_t)l * 3 * 9216 + cb * 256 + lane * 4;
#pragma unroll
    for (int i = 0; i < 4; ++i) { atomicAdd(mp + i, a0[i]); atomicAdd(mp + 9216 + i, a1[i]); atomicAdd(mp + 2 * 9216 + i, a2[i]); }
}
__device__ __forceinline__ void p0_tw_item(bf16* TW, int L, int item, int lane) {
    const int nks = L / 16, ks = item % nks, kh = (item / nks) & 1, rt = item / (2 * nks), k = 32 * rt + (lane & 31), h = lane >> 5;
    unsigned w[4];
#pragma unroll
    for (int i = 0; i < 4; ++i) { float v[2];
#pragma unroll
        for (int e = 0; e < 2; ++e) { const int j = 2 * i + e, kk = 16 * ks + 8 * (j >> 2) + 4 * h + (j & 3); const int ang = (k * kk) & (L - 1);
            float sn, cs; sincospif(2.0f * (float)ang / (float)L, &sn, &cs); v[e] = kh ? sn : cs; }
        w[i] = pk2(v[0], v[1]); }
    *(GAS v4u*)(TW + (size_t)item * 512 + lane * 8) = (v4u){w[0], w[1], w[2], w[3]};
}
__device__ __forceinline__ void p0_wcs_item(const KArgs& A, bf16* WCS, int item, int lane) {
    const int lg = item >> 7, n = item & 127, d = n & 63; const bool sn = n >= 64;
    const float* Wf = A.in[I_FNETW] + (size_t)lg * 4096 + d;
    float acc = 0.f;
    for (int m = 0; m < 64; ++m) { float s, c; sincospif(2.0f * (float)((m * lane) & 63) / 64.0f, &s, &c); acc += (sn ? -s : c) * Wf[m * 64]; }
    WCS[(size_t)item * 64 + lane] = (bf16)f2bf(acc);
}
__device__ __forceinline__ void p0_misc_item(const KArgs& A, float* rope, float* scal, int lane) {
    for (int e = lane; e < 1024; e += 64) { const int pos = e >> 4, i = e & 15; const float inv = 1.0f / powf(10000.0f, (float)(2 * i) / 32.0f); const float ang = (float)pos * inv;
        rope[e] = cosf(ang); rope[1024 + e] = sinf(ang); }
#pragma unroll
    for (int l = 0; l < 2; ++l) {
        const float d1 = wave_sum(A.in[I_LQ1][l * 64 + lane] * A.in[I_LK1][l * 64 + lane]), d2 = wave_sum(A.in[I_LQ2][l * 64 + lane] * A.in[I_LK2][l * 64 + lane]);
        const float lam_init = 0.8f - 0.6f * expf(-0.3f * (float)l);
        if (lane == 0) scal[l] = expf(d1) - expf(d2) + lam_init;
    }
}
constexpr int IT_MODS = 2 * 16 * 36, IT_TWI = (DM / 64) * (NWI / 32), IT_TWO = (FF / 64) * (DM / 32), IT_TWIN = (DM / 64) * (NIN / 32), IT_TWOUT = (DM / 64) * (DM / 32);
constexpr int IT_TRL = 2 * IT_TWI + 2 * IT_TWO + IT_TWIN + IT_TWOUT;
constexpr int IT_TW1024 = 32 * 2 * 64, IT_TW256 = 8 * 2 * 16, IT_WCS = 2 * 4 * 128;
constexpr int P0_ITEMS = IT_MODS + 2 * IT_TRL + IT_TW1024 + IT_TW256 + IT_WCS + 1;
__device__ __forceinline__ void p0_prologue(const KArgs& A, LAS unsigned char* lds, int gw, int NGW, int wave, int lane, bool skip_mods = false) {
    LAS float* scr = (LAS float*)(lds + wave * 16384);
    unsigned char* ws = A.ws;
    float* mods = (float*)(ws + WS_CTL) + CW_MODS;
    for (int it = gw; it < P0_ITEMS; it += NGW) {
        int r = it;
        if (r < IT_MODS) { if (!skip_mods) p0_mods_item(A, mods, r, lane); continue; } r -= IT_MODS;
        if (r < 2 * IT_TRL) { const int l = r / IT_TRL; r %= IT_TRL; unsigned char* wl = ws + WS_W + (size_t)l * SZ_WLAYER;
            if (r < IT_TWI) { p0_transpose_item(A.in[I_F1WI] + (size_t)l * DM * NWI, DM, NWI, (bf16*)(wl + OFF_WI1), true, scr, r, lane); continue; } r -= IT_TWI;
            if (r < IT_TWO) { p0_transpose_item(A.in[I_F1WO] + (size_t)l * FF * DM, FF, DM, (bf16*)(wl + OFF_WO1), false, scr, r, lane); continue; } r -= IT_TWO;
            if (r < IT_TWI) { p0_transpose_item(A.in[I_F2WI] + (size_t)l * DM * NWI, DM, NWI, (bf16*)(wl + OFF_WI2), true, scr, r, lane); continue; } r -= IT_TWI;
            if (r < IT_TWO) { p0_transpose_item(A.in[I_F2WO] + (size_t)l * FF * DM, FF, DM, (bf16*)(wl + OFF_WO2), false, scr, r, lane); continue; } r -= IT_TWO;
            if (r < IT_TWIN) { const int nblk = NIN / 32, kb = r / nblk, nb = r % nblk;
                if (nb < 8) p0_fold_item(A.in[I_WIN] + (size_t)l * DM * NIN, A.in[I_POOLW] + (size_t)l * 4 * 4096, (bf16*)(wl + OFF_WIN), scr, kb, nb, lane);
                else p0_transpose_item(A.in[I_WIN] + (size_t)l * DM * NIN, DM, NIN, (bf16*)(wl + OFF_WIN), false, scr, r, lane);
                continue; } r -= IT_TWIN;
            p0_transpose_item(A.in[I_WOUT] + (size_t)l * DM * DM, DM, DM, (bf16*)(wl + OFF_WOUT), false, scr, r, lane); continue; }
        r -= 2 * IT_TRL;
        if (r < IT_TW1024) { p0_tw_item((bf16*)(ws + WS_TW1024), 1024, r, lane); continue; } r -= IT_TW1024;
        if (r < IT_TW256) { p0_tw_item((bf16*)(ws + WS_TW256), 256, r, lane); continue; } r -= IT_TW256;
        if (r < IT_WCS) { p0_wcs_item(A, (bf16*)(ws + WS_WCS), r, lane); continue; }
        p0_misc_item(A, (float*)(ws + WS_ROPE), (float*)(ws + WS_SCAL), lane);
    }
}
__device__ __forceinline__ void norm_phase(const float* x0, const float* x1, bf16* XN, const float* g, const float* mods_l, int sub, int gw, int NGW, int lane) {
    for (int m = gw; m < M_TOK; m += NGW) {
        const float* xrow = m < M_CTX ? x0 + (size_t)m * DM : x1 + (size_t)(m - M_CTX) * DM;
        const int set = m < M_CTX ? 0 : 1 + ((m - M_CTX) >> 10);
        const float* shift = mods_l + (size_t)(set * 9 + 3 * sub) * DM; const float* scale = shift + DM;
        const GAS f32x4* xr = (const GAS f32x4*)xrow + lane;
        f32x4 v[4]; float ss = 0.f;
#pragma unroll
        for (int j = 0; j < 4; ++j) { v[j] = xr[64 * j]; ss += (v[j].x * v[j].x + v[j].y * v[j].y) + (v[j].z * v[j].z + v[j].w * v[j].w); }
        const float rstd = 1.0f / sqrtf(wave_sum(ss) * (1.0f / DM) + EPS);
        GAS unsigned long long* o8 = (GAS unsigned long long*)(XN + (size_t)m * DM) + lane;
#pragma unroll
        for (int j = 0; j < 4; ++j) { const f32x4 gg = *((const f32x4*)g + 64 * j + lane), sc = *((const f32x4*)scale + 64 * j + lane), sh = *((const f32x4*)shift + 64 * j + lane);
            const f32x4 h = (v[j] * rstd) * gg * (sc + 1.0f) + sh;
            o8[64 * j] = (unsigned long long)pk2(h.x, h.y) | ((unsigned long long)pk2(h.z, h.w) << 32); }
    }
}
__device__ __forceinline__ void prep_token_item(const KArgs& A, int l, int row, int lane, const bf16* U, bf16* QB, bf16* KB, float* QN, unsigned* kmax, const float* rope) {
    const int j = lane & 7, grp = lane >> 3;
    const bool lat = row >= M_CTX;
    const int t = lat ? (row - M_CTX) & 1023 : row & 255;
    const int seq = lat ? 32 + ((row - M_CTX) >> 10) : row >> 8;
    const float* gq = A.in[I_QG] + l * 64 + 8 * j; const float* gk = A.in[I_KG] + l * 64 + 8 * j;
    const v4u uq = *(const GAS v4u*)(U + (size_t)row * NIN + 512 + lane * 8), uk = *(const GAS v4u*)(U + (size_t)row * NIN + 1024 + lane * 8);
    float q[8], k[8];
    { const unsigned wq[4] = {uq.x, uq.y, uq.z, uq.w}, wk[4] = {uk.x, uk.y, uk.z, uk.w};
#pragma unroll
      for (int i = 0; i < 4; ++i) { q[2 * i] = bf2f(wq[i] & 0xffffu); q[2 * i + 1] = bf2f(wq[i] >> 16); k[2 * i] = bf2f(wk[i] & 0xffffu); k[2 * i + 1] = bf2f(wk[i] >> 16); } }
    float sq = 0.f, sk = 0.f;
#pragma unroll
    for (int i = 0; i < 8; ++i) { sq += q[i] * q[i]; sk += k[i] * k[i]; }
#pragma unroll
    for (int o = 1; o < 8; o <<= 1) { sq += __shfl_xor(sq, o); sk += __shfl_xor(sk, o); }
    const float rq = 1.0f / sqrtf(sq * (1.0f / 64.0f) + EPS), rk = 1.0f / sqrtf(sk * (1.0f / 64.0f) + EPS);
#pragma unroll
    for (int i = 0; i < 8; ++i) { q[i] = q[i] * rq * gq[i]; k[i] = k[i] * rk * gk[i]; }
    if (lat) {
        const int pos = (j < 4) ? (t >> 6) : (t & 63);
        const float* cs = rope + pos * 16 + (j & 1) * 8; const float* sn = cs + 1024;
        const float sgn = (j & 2) ? 1.0f : -1.0f;
#pragma unroll
        for (int i = 0; i < 8; ++i) { const float pq = __shfl_xor(q[i], 2), pk = __shfl_xor(k[i], 2); const float c = cs[i], s = sn[i] * sgn;
            q[i] = q[i] * c + pq * s; k[i] = k[i] * c + pk * s; }
    }
    const float QS = 0.125f * 1.4426950408889634f;
    float nq = 0.f, nk = 0.f;
#pragma unroll
    for (int i = 0; i < 8; ++i) { q[i] *= QS; nq += q[i] * q[i]; nk += k[i] * k[i]; }
#pragma unroll
    for (int o = 1; o < 8; o <<= 1) { nq += __shfl_xor(nq, o); nk += __shfl_xor(nk, o); }
    const int hc = grp, key = lat ? 256 + t : t, fo = ((j >> 1) * 64 + (j & 1) * 32) * 8;
    const size_t qchunk = lat ? 2048 + (size_t)((seq - 32) * 8 + hc) * 32 + (t >> 5) : (size_t)(seq * 8 + hc) * 8 + (t >> 5);
    const size_t kchunk = lat ? 2048 + (size_t)((seq - 32) * 8 + hc) * 40 + (key >> 5) : (size_t)(seq * 8 + hc) * 8 + (key >> 5);
    *(GAS v4u*)(QB + qchunk * 2048 + fo + (t & 31) * 8) = (v4u){pk2(q[0], q[1]), pk2(q[2], q[3]), pk2(q[4], q[5]), pk2(q[6], q[7])};
    *(GAS v4u*)(KB + kchunk * 2048 + fo + (key & 31) * 8) = (v4u){pk2(k[0], k[1]), pk2(k[2], k[3]), pk2(k[4], k[5]), pk2(k[6], k[7])};
    if (j == 0) { QN[(size_t)row * 8 + grp] = sqrtf(nq) * 1.01f; atomicMax(kmax + seq * 8 + grp, __builtin_bit_cast(unsigned, sqrtf(nk) * 1.01f)); }
    if (!lat) { float* ko = A.out + OUT_K + ((size_t)((row >> 8) * 2 + l) * 256 + t) * 512 + lane * 8;
        *(f32x4*)ko = (f32x4){k[0], k[1], k[2], k[3]}; *(f32x4*)(ko + 4) = (f32x4){k[4], k[5], k[6], k[7]}; }
}
__device__ __forceinline__ void prep_cachek_item(const KArgs& A, int l, int item, int lane, bf16* KB, unsigned* kmax) {
    const int b = item >> 8, jrow = item & 255, grp = lane >> 3;
    const float* src = A.in[I_CK] + ((size_t)(b * 2 + l) * 256 + jrow) * 512 + lane * 8;
    const f32x4 a = *(const f32x4*)src, c = *(const f32x4*)(src + 4);
    float nk = (a.x * a.x + a.y * a.y) + (a.z * a.z + a.w * a.w) + (c.x * c.x + c.y * c.y) + (c.z * c.z + c.w * c.w);
#pragma unroll
    for (int o = 1; o < 8; o <<= 1) nk += __shfl_xor(nk, o);
    { const int j = lane & 7, fo = ((j >> 1) * 64 + (j & 1) * 32) * 8; const size_t kchunk = 2048 + (size_t)(b * 8 + grp) * 40 + (jrow >> 5);
      *(GAS v4u*)(KB + kchunk * 2048 + fo + (jrow & 31) * 8) = (v4u){pk2(a.x, a.y), pk2(a.z, a.w), pk2(c.x, c.y), pk2(c.z, c.w)}; }
    if ((lane & 7) == 0) atomicMax(kmax + (32 + b) * 8 + grp, __builtin_bit_cast(unsigned, sqrtf(nk) * 1.01f));
}
__device__ __forceinline__ void prep_vt_item(const KArgs& A, int l, int kind, int item, int lane, const bf16* U, bf16* VF, LAS unsigned char* scr) {
    LAS bf16* T = (LAS bf16*)scr;
    const int ch = item & (kind == 1 ? 31 : 7), sh = item >> (kind == 1 ? 5 : 3), h = sh & 3, s = sh >> 2;
    const size_t chunk = kind == 0 ? (size_t)(s * 4 + h) * 8 + ch : 1024 + (size_t)(s * 4 + h) * 40 + (kind == 1 ? 8 + ch : ch);
    if (kind < 2) { const int row0 = (kind == 0 ? s * 256 : M_CTX + s * 1024) + ch * 32;
#pragma unroll 8
        for (int i = 0; i < 32; ++i) { const unsigned w = *(const GAS unsigned*)(U + (size_t)(row0 + i) * NIN + 1536 + h * 128 + 2 * lane);
            T[(2 * lane) * 40 + i] = (bf16)(w & 0xffffu); T[(2 * lane + 1) * 40 + i] = (bf16)(w >> 16); }
    } else { const float* src = A.in[I_CV] + ((size_t)(s * 2 + l) * 256 + ch * 32) * 512 + h * 128 + 2 * lane;
#pragma unroll 8
        for (int i = 0; i < 32; ++i) { const float2 w = *(const float2*)(src + (size_t)i * 512);
            T[(2 * lane) * 40 + i] = (bf16)f2bf(w.x); T[(2 * lane + 1) * 40 + i] = (bf16)f2bf(w.y); } }
    LDS_WAIT(); asm volatile("" ::: "memory");
    const int r32 = lane & 31, hi = lane >> 5;
#pragma unroll
    for (int it = 0; it < 8; ++it) { const int s2 = it >> 2, d = it & 3;
        const LAS unsigned char* tp = scr + (d * 32 + r32) * 80 + (16 * s2 + 4 * hi) * 2;
        const u32x2 lo = *(const LAS u32x2*)tp, hh = *(const LAS u32x2*)(tp + 16);
        *(GAS v4u*)(VF + chunk * 4096 + (size_t)(it * 64 + lane) * 8) = (v4u){lo.x, lo.y, hh.x, hh.y}; }
    LDS_WAIT(); asm volatile("" ::: "memory");
}
__device__ __forceinline__ void prep_yt_item(int l, int item, int lane, const bf16* U, const bf16* WCS, bf16* YTC, bf16* YTL) {
    const int g = item & 3, rb = item >> 2, row0 = rb * 32, r32 = lane & 31, hi = lane >> 5;
    bf16* Y; int L, lp0;
    if (row0 < M_CTX) { L = 256; lp0 = row0 & 255; Y = YTC + (size_t)(((row0 >> 8) * 4 + g) * 128) * 256; }
    else { L = 1024; lp0 = (row0 - M_CTX) & 1023; Y = YTL + (size_t)((((row0 - M_CTX) >> 10) * 4 + g) * 128) * 1024; }
    const bf16* xp = U + (size_t)(row0 + r32) * NIN + 256 + g * 64 + hi * 8;
    const bf16* wp = WCS + (size_t)((l * 4 + g) * 128 + r32) * 64 + hi * 8;
    bf16x8 xa[4];
#pragma unroll
    for (int ks = 0; ks < 4; ++ks) xa[ks] = *(const GAS bf16x8*)(xp + ks * 16);
#pragma unroll
    for (int nb = 0; nb < 4; ++nb) { f32x16 acc = {};
#pragma unroll
        for (int ks = 0; ks < 4; ++ks) { const bf16x8 wb = *(const GAS bf16x8*)(wp + (size_t)nb * 32 * 64 + ks * 16); acc = __builtin_amdgcn_mfma_f32_32x32x16_bf16(xa[ks], wb, acc, 0, 0, 0); }
#pragma unroll
        for (int s2 = 0; s2 < 2; ++s2)
            *(GAS v4u*)(Y + ((size_t)nb * (L >> 4) + (lp0 >> 4) + s2) * 512 + lane * 8) =
                (v4u){pk2(acc[8 * s2], acc[8 * s2 + 1]), pk2(acc[8 * s2 + 2], acc[8 * s2 + 3]), pk2(acc[8 * s2 + 4], acc[8 * s2 + 5]), pk2(acc[8 * s2 + 6], acc[8 * s2 + 7])}; }
}
constexpr int PR_TOK = M_TOK, PR_CK = 512, PR_VT0 = 32 * 4 * 8, PR_VT1 = 2 * 4 * 32, PR_VT2 = 2 * 4 * 8, PR_YT = (M_TOK / 32) * 4;
constexpr int PR_ITEMS = PR_TOK + PR_CK + PR_VT0 + PR_VT1 + PR_VT2 + PR_YT;
__device__ __forceinline__ void prep_phase(const KArgs& A, int l, LAS unsigned char* lds, int gw, int NGW, int wave, int lane) {
    unsigned char* ws = A.ws;
    const bf16* U = (const bf16*)(ws + WS_U); bf16* QB = (bf16*)(ws + WS_QB); bf16* KB = (bf16*)(ws + WS_KB);
    float* QN = (float*)(ws + WS_QN); unsigned* kmax = (unsigned*)(ws + WS_CTL) + CW_KMAX + l * NSEQ * 8; const float* rope = (const float*)(ws + WS_ROPE);
    LAS unsigned char* scr = lds + wave * 16384;
    for (int it = gw; it < PR_ITEMS; it += NGW) {
        int r = it;
        if (r < PR_YT) { prep_yt_item(l, r, lane, U, (const bf16*)(ws + WS_WCS), (bf16*)(ws + WS_YTC), (bf16*)(ws + WS_YTL)); continue; } r -= PR_YT;
        if (r < PR_VT0) { prep_vt_item(A, l, 0, r, lane, U, (bf16*)(ws + WS_VTC), scr); continue; } r -= PR_VT0;
        if (r < PR_VT1) { prep_vt_item(A, l, 1, r, lane, U, (bf16*)(ws + WS_VTC), scr); continue; } r -= PR_VT1;
        if (r < PR_VT2) { prep_vt_item(A, l, 2, r, lane, U, (bf16*)(ws + WS_VTC), scr); continue; } r -= PR_VT2;
        if (r < PR_CK) { prep_cachek_item(A, l, r, lane, KB, kmax); continue; } r -= PR_CK;
        prep_token_item(A, l, r, lane, U, QB, KB, QN, kmax, rope);
    }
}
#define WG_BAR() do { asm volatile("s_waitcnt vmcnt(0) lgkmcnt(0)" ::: "memory"); __builtin_amdgcn_s_barrier(); asm volatile("" ::: "memory"); } while (0)
__device__ __forceinline__ void lds_fadd(LAS float* p, float v) { (void)__hip_atomic_fetch_add(p, v, __ATOMIC_RELAXED, __HIP_MEMORY_SCOPE_WORKGROUP); }
#define ATT_LOADK(dst, kp_) do { _Pragma("unroll") for (int ds_ = 0; ds_ < 4; ++ds_) dst[ds_] = *(const GAS bf16x8*)((kp_) + ds_ * 512); } while (0)
#define ATT_LOADV(dst, vp_) do { _Pragma("unroll") for (int i_ = 0; i_ < 8; ++i_) dst[i_] = *(const GAS bf16x8*)((vp_) + i_ * 512); } while (0)
#define ATT_QK(kf_) f32x16 S_; do { _Pragma("unroll") for (int r_ = 0; r_ < 16; ++r_) S_[r_] = nm; \
        _Pragma("unroll") for (int ds_ = 0; ds_ < 4; ++ds_) S_ = __builtin_amdgcn_mfma_f32_32x32x16_bf16(kf_[ds_], qf[ds_], S_, 0, 0, 0); } while (0)
#define ATT_PV(vf_) do { bf16x8 pa_[2]; \
        _Pragma("unroll") for (int s2_ = 0; s2_ < 2; ++s2_) { unsigned w_[4]; \
            _Pragma("unroll") for (int i_ = 0; i_ < 4; ++i_) { const float a_ = __builtin_amdgcn_exp2f(S_[8 * s2_ + 2 * i_]), b_ = __builtin_amdgcn_exp2f(S_[8 * s2_ + 2 * i_ + 1]); lsum += a_ + b_; w_[i_] = pk2(a_, b_); } \
            pa_[s2_] = __builtin_bit_cast(bf16x8, (v4u){w_[0], w_[1], w_[2], w_[3]}); } \
        _Pragma("unroll") for (int s2_ = 0; s2_ < 2; ++s2_) _Pragma("unroll") for (int d_ = 0; d_ < 4; ++d_) O[d_] = __builtin_amdgcn_mfma_f32_32x32x16_bf16(pa_[s2_], vf_[s2_ * 4 + d_], O[d_], 0, 0, 0); } while (0)
constexpr int LX_OFF = RING_BYTES + 1024;
__device__ __forceinline__ void attn_unit(const KArgs& A, int l, int seq, int h, int qb, LAS unsigned char* lds, int tid, int wave, int lane) {
    asm volatile("" : "+v"(tid), "+v"(lane));
    unsigned char* ws = A.ws; asm volatile("" : "+s"(ws));
    const bf16* QF = (const bf16*)(ws + WS_QB); const bf16* KF = (const bf16*)(ws + WS_KB); const bf16* VF = (const bf16*)(ws + WS_VTC); const float* QN = (const float*)(ws + WS_QN);
    const unsigned* kmax = (const unsigned*)(ws + WS_CTL) + CW_KMAX + l * NSEQ * 8;
    const bool lat = seq >= 32;
    const int qrow0 = lat ? M_CTX + (seq - 32) * 1024 + qb * 64 : seq * 256 + qb * 64;
    const int qs = wave & 1, ks = wave >> 1, r32 = lane & 31, hi = lane >> 5;
    const int nt = lat ? 10 : 2;
    const int qrow = qrow0 + qs * 32 + r32;
    LAS float* PO = (LAS float*)lds + wave * 4096;
    LAS float* PL = (LAS float*)(lds + LX_OFF);
    float acc[16];
#pragma unroll
    for (int i = 0; i < 16; ++i) acc[i] = 0.f;
    const float lam = ((const float*)(ws + WS_SCAL))[l];
#pragma unroll 1
    for (int c = 0; c < 2; ++c) {
        const size_t qchunk = lat ? 2048 + (size_t)((seq - 32) * 8 + h * 2 + c) * 32 + (qb * 2 + qs) : (size_t)(seq * 8 + h * 2 + c) * 8 + (qb * 2 + qs);
        const size_t kchunk = lat ? 2048 + (size_t)((seq - 32) * 8 + h * 2 + c) * 40 + ks * nt : (size_t)(seq * 8 + h * 2 + c) * 8 + ks * nt;
        const size_t vchunk = lat ? 1024 + (size_t)((seq - 32) * 4 + h) * 40 + ks * nt : (size_t)(seq * 4 + h) * 8 + ks * nt;
        const bf16* kp = KF + kchunk * 2048 + lane * 8; const bf16* vp = VF + vchunk * 4096 + lane * 8;
        bf16x8 qf[4], kf[4], vf[8];
        ATT_LOADK(qf, QF + qchunk * 2048 + lane * 8);
        ATT_LOADK(kf, kp); ATT_LOADV(vf, vp);
        const float nm = -QN[(size_t)qrow * 8 + h * 2 + c] * __builtin_bit_cast(float, kmax[seq * 8 + h * 2 + c]);
        f32x16 O[4];
#pragma unroll
        for (int d = 0; d < 4; ++d) O[d] = (f32x16){};
        float lsum = 0.f;
#pragma unroll 1
        for (int t = 0; t < nt; ++t) {
            ATT_QK(kf);
            __builtin_amdgcn_sched_barrier(0);
            if (t + 1 < nt) ATT_LOADK(kf, kp + (size_t)(t + 1) * 2048);
            ATT_PV(vf);
            __builtin_amdgcn_sched_barrier(0);
            if (t + 1 < nt) ATT_LOADV(vf, vp + (size_t)(t + 1) * 4096);
        }
        lsum += __shfl_xor(lsum, 32);
        if (hi == 0) PL[wave * 32 + r32] = lsum;
#pragma unroll
        for (int d = 0; d < 4; ++d)
#pragma unroll
            for (int r = 0; r < 16; ++r) { const int row = crow(r, hi); PO[row * 128 + ((d * 32 + r32) ^ ((row & 1) << 5))] = O[d][r]; }
        WG_BAR();
        {
            const int row = tid >> 3, a = tid & 7, q2 = row >> 5, r5 = row & 31;
            const float lt = (PL[(0 + q2) * 32 + r5] + PL[(2 + q2) * 32 + r5]) + (PL[(4 + q2) * 32 + r5] + PL[(6 + q2) * 32 + r5]);
            const float sc = c == 0 ? 1.0f / lt : -lam / lt;
#pragma unroll
            for (int i = 0; i < 4; ++i) { const int col = (32 * i + 4 * a) ^ ((r5 & 1) << 5);
                f32x4 v = *(const LAS f32x4*)((LAS float*)lds + (0 + q2) * 4096 + r5 * 128 + col);
                v += *(const LAS f32x4*)((LAS float*)lds + (2 + q2) * 4096 + r5 * 128 + col);
                v += *(const LAS f32x4*)((LAS float*)lds + (4 + q2) * 4096 + r5 * 128 + col);
                v += *(const LAS f32x4*)((LAS float*)lds + (6 + q2) * 4096 + r5 * 128 + col);
#pragma unroll
                for (int e = 0; e < 4; ++e) acc[4 * i + e] += v[e] * sc; }
        }
        WG_BAR();
    }
    {
        const int row = tid >> 3, a = tid & 7;
        const float lam_init = 0.8f - 0.6f * expf(-0.3f * (float)l);
        float ss = 0.f;
#pragma unroll
        for (int i = 0; i < 16; ++i) ss += acc[i] * acc[i];
#pragma unroll
        for (int of = 1; of < 8; of <<= 1) ss += __shfl_xor(ss, of);
        const float sc = (1.0f - lam_init) / sqrtf(ss * (1.0f / 128.0f) + EPS);
        const float* g = A.in[I_AOG] + l * 128 + 4 * a;
        bf16* mp = (bf16*)(ws + WS_MIX) + (size_t)(qrow0 + row) * DM + 512 + h * 128 + 4 * a;
#pragma unroll
        for (int i = 0; i < 4; ++i) { const f32x4 gv = *(const f32x4*)(g + 32 * i);
            *(GAS u32x2*)(mp + 32 * i) = (u32x2){pk2(acc[4 * i] * sc * gv[0], acc[4 * i + 1] * sc * gv[1]), pk2(acc[4 * i + 2] * sc * gv[2], acc[4 * i + 3] * sc * gv[3])}; }
    }
}
__device__ __forceinline__ void fourier_unit(const KArgs& A, int seq, int g, int rb, LAS unsigned char* lds, int tid, int wave, int lane) {
    asm volatile("" : "+v"(tid), "+v"(lane));
    unsigned char* ws = A.ws; asm volatile("" : "+s"(ws));
    const bool lat = seq >= 32; const int L = lat ? 1024 : 256, nks = L >> 4;
    const bf16* TW = lat ? (const bf16*)(ws + WS_TW1024) : (const bf16*)(ws + WS_TW256);
    const bf16* Y = lat ? (const bf16*)(ws + WS_YTL) + (size_t)(((seq - 32) * 4 + g) * 128) * 1024 : (const bf16*)(ws + WS_YTC) + (size_t)((seq * 4 + g) * 128) * 256;
    const int row0 = (lat ? M_CTX + (seq - 32) * 1024 : seq * 256) + rb * 128;
    const int rt = wave & 3, kh = wave >> 2, r32 = lane & 31, hi = lane >> 5;
    const bf16* ap = TW + ((size_t)((rb * 4 + rt) * 2 + kh) * nks) * 512 + lane * 8;
    const bf16* bp0 = Y + ((size_t)(kh * 2 + 0) * nks) * 512 + lane * 8;
    const bf16* bp1 = Y + ((size_t)(kh * 2 + 1) * nks) * 512 + lane * 8;
    f32x16 acc0 = {}, acc1 = {};
#pragma unroll 4
    for (int ks = 0; ks < nks; ++ks) { const bf16x8 a = *(const GAS bf16x8*)(ap + (size_t)ks * 512), b0 = *(const GAS bf16x8*)(bp0 + (size_t)ks * 512), b1 = *(const GAS bf16x8*)(bp1 + (size_t)ks * 512);
        acc0 = __builtin_amdgcn_mfma_f32_32x32x16_bf16(a, b0, acc0, 0, 0, 0); acc1 = __builtin_amdgcn_mfma_f32_32x32x16_bf16(a, b1, acc1, 0, 0, 0); }
    LAS float* C = (LAS float*)lds + rt * 2048;
    if (kh == 1) {
#pragma unroll
        for (int r = 0; r < 16; ++r) { C[crow(r, hi) * 64 + r32] = acc0[r]; C[crow(r, hi) * 64 + 32 + r32] = acc1[r]; } }
    WG_BAR();
    if (kh == 0) { const float s = lat ? (1.0f / 256.0f) : (1.0f / 128.0f);
        bf16* mp = (bf16*)(ws + WS_MIX) + (size_t)(row0 + rt * 32) * DM + 256 + g * 64 + r32;
#pragma unroll
        for (int r = 0; r < 16; ++r) { const int row = crow(r, hi);
            mp[(size_t)row * DM] = (bf16)f2bf((acc0[r] + C[row * 64 + r32]) * s); mp[(size_t)row * DM + 32] = (bf16)f2bf((acc1[r] + C[row * 64 + 32 + r32]) * s); } }
    WG_BAR();
}
template <int HALF> __device__ __forceinline__ void pool_item_g(const KArgs& A, int l, int chunk, int g, int lane, unsigned char* ws) {
    const bf16* U = (const bf16*)(ws + WS_U);
    const int row0 = chunk * 64;
    int sstart, L; if (row0 < M_CTX) { sstart = row0 & ~255; L = 256; } else { sstart = M_CTX + ((row0 - M_CTX) & ~1023); L = 1024; }
    const int sub = lane >> 4, c4 = (lane & 15) * 4, p0 = row0 - sstart + 16 * sub;
    constexpr int NR = 16 + 2 * HALF;
    f32x4 z[NR];
#pragma unroll
    for (int i = 0; i < NR; ++i) { const int pos = p0 - HALF + i; u32x2 w = {0u, 0u};
        if (pos >= 0 && pos < L) w = *(const GAS u32x2*)(U + (size_t)(sstart + pos) * NIN + g * 64 + c4);
        z[i] = (f32x4){bf2f(w.x & 0xffffu), bf2f(w.x >> 16), bf2f(w.y & 0xffffu), bf2f(w.y >> 16)}; }
    const f32x4 sc = *(const f32x4*)(A.in[I_POOLS] + l * 256 + g * 64 + c4);
    f32x4 run = {0.f, 0.f, 0.f, 0.f};
#pragma unroll
    for (int i = 0; i < 2 * HALF; ++i) run += z[i];
    bf16* mp = (bf16*)(ws + WS_MIX) + (size_t)(sstart + p0) * DM + g * 64 + c4;
#pragma unroll
    for (int t = 0; t < 16; ++t) { const int pos = p0 + t; const int cnt = min(pos + HALF, L) - max(pos - HALF, 0);
        const f32x4 y = (run * (1.0f / (float)cnt) - z[t + HALF]) * sc;
        *(GAS u32x2*)(mp + (size_t)t * DM) = (u32x2){pk2(y.x, y.y), pk2(y.z, y.w)};
        if (t < 15) run += z[t + 2 * HALF] - z[t]; }
}
__device__ __forceinline__ void pool_item(const KArgs& A, int l, int item, int lane) {
    asm volatile("" : "+v"(lane));
    unsigned char* ws = A.ws; asm volatile("" : "+s"(ws));
    const int g = item & 3, chunk = item >> 2;
    if (g == 0) pool_item_g<1>(A, l, chunk, 0, lane, ws); else if (g == 1) pool_item_g<2>(A, l, chunk, 1, lane, ws);
    else if (g == 2) pool_item_g<4>(A, l, chunk, 2, lane, ws); else pool_item_g<8>(A, l, chunk, 3, lane, ws);
}
constexpr int MX_LATT = 2 * 4 * 16, MX_CATT = 32 * 4 * 4, MX_LFOU = 2 * 4 * 8, MX_CFOU = 32 * 4 * 2, MX_POOL = (M_TOK / 64) * 4;
__device__ __forceinline__ void mix_phase(const KArgs& A, int l, LAS unsigned char* lds, int vcu, int G, int tid, int wave, int lane, int sel = 31) {
    if (sel & 5) {
#pragma unroll 1
        for (int it = vcu; it < MX_LATT + MX_CATT; it += G) {
            const bool isl = it < MX_LATT; const int r = it - MX_LATT;
            const int seq = isl ? 32 + (it >> 6) : r >> 4, hh = isl ? (it >> 4) & 3 : (r >> 2) & 3, qb = isl ? it & 15 : r & 3;
            if (sel & (isl ? 1 : 4)) attn_unit(A, l, seq, hh, qb, lds, tid, wave, lane);
        }
    }
    constexpr int O1 = MX_LATT + MX_CATT;
    if (sel & 10) {
#pragma unroll 1
        for (int it = ((vcu - O1) % G + G) % G; it < MX_LFOU + MX_CFOU; it += G) {
            const bool isl = it < MX_LFOU; const int r = it - MX_LFOU;
            const int seq = isl ? 32 + (it >> 5) : r >> 3, gg = isl ? (it >> 3) & 3 : (r >> 1) & 3, rb = isl ? it & 7 : r & 1;
            if (sel & (isl ? 2 : 8)) fourier_unit(A, seq, gg, rb, lds, tid, wave, lane);
        }
    }
    constexpr int O2 = O1 + MX_LFOU + MX_CFOU;
    if (sel & 16) {
        const int gw2 = (((vcu - O2) % G + G) % G) * NWAVES + wave;
#pragma unroll 1
        for (int it = gw2; it < MX_POOL; it += G * NWAVES) pool_item(A, l, it, lane);
    }
}
#define CAS __attribute__((address_space(4)))
#ifndef PROBE_KIND
#define PROBE_KIND -1
#endif
#ifndef PROBE_SEL
#define PROBE_SEL 31
#endif
#ifndef PROBE_N
#define PROBE_N 1
#endif
constexpr bool probe_match(int P, int kind) {
    if (kind < 0) return false;
    if (kind == 7) return P < NPHASES - 1;
    if (P == 0) return kind == 0;
    const int l = (P - 1) / 11, k = (P - 1) % 11;
    if (kind == 1) return k == 0 || k == 3 || k == 8;
    if (kind == 2) return k == 1 || k == 9;
    if (kind == 3) return k == 2 && l == 0;
    if (kind == 4) return k == 4;
    if (kind == 5) return k == 5;
    if (kind == 6) return k == 6;
    return false;
}
template <int PH> __device__ __forceinline__ void run_phase(const bool DUP, const KArgs& A, LAS unsigned char* lds, int tid, int lane, int wave, int G, int bx, int vcu, int gw, int NGW) {
    unsigned char* ws = A.ws;
    float* X = A.out;
    const float* mods = (const float*)(ws + WS_CTL) + CW_MODS;
    bf16* XN = (bf16*)(ws + WS_XN); bf16* GBUF = (bf16*)(ws + WS_GB); bf16* UB = (bf16*)(ws + WS_U); bf16* MIXB = (bf16*)(ws + WS_MIX);
    if constexpr (PH == 0) {
#ifndef SKIP_P0
        p0_prologue(A, lds, gw, NGW, wave, lane, DUP);
#endif
    } else {
        constexpr int l = (PH - 1) / 11, k = (PH - 1) % 11;
        const float* mods_l = mods + (size_t)l * 3 * 9216;
        unsigned char* wl = ws + WS_W + (size_t)l * SZ_WLAYER;
        const float* ng = A.in[I_NG] + (size_t)l * 3 * DM;
        if constexpr (k == 0) { if (l == 0) norm_phase(A.in[I_XP], A.in[I_XS], XN, ng, mods_l, 0, gw, NGW, lane); else norm_phase(X, X + OUT_YS, XN, ng, mods_l, 0, gw, NGW, lane); }
        else if constexpr (k == 3) norm_phase(X, X + OUT_YS, XN, ng + DM, mods_l, 1, gw, NGW, lane);
        else if constexpr (k == 8) norm_phase(X, X + OUT_YS, XN, ng + 2 * DM, mods_l, 2, gw, NGW, lane);
        else if constexpr (k == 1 || k == 9) {
            pg8::Gemm g{XN, (const bf16*)(wl + (k == 1 ? OFF_WI1 : OFF_WI2)), M_TOK, NWI, DM}; pg8::StaticOrder S; S.init(M_TOK, NWI, G, bx);
            pg8::EpiSwiglu E{GBUF, FF};
            pg8::gemm_phase<pg8::EpiSwiglu, pg8::StaticOrder, true, true>(lds, g, S, E);
        } else if constexpr (k == 2 || k == 10) {
            pg8::Gemm g{GBUF, (const bf16*)(wl + (k == 2 ? OFF_WO1 : OFF_WO2)), M_TOK, DM, FF}; pg8::StaticOrder S; S.init(M_TOK, DM, G, bx, 160);
            constexpr bool first = (k == 2 && l == 0);
            pg8::EpiResGate<1> E{first ? A.in[I_XP] : X, first ? A.in[I_XS] : X + OUT_YS, X, mods_l, k == 2 ? 2 : 8, 0.5f};
            pg8::gemm_phase<pg8::EpiResGate<1>, pg8::StaticOrder, true, true, 1>(lds, g, S, E);
        } else if constexpr (k == 4) {
            pg8::Gemm g{XN, (const bf16*)(wl + OFF_WIN), M_TOK, NIN, DM}; pg8::StaticOrder S; S.init(M_TOK, NIN, G, bx, 160);
            pg8::EpiU<1> E{UB, A.out + OUT_V, l};
            pg8::gemm_phase<pg8::EpiU<1>, pg8::StaticOrder, true, true, 1>(lds, g, S, E);
        } else if constexpr (k == 5) {
#ifndef SKIP_PREP
            prep_phase(A, l, lds, gw, NGW, wave, lane);
#endif
        } else if constexpr (k == 6) {
#ifndef SKIP_MIX
            mix_phase(A, l, lds, vcu, G, tid, wave, lane, DUP ? PROBE_SEL : 31);
#endif
        } else if constexpr (k == 7) {
            pg8::Gemm g{MIXB, (const bf16*)(wl + OFF_WOUT), M_TOK, DM, DM}; pg8::StaticOrder S; S.init(M_TOK, DM, G, bx, 160);
            pg8::EpiResGate<1> E{X, X + OUT_YS, X, mods_l, 5, 1.0f};
            pg8::gemm_phase<pg8::EpiResGate<1>, pg8::StaticOrder, true, true, 1>(lds, g, S, E);
        }
    }
}
__global__ void __launch_bounds__(NWAVES * 64, 2) hyb_fwd(KArgs A) {
    extern __shared__ __attribute__((aligned(16))) unsigned char lds_raw[];
    LAS unsigned char* lds = (LAS unsigned char*)lds_raw;
    volatile LAS unsigned* MISC = (volatile LAS unsigned*)(lds + MISC_OFF);
    const int tid = threadIdx.x, lane = tid & 63, wave = __builtin_amdgcn_readfirstlane(tid >> 6);
    const int G = gridDim.x, bx = blockIdx.x, vcu = (G % 8 == 0) ? (bx % 8) * (G / 8) + bx / 8 : bx;
    const int gw = vcu * NWAVES + wave, NGW = G * NWAVES;
    gu32* ctl = (gu32*)(A.ws + WS_CTL);
    for (int u = tid; u < (LDS_BYTES - LDSCTL_OFF) / 4; u += NWAVES * 64) ((LAS unsigned*)(lds + LDSCTL_OFF))[u] = 0u;
    __syncthreads();
    const int lo = A.ph_lo, hi = A.ph_hi;
    XcdBarrier bar; bar.bar = (unsigned*)(ctl + CW_BAR); bar.x = 0; bar.st = nullptr;
    if (hi - lo > 1) bar = xcd_barrier_post((unsigned*)(ctl + CW_BAR), MISC + 8);
#define PHASE(P) if (lo <= (P) && (P) < hi) { _Pragma("unroll 1") for (int rep_ = 0; rep_ < (probe_match(P, PROBE_KIND) ? 1 + PROBE_N : 1); ++rep_) { \
        if (PROBE_KIND != 7 || rep_ == 0) run_phase<P>(rep_ > 0, A, lds, tid, lane, wave, G, bx, vcu, gw, NGW); if ((P) + 1 < hi || rep_ + 1 < (probe_match(P, PROBE_KIND) ? 1 + PROBE_N : 1)) xcd_barrier(bar); } }
    PHASE(0) PHASE(1) PHASE(2) PHASE(3) PHASE(4) PHASE(5) PHASE(6) PHASE(7) PHASE(8) PHASE(9) PHASE(10) PHASE(11)
    PHASE(12) PHASE(13) PHASE(14) PHASE(15) PHASE(16) PHASE(17) PHASE(18) PHASE(19) PHASE(20) PHASE(21) PHASE(22)
#undef PHASE
}

#ifndef N_LAUNCH_MODE
#define N_LAUNCH_MODE 1
#endif
extern "C" void kernel_launch(void* const* d_in, const int* in_sizes, int n_in, void* d_out, int out_size, void* d_ws, size_t ws_size, hipStream_t stream) {
    static int grid = 0;
    if (grid == 0) {
        if (n_in != 25 || ws_size < WS_END) { fprintf(stderr, "kernel_launch: unexpected n_in %d / ws %zu\n", n_in, ws_size); grid = -1; return; }
        int dev = 0, cus = 0, per_cu = 0;
        if (hipGetDevice(&dev) != hipSuccess || hipDeviceGetAttribute(&cus, hipDeviceAttributeMultiprocessorCount, dev) != hipSuccess) { grid = -1; return; }
        if (hipFuncSetAttribute((const void*)hyb_fwd, hipFuncAttributeMaxDynamicSharedMemorySize, LDS_BYTES) != hipSuccess) { fprintf(stderr, "kernel_launch: hipFuncSetAttribute failed\n"); grid = -1; return; }
        if (hipOccupancyMaxActiveBlocksPerMultiprocessor(&per_cu, (const void*)hyb_fwd, NWAVES * 64, LDS_BYTES) != hipSuccess || per_cu < 1) { fprintf(stderr, "kernel_launch: occupancy query says %d blocks per CU\n", per_cu); }
        (void)hipGetLastError();
        grid = cus;
    }
    if (grid < 0) return;
    if (hipMemsetAsync((char*)d_ws + WS_CTL, 0, CTL_ZERO_BYTES, stream) != hipSuccess) return;
    KArgs a{};
    for (int i = 0; i < 25; ++i) a.in[i] = (const float*)d_in[i];
    a.out = (float*)d_out; a.ws = (unsigned char*)d_ws;
#if N_LAUNCH_MODE == 0
    for (int p = 0; p < NPHASES; ++p) { a.ph_lo = p; a.ph_hi = p + 1; hipLaunchKernelGGL(hyb_fwd, dim3(grid), dim3(NWAVES * 64), LDS_BYTES, stream, a); }
#else
    a.ph_lo = 0; a.ph_hi = NPHASES; hipLaunchKernelGGL(hyb_fwd, dim3(grid), dim3(NWAVES * 64), LDS_BYTES, stream, a);
#endif
}
```

```cpp
#include <hip/hip_runtime.h>
#include <cstdio>
#include <cstdint>
namespace pg8 {
#define PG8_LAS __attribute__((address_space(3)))
typedef unsigned short bf16_t;
typedef short bf16x8 __attribute__((ext_vector_type(8)));
typedef float f32x4 __attribute__((ext_vector_type(4)));
typedef unsigned u32x4 __attribute__((ext_vector_type(4)));
constexpr int BM = 256, BK = 64, HALF = 128, HTB = HALF * BK * 2  , STAGE_BYTES = 8 * HTB, NXCD = 8, WGM = 8;

__host__ __device__ __forceinline__ int lds_byte(int r, int c) { const int st = (r >> 4) * 2 + (c >> 5), rr = r & 15, cc = c & 31, ob = rr * 64 + cc * 2; return st * 1024 + (ob ^ (((ob >> 9) & 1) << 5)); }
__host__ __device__ __forceinline__ void stage_rc(int b, int& R, int& C) { const int st = b / 1024, sb = b % 1024, swz = sb ^ (((sb >> 9) & 1) << 5); R = (st >> 1) * 16 + swz / 64; C = (st & 1) * 32 + (swz % 64) / 2; }
__host__ __device__ __forceinline__ int perm32(int rho) { const int n = rho >> 4, i = rho & 15; return 8 * (i >> 2) + 4 * n + (i & 3); }

struct Unit { int pm, pn; };
struct Gemm { const bf16_t* A; const bf16_t* Bt; int M, N, K; };

struct StaticOrder {
    int nM, nN, nwg, G, c;
    __host__ __device__ void init(int M, int N, int G_, int c_, int TM = BM) { nM = M / TM; nN = N / BM; nwg = nM * nN; G = G_; c = c_; }
    __host__ __device__ bool next(int i, Unit& u) const {
        const long L = (long)i * G + c; if (L >= nwg) return false;
        int wgid = (int)L; { const int q = nwg / NXCD, r = nwg % NXCD, xcd = wgid % NXCD, off = wgid / NXCD; wgid = (xcd < r ? xcd * (q + 1) : r * (q + 1) + (xcd - r) * q) + off; }
        const int nig = WGM * nN, gid = wgid / nig, fm = gid * WGM, gsz = (nM - fm) < WGM ? (nM - fm) : WGM;
        u.pm = fm + ((wgid % nig) % gsz); u.pn = (wgid % nig) / gsz; return true;
    }
    __device__ __forceinline__ void a_ready(const Unit&) const {}
    __device__ __forceinline__ void done(const Unit&) const {}
};

__device__ __forceinline__ unsigned cvt_pk_bf16(float lo, float hi) { unsigned r; asm volatile("v_cvt_pk_bf16_f32 %0, %1, %2" : "=v"(r) : "v"(lo), "v"(hi)); return r; }
typedef float f32x2 __attribute__((ext_vector_type(2)));
template <class Epi, class Sched, bool ALIGN_EPI = false, bool SP2 = false, int M1 = 4>
__device__ __forceinline__ void gemm_phase(PG8_LAS unsigned char* lds, const Gemm g, const Sched& S, const Epi& E) {
    const int tid = threadIdx.x, wid = __builtin_amdgcn_readfirstlane(tid >> 6), lane = tid & 63, wr = wid >> 2, wc = wid & 3, fr = lane & 15, fq = lane >> 4;
    const int K = g.K, nt = K / BK;
    unsigned voffA[2], voffB[2];
#pragma unroll
    for (int i = 0; i < 2; ++i) { int R, C; stage_rc(tid * 16 + i * 8192, R, C); const int Rb = Epi::PERM ? ((R & ~31) + perm32(R & 31)) : R;
        voffA[i] = (unsigned)(R * K + C) * 2u; voffB[i] = (unsigned)(Rb * K + C) * 2u; }
    unsigned voffA1[2], ldsA1[2];
#pragma unroll
    for (int i = 0; i < 2; ++i) { if (M1 == 4) { voffA1[i] = voffA[i]; ldsA1[i] = (unsigned)wid * 1024u + i * 8192u; }
        else { int R, C; stage_rc((wid & 3) * 1024 + lane * 16, R, C); voffA1[i] = (unsigned)(R * K + C) * 2u; ldsA1[i] = (unsigned)(wid & 3) * 1024u; } }
    unsigned voffA1d; { int R, C; stage_rc((wid & 3) * 1024 + lane * 4, R, C); voffA1d = (unsigned)(R * K + C) * 2u; }
    const size_t kstep = (size_t)(BK * 2);
    const size_t hstep = (size_t)HALF * K * 2;
    const size_t tstep = 2 * hstep;
    const size_t tstepA = (size_t)(HALF + 32 * M1) * K * 2;
    const unsigned ldsw = (unsigned)wid * 1024u;
    const int aoff = lds_byte(wr * 64 + fr, fq * 8), boff = lds_byte(wc * 32 + fr, fq * 8), aoff1 = lds_byte(wr * 16 * M1 + fr, fq * 8);
#define PG8_SA(b, h) (((b) * 2 + (h)) * HTB)
#define PG8_SB(b, h) ((4 + (b) * 2 + (h)) * HTB)
#define PG8_STAGE(bufoff, gbase, voff) do { _Pragma("unroll") for (int _i = 0; _i < 2; ++_i) \
        __builtin_amdgcn_global_load_lds((const unsigned*)((const char*)(gbase) + (voff)[_i]), (PG8_LAS unsigned*)(lds + (bufoff) + ldsw + _i * 8192), 16, 0, 0); } while (0)
#define PG8_STAGE_A1(bufoff, gbase) do { if (M1 == 4) { _Pragma("unroll") for (int _i = 0; _i < 2; ++_i) \
        __builtin_amdgcn_global_load_lds((const unsigned*)((const char*)(gbase) + voffA1[_i]), (PG8_LAS unsigned*)(lds + (bufoff) + ldsA1[_i]), 16, 0, 0); } \
      else {   \
        if (wid < 4) __builtin_amdgcn_global_load_lds((const unsigned*)((const char*)(gbase) + voffA1[0]), (PG8_LAS unsigned*)(lds + (bufoff) + ldsA1[0]), 16, 0, 0); \
        else __builtin_amdgcn_global_load_lds((const unsigned*)((const char*)(gbase) + voffA1d), (PG8_LAS unsigned*)(lds + (bufoff) + ldsA1[0]), 4, 0, 0); \
        __builtin_amdgcn_global_load_lds((const unsigned*)((const char*)(gbase) + voffA1d), (PG8_LAS unsigned*)(lds + (bufoff) + ldsA1[0]), 4, 0, 0); } } while (0)
#define PG8_LDA(dst, b, h) do { _Pragma("unroll") for (int m = 0; m < ((h) ? M1 : 4); ++m) _Pragma("unroll") for (int k = 0; k < 2; ++k) dst[m][k] = *(const PG8_LAS bf16x8*)(lds + PG8_SA(b, h) + ((h) ? aoff1 : aoff) + m * 2048 + k * 1024); } while (0)
#define PG8_LDB(dst, b, h) do { _Pragma("unroll") for (int n = 0; n < 2; ++n) _Pragma("unroll") for (int k = 0; k < 2; ++k) dst[n][k] = *(const PG8_LAS bf16x8*)(lds + PG8_SB(b, h) + boff + n * 2048 + k * 1024); } while (0)
#define PG8_MMA(ai, bj, At, Bt) do { __builtin_amdgcn_s_setprio(1); _Pragma("unroll") for (int m = 0; m < ((ai) ? M1 : 4); ++m) _Pragma("unroll") for (int n = 0; n < 2; ++n) _Pragma("unroll") for (int k = 0; k < 2; ++k) \
        acc[ai][bj][m][n] = __builtin_amdgcn_mfma_f32_16x16x32_bf16(Bt[n][k], At[m][k], acc[ai][bj][m][n], 0, 0, 0); __builtin_amdgcn_s_setprio(0); } while (0)
#define PG8_WAIT_V(n) asm volatile("s_waitcnt vmcnt(" #n ")" ::: "memory")
#define PG8_WAIT_L(n) asm volatile("s_waitcnt lgkmcnt(" #n ")" ::: "memory")
#define PG8_BAR __builtin_amdgcn_s_barrier()
#define PG8_SCHED __builtin_amdgcn_sched_barrier(0)
    Unit cur, nxt; int ui = 0;
    if (!S.next(0, cur)) return;
    f32x4 acc[2][2][4][2];
#pragma unroll
    for (int a = 0; a < 2; ++a)
#pragma unroll
        for (int b = 0; b < 2; ++b)
#pragma unroll
            for (int m = 0; m < 4; ++m)
#pragma unroll
                for (int n = 0; n < 2; ++n) acc[a][b][m][n] = (f32x4){0.f, 0.f, 0.f, 0.f};
    bf16x8 At[4][2], B0[2][2], B1[2][2];
    const char* cA = (const char*)g.A + (size_t)cur.pm * tstepA; const char* cB = (const char*)g.Bt + (size_t)cur.pn * tstep;
    S.a_ready(cur);
    if constexpr (SP2) {
        PG8_STAGE(PG8_SB(0, 0), cB, voffB); PG8_STAGE(PG8_SB(0, 1), cB + hstep, voffB); PG8_STAGE(PG8_SA(0, 0), cA, voffA); PG8_STAGE_A1(PG8_SA(0, 1), cA + hstep);
        if (wr == 1) PG8_BAR;
        PG8_WAIT_V(2); PG8_BAR;
        PG8_STAGE(PG8_SB(1, 0), cB + kstep, voffB); PG8_STAGE(PG8_SA(1, 0), cA + kstep, voffA); PG8_STAGE(PG8_SB(1, 1), cB + hstep + kstep, voffB);
        PG8_WAIT_V(6); PG8_BAR;
    } else {
        PG8_STAGE(PG8_SB(0, 0), cB, voffB); PG8_STAGE(PG8_SA(0, 0), cA, voffA); PG8_STAGE(PG8_SB(0, 1), cB + hstep, voffB); PG8_STAGE_A1(PG8_SA(0, 1), cA + hstep);
        if (wr == 1) PG8_BAR;
        PG8_WAIT_V(4); PG8_BAR;
        PG8_STAGE(PG8_SB(1, 0), cB + kstep, voffB); PG8_STAGE(PG8_SA(1, 0), cA + kstep, voffA); PG8_STAGE(PG8_SB(1, 1), cB + hstep + kstep, voffB);
        PG8_WAIT_V(6); PG8_BAR;
    }
    for (;;) {
        const bool has_next = S.next(ui + 1, nxt);
        const char* nA = has_next ? (const char*)g.A + (size_t)nxt.pm * tstepA : cA; const char* nB = has_next ? (const char*)g.Bt + (size_t)nxt.pn * tstep : cB;
        for (int t = 0; t < nt; t += 2) {
            const bool last = (t == nt - 2);
            const char* a1 = cA + (size_t)(t + 1) * kstep;
            const char* a2 = last ? nA : cA + (size_t)(t + 2) * kstep; const char* b2 = last ? nB : cB + (size_t)(t + 2) * kstep;
            const char* a3 = a2 + kstep; const char* b3 = b2 + kstep;
            if (last && has_next) S.a_ready(nxt);
            if constexpr (SP2) {
            PG8_LDB(B0, 0, 0); PG8_LDB(B1, 0, 1); PG8_SCHED; PG8_LDA(At, 0, 0); PG8_STAGE_A1(PG8_SA(1, 1), a1 + hstep);
            PG8_WAIT_V(8); PG8_WAIT_L(0); PG8_BAR; PG8_MMA(0, 0, At, B0); PG8_MMA(0, 1, At, B1); PG8_BAR; PG8_SCHED;
            PG8_LDA(At, 0, 1); PG8_STAGE(PG8_SB(0, 0), b2, voffB); PG8_STAGE(PG8_SB(0, 1), b2 + hstep, voffB); PG8_STAGE(PG8_SA(0, 0), a2, voffA);
            PG8_WAIT_V(8); PG8_WAIT_L(0); PG8_BAR; PG8_MMA(1, 0, At, B0); PG8_MMA(1, 1, At, B1); PG8_BAR; PG8_SCHED;
            PG8_LDB(B0, 1, 0); PG8_LDB(B1, 1, 1); PG8_SCHED; PG8_LDA(At, 1, 0); PG8_STAGE_A1(PG8_SA(0, 1), a2 + hstep);
            PG8_WAIT_V(8); PG8_WAIT_L(0); PG8_BAR; PG8_MMA(0, 0, At, B0); PG8_MMA(0, 1, At, B1); PG8_BAR; PG8_SCHED;
            PG8_LDA(At, 1, 1); PG8_STAGE(PG8_SB(1, 0), b3, voffB); PG8_STAGE(PG8_SB(1, 1), b3 + hstep, voffB); PG8_STAGE(PG8_SA(1, 0), a3, voffA);
            PG8_WAIT_V(8); PG8_WAIT_L(0); PG8_BAR; PG8_MMA(1, 0, At, B0); PG8_MMA(1, 1, At, B1); PG8_BAR; PG8_SCHED;
            } else {
            PG8_LDB(B0, 0, 0); PG8_SCHED; PG8_LDA(At, 0, 0); PG8_STAGE_A1(PG8_SA(1, 1), a1 + hstep);
            PG8_WAIT_L(8); PG8_BAR; PG8_WAIT_L(0); PG8_MMA(0, 0, At, B0); PG8_BAR; PG8_SCHED;
            PG8_LDB(B1, 0, 1); PG8_STAGE(PG8_SB(0, 0), b2, voffB);
            PG8_BAR; PG8_WAIT_L(0); PG8_MMA(0, 1, At, B1); PG8_BAR;
            PG8_LDA(At, 0, 1); PG8_STAGE(PG8_SA(0, 0), a2, voffA);
            PG8_BAR; PG8_WAIT_L(0); PG8_MMA(1, 0, At, B0); PG8_BAR; PG8_SCHED;
            PG8_STAGE(PG8_SB(0, 1), b2 + hstep, voffB);
            PG8_WAIT_V(6); PG8_BAR; PG8_MMA(1, 1, At, B1); PG8_BAR;
            PG8_LDB(B0, 1, 0); PG8_SCHED; PG8_LDA(At, 1, 0); PG8_STAGE_A1(PG8_SA(0, 1), a2 + hstep);
            PG8_WAIT_L(8); PG8_BAR; PG8_WAIT_L(0); PG8_MMA(0, 0, At, B0); PG8_BAR; PG8_SCHED;
            PG8_LDB(B1, 1, 1); PG8_STAGE(PG8_SB(1, 0), b3, voffB);
            PG8_BAR; PG8_WAIT_L(0); PG8_MMA(0, 1, At, B1); PG8_BAR;
            PG8_LDA(At, 1, 1); PG8_STAGE(PG8_SA(1, 0), a3, voffA);
            PG8_BAR; PG8_WAIT_L(0); PG8_MMA(1, 0, At, B0); PG8_BAR; PG8_SCHED;
            PG8_STAGE(PG8_SB(1, 1), b3 + hstep, voffB);
            PG8_WAIT_V(6); PG8_BAR; PG8_MMA(1, 1, At, B1); PG8_BAR;
            }
        }
        if constexpr (ALIGN_EPI) { if (wr == 0) PG8_BAR; }
        if constexpr (!Epi::AFTER_DRAIN) { E(acc, cur, wr, wc, fr, fq); S.done(cur); }
        if (!has_next) break;
#pragma unroll
        for (int a = 0; a < 2; ++a)
#pragma unroll
            for (int b = 0; b < 2; ++b)
#pragma unroll
                for (int m = 0; m < 4; ++m)
#pragma unroll
                    for (int n = 0; n < 2; ++n) acc[a][b][m][n] = (f32x4){0.f, 0.f, 0.f, 0.f};
        cur = nxt; cA = nA; cB = nB; ++ui;
        if constexpr (ALIGN_EPI) { if (wr == 1) PG8_BAR; }
    }
    PG8_WAIT_V(0);
    if constexpr (!ALIGN_EPI) { if (wr == 0) PG8_BAR; }
    PG8_BAR;
    if constexpr (Epi::AFTER_DRAIN) { E.fused(acc, cur, wr, wc, fr, fq, lds, wid, lane); S.done(cur); }
#undef PG8_SA
#undef PG8_SB
#undef PG8_STAGE
#undef PG8_STAGE_A1
#undef PG8_LDA
#undef PG8_LDB
#undef PG8_MMA
#undef PG8_WAIT_V
#undef PG8_WAIT_L
#undef PG8_BAR
#undef PG8_SCHED
}
}
constexpr int M_TOK = 10240, M_CTX = 8192, DM = 1024, FF = 2816, NWI = 5632, NIN = 2048;
constexpr int LCTX = 256, LLAT = 1024, LKLAT = 1280, NSEQ = 34;
constexpr float EPS = 1e-6f;

namespace pg8 {
__device__ __forceinline__ float silu_f(float x) { return x * __builtin_amdgcn_rcpf(1.0f + __builtin_amdgcn_exp2f(-1.4426950408889634f * x)); }
struct EpiSwiglu {
    static constexpr bool PERM = true, AFTER_DRAIN = false;
    bf16_t* O; int ldc;
    __device__ __forceinline__ void operator()(const f32x4 (&acc)[2][2][4][2], const Unit& u, int wr, int wc, int fr, int fq) const {
        const int row0 = u.pm * BM + wr * 64 + fr, col0 = u.pn * HALF + wc * 32 + 8 * fq;
#pragma unroll
        for (int ai = 0; ai < 2; ++ai)
#pragma unroll
            for (int m = 0; m < 4; ++m) { bf16_t* rowp = O + (size_t)(row0 + ai * HALF + m * 16) * ldc + col0;
                const f32x4 a0 = acc[ai][0][m][0], a1 = acc[ai][0][m][1], b0 = acc[ai][1][m][0], b1 = acc[ai][1][m][1];
                u32x4 w;
                w.x = cvt_pk_bf16(silu_f(a0[0]) * b0[0], silu_f(a0[1]) * b0[1]); w.y = cvt_pk_bf16(silu_f(a0[2]) * b0[2], silu_f(a0[3]) * b0[3]);
                w.z = cvt_pk_bf16(silu_f(a1[0]) * b1[0], silu_f(a1[1]) * b1[1]); w.w = cvt_pk_bf16(silu_f(a1[2]) * b1[2], silu_f(a1[3]) * b1[3]);
                *(u32x4*)rowp = w; }
    }
};
template <int M1> struct EpiResGate {
    static constexpr bool PERM = false, AFTER_DRAIN = false;
    static constexpr int TM = HALF + 32 * M1;
    const float* base0; const float* base1;
    float* out; const float* mods;
    int idx; float gs;
    __device__ __forceinline__ void operator()(const f32x4 (&acc)[2][2][4][2], const Unit& u, int wr, int wc, int fr, int fq) const {
        const int col0 = u.pn * BM + wc * 32 + 4 * fq;
#pragma unroll
        for (int ai = 0; ai < 2; ++ai)
#pragma unroll
            for (int m = 0; m < (ai ? M1 : 4); ++m) {
                const int rb = u.pm * TM + (ai ? HALF + wr * 16 * M1 : wr * 64) + m * 16;
                const int set = rb < M_CTX ? 0 : 1 + ((rb - M_CTX) >> 10);
                const float* mv = mods + (size_t)(set * 9 + idx) * DM + col0;
                const float* bp = (rb < M_CTX ? base0 + (size_t)rb * DM : base1 + (size_t)(rb - M_CTX) * DM) + (size_t)fr * DM + col0;
                float* op = out + (size_t)(rb + fr) * DM + col0;
#pragma unroll
                for (int bj = 0; bj < 2; ++bj)
#pragma unroll
                    for (int n = 0; n < 2; ++n) { const f32x4 gv = *(const f32x4*)(mv + bj * HALF + n * 16) * gs; const f32x4 b = *(const f32x4*)(bp + bj * HALF + n * 16);
                        *(f32x4*)(op + bj * HALF + n * 16) = b + gv * acc[ai][bj][m][n]; } }
    }
};
template <int M1> struct EpiU {
    static constexpr bool PERM = true, AFTER_DRAIN = false;
    static constexpr int TM = HALF + 32 * M1;
    bf16_t* U; float* outV; int layer;
    __device__ __forceinline__ void operator()(const f32x4 (&acc)[2][2][4][2], const Unit& u, int wr, int wc, int fr, int fq) const {
        const int col0 = u.pn * BM + wc * 32 + 8 * fq;
#pragma unroll
        for (int ai = 0; ai < 2; ++ai)
#pragma unroll
            for (int m = 0; m < (ai ? M1 : 4); ++m) { const int rb = u.pm * TM + (ai ? HALF + wr * 16 * M1 : wr * 64) + m * 16, row = rb + fr; bf16_t* rowp = U + (size_t)row * NIN + col0;
                const bool vout = (u.pn >= 6) && (rb < M_CTX);
#pragma unroll
                for (int bj = 0; bj < 2; ++bj) { const f32x4 v0 = acc[ai][bj][m][0], v1 = acc[ai][bj][m][1];
                    u32x4 w; w.x = cvt_pk_bf16(v0[0], v0[1]); w.y = cvt_pk_bf16(v0[2], v0[3]); w.z = cvt_pk_bf16(v1[0], v1[1]); w.w = cvt_pk_bf16(v1[2], v1[3]);
                    *(u32x4*)(rowp + bj * HALF) = w;
                    if (vout) { float* vp = outV + ((size_t)((row >> 8) * 2 + layer) * 256 + (row & 255)) * 512 + (col0 + bj * HALF - 1536);
                        *(f32x4*)vp = v0; *(f32x4*)(vp + 4) = v1; } } }
    }
};
}
constexpr size_t MiB = 1u << 20;
constexpr size_t WS_CTL = 0, CTL_ZERO_BYTES = 512 * 1024;
constexpr size_t SZ_WI = (size_t)NWI * DM * 2, SZ_WO = (size_t)DM * FF * 2, SZ_WIN = (size_t)NIN * DM * 2, SZ_WOUT = (size_t)DM * DM * 2;
constexpr size_t WS_W = 2 * MiB;
constexpr size_t OFF_WI1 = 0, OFF_WO1 = OFF_WI1 + SZ_WI, OFF_WI2 = OFF_WO1 + SZ_WO, OFF_WO2 = OFF_WI2 + SZ_WI, OFF_WIN = OFF_WO2 + SZ_WO, OFF_WOUT = OFF_WIN + SZ_WIN, SZ_WLAYER = OFF_WOUT + SZ_WOUT;
constexpr size_t WS_TW1024 = 84 * MiB;
constexpr size_t WS_TW256 = 88 * MiB;
constexpr size_t WS_WCS = WS_TW256 + 512 * 1024;
constexpr size_t WS_ROPE = WS_WCS + 256 * 1024;
constexpr size_t WS_SCAL = WS_ROPE + 16 * 1024;
constexpr size_t WS_XN = 90 * MiB;
constexpr size_t WS_MIX = 110 * MiB;
constexpr size_t WS_GB = 130 * MiB;
constexpr size_t WS_U = 130 * MiB;
constexpr size_t WS_QB = 170 * MiB;
constexpr size_t WS_KB = 185 * MiB;
constexpr size_t WS_VTC = 196 * MiB;
constexpr size_t WS_VTL = 204 * MiB;
constexpr size_t WS_YTC = 207 * MiB;
constexpr size_t WS_YTL = 215 * MiB;
constexpr size_t WS_QN = 217 * MiB;
constexpr size_t WS_END = 218 * MiB;
static_assert(WS_W + 2 * SZ_WLAYER <= WS_TW1024 && WS_SCAL + 64 <= WS_XN && WS_GB + (size_t)M_TOK * FF * 2 <= WS_KB && WS_QB + (size_t)M_TOK * 512 * 2 <= WS_KB, "ws map");
constexpr int CW_TMO = 0, CW_BAR = 4096, CW_KMAX = 8192  , CW_MODS = 16384  ;
static_assert((CW_MODS + 2 * 3 * 9 * 1024) * 4 <= (int)CTL_ZERO_BYTES, "ctl");
constexpr int RING_BYTES = 131072, LDSCTL_OFF = RING_BYTES, MISC_OFF = LDSCTL_OFF + 320, LDS_BYTES = 147456;
constexpr int NWAVES = 8;
constexpr int NPHASES = 23;
#define GAS __attribute__((address_space(1)))
#define LAS __attribute__((address_space(3)))
typedef unsigned short bf16;
typedef unsigned v4u __attribute__((ext_vector_type(4)));
typedef float f32x4 __attribute__((ext_vector_type(4)));
typedef short bf16x8 __attribute__((ext_vector_type(8)));
typedef GAS unsigned gu32;
typedef GAS unsigned long long gu64;
#define RLX_AGENT __ATOMIC_RELAXED, __HIP_MEMORY_SCOPE_AGENT
#define LDS_WAIT() asm volatile("s_waitcnt lgkmcnt(0)" ::: "memory")
#define VM_WAIT() asm volatile("s_waitcnt vmcnt(0)" ::: "memory")
__device__ __forceinline__ unsigned long long rt() { return __builtin_amdgcn_s_memrealtime(); }
__device__ __forceinline__ unsigned f2bf(float f) { unsigned u = __builtin_bit_cast(unsigned, f); return (u + 0x7fffu + ((u >> 16) & 1u)) >> 16; }
typedef float f32x2_t __attribute__((ext_vector_type(2))); typedef __bf16 bf16x2_t __attribute__((ext_vector_type(2)));
__device__ __forceinline__ unsigned pk2(float lo, float hi) { f32x2_t v = {lo, hi}; bf16x2_t b = __builtin_convertvector(v, bf16x2_t); return __builtin_bit_cast(unsigned, b); }
#define XB_TMO      128
#define XB_XCNT(j)  (256  + 64 * (j))
#define XB_XSUB(j)  (1280 + 64 * (j))
#define XB_XGEN(j)  (2304 + 64 * (j))
#define XB_TOP      3328
#define XB_TOPGEN   3392
#define XCD_BAR_WORDS 3456
#define XB_SPIN_CAP (1u << 18)

__device__ __forceinline__ unsigned xb_ld(unsigned* p)              { return __hip_atomic_load(p, __ATOMIC_RELAXED, __HIP_MEMORY_SCOPE_AGENT); }
__device__ __forceinline__ unsigned xb_add(unsigned* p, unsigned v) { return __hip_atomic_fetch_add(p, v, __ATOMIC_RELAXED, __HIP_MEMORY_SCOPE_AGENT); }
__device__ __forceinline__ unsigned xb_xcc_id() { return (unsigned)__builtin_amdgcn_s_getreg((3 << 11) | 20) & 0xFu; }
#define XB_SPIN(cond, bar) do { unsigned _sp = 0; while (cond) { __builtin_amdgcn_s_sleep(1); \
    if ((++_sp & 255u) == 0u) { if (xb_ld(&(bar)[XB_TMO])) break; if (_sp > XB_SPIN_CAP) { atomicAdd(&(bar)[XB_TMO], 1u); break; } } } } while (0)

struct XcdBarrier {
    unsigned* bar; unsigned x;
    volatile LAS unsigned* st;
};

__device__ __forceinline__ XcdBarrier xcd_barrier_post(unsigned* bar, volatile LAS unsigned* st) {
    XcdBarrier b; b.bar = bar; b.x = xb_xcc_id(); b.st = st;
    if (threadIdx.x == 0) (void)xb_add(&bar[XB_XCNT(b.x)], 1u);
    return b;
}
__device__ __forceinline__ void xcd_barrier_complete(unsigned* bar, unsigned x, unsigned& nloc, unsigned& nx) {
    const unsigned G = gridDim.x * gridDim.y * gridDim.z;
    unsigned sum, cnt, mine, sp = 0u;
    for (;;) {
        sum = 0u; cnt = 0u; mine = 0u;
#pragma unroll
        for (unsigned j = 0; j < 16; ++j) { const unsigned c = xb_ld(&bar[XB_XCNT(j)]); sum += c; cnt += (c > 0u) ? 1u : 0u; mine = (j == x) ? c : mine; }
        if (sum == G) break;
        __builtin_amdgcn_s_sleep(1);
        if ((++sp & 255u) == 0u) { if (xb_ld(&bar[XB_TMO])) break; if (sp > XB_SPIN_CAP) { atomicAdd(&bar[XB_TMO], 1u); break; } }
    }
    nloc = mine > 0u ? mine : 1u; nx = cnt > 0u ? cnt : 1u;
}

__device__ __forceinline__ void xcd_barrier(const XcdBarrier& b) {
    asm volatile("s_waitcnt vmcnt(0)" ::: "memory");
    __syncthreads();
    if (threadIdx.x == 0) {
        unsigned* bar = b.bar;
        __builtin_amdgcn_s_waitcnt(0);
        unsigned nloc = b.st[0], nx = b.st[1];
        if (nloc == 0u) { xcd_barrier_complete(bar, b.x, nloc, nx); b.st[0] = nloc; b.st[1] = nx; }
        const unsigned old = xb_add(&bar[XB_XSUB(b.x)], 1u);
        const unsigned gen = old / nloc;
        if (old + 1u == (gen + 1u) * nloc) {
            __builtin_amdgcn_fence(__ATOMIC_RELEASE, "agent");
            asm volatile("s_waitcnt vmcnt(0)" ::: "memory");
            const unsigned og = xb_add(&bar[XB_TOP], 1u);
            const unsigned tg = og / nx;
            if (og + 1u == (tg + 1u) * nx) xb_add(&bar[XB_TOPGEN], 1u);
            else XB_SPIN(xb_ld(&bar[XB_TOPGEN]) == tg, bar);
            __builtin_amdgcn_fence(__ATOMIC_ACQUIRE, "agent");
            xb_add(&bar[XB_XGEN(b.x)], 1u);
            asm volatile("s_waitcnt vmcnt(0)" ::: "memory");
        } else {
            XB_SPIN(xb_ld(&bar[XB_XGEN(b.x)]) == gen, bar);
            __builtin_amdgcn_fence(__ATOMIC_ACQUIRE, "agent");
            asm volatile("s_waitcnt vmcnt(0)" ::: "memory");
        }
    }
    __syncthreads();
}
typedef float f32x16 __attribute__((ext_vector_type(16)));
typedef unsigned u32x2 __attribute__((ext_vector_type(2)));
__device__ __forceinline__ float bf2f(unsigned h) { return __builtin_bit_cast(float, h << 16); }
__device__ __forceinline__ float wave_sum(float v) {
#pragma unroll
    for (int o = 1; o < 64; o <<= 1) v += __shfl_xor(v, o);
    return v;
}
__device__ __forceinline__ int crow(int r, int hi) { return (r & 3) + 8 * (r >> 2) + 4 * hi; }
__device__ __forceinline__ float silu_acc(float x) { return x / (1.0f + expf(-x)); }

struct KArgs { const float* in[25]; float* out; unsigned char* ws; int ph_lo, ph_hi; };
enum { I_XP = 0, I_XS, I_CK, I_CV, I_C, I_CCTX, I_NG, I_ADAW, I_ADAB, I_F1WI, I_F1WO, I_F2WI, I_F2WO, I_WIN, I_WOUT, I_QG, I_KG, I_LQ1, I_LK1, I_LQ2, I_LK2, I_AOG, I_POOLW, I_POOLS, I_FNETW };
constexpr size_t OUT_YS = (size_t)M_CTX * DM, OUT_K = (size_t)M_TOK * DM, OUT_V = OUT_K + (size_t)32 * 2 * 256 * 512;

__device__ __forceinline__ void p0_transpose_item(const float* W, int K, int N, bf16* WT, bool swi, LAS float* scr, int item, int lane) {
    const int nblk = N / 32, kb = item / nblk, nb = item % nblk, k0 = 64 * kb, n0 = 32 * nb;
    int r0 = n0;
    if (swi) { const int half = n0 / FF, jj = n0 % FF; r0 = (jj / 128) * 256 + half * 128 + (jj % 128); }
#pragma unroll 8
    for (int i = 0; i < 32; ++i) { const int kk = 2 * i + (lane >> 5); scr[kk * 33 + (lane & 31)] = W[(size_t)(k0 + kk) * N + n0 + (lane & 31)]; }
    LDS_WAIT(); asm volatile("" ::: "memory");
    const int c = lane & 7;
#pragma unroll
    for (int j = 0; j < 4; ++j) { const int n = (lane >> 3) + 8 * j; const LAS float* s = scr + (8 * c) * 33 + n;
        v4u o; o.x = pk2(s[0 * 33], s[1 * 33]); o.y = pk2(s[2 * 33], s[3 * 33]); o.z = pk2(s[4 * 33], s[5 * 33]); o.w = pk2(s[6 * 33], s[7 * 33]);
        *(GAS v4u*)(WT + (size_t)(r0 + n) * K + k0 + 8 * c) = o; }
    LDS_WAIT(); asm volatile("" ::: "memory");
}
__device__ __forceinline__ void p0_fold_item(const float* Win, const float* PW, bf16* WT, LAS float* scr, int kb, int nb, int lane) {
    const int k0 = 64 * kb, n0 = 32 * nb, g = n0 >> 6, kh = lane >> 5, n = lane & 31;
    for (int kk = 0; kk < 64; ++kk) scr[kk * 64 + lane] = Win[(size_t)(k0 + kk) * NIN + g * 64 + lane];
    LDS_WAIT(); asm volatile("" ::: "memory");
    float acc[32];
#pragma unroll
    for (int i = 0; i < 32; ++i) acc[i] = 0.f;
    const float* pw = PW + (size_t)g * 4096 + (n0 & 63) + n;
#pragma unroll 1
    for (int c4 = 0; c4 < 16; ++c4) {
        const float p0 = pw[(4 * c4) * 64], p1 = pw[(4 * c4 + 1) * 64], p2 = pw[(4 * c4 + 2) * 64], p3 = pw[(4 * c4 + 3) * 64];
#pragma unroll
        for (int i = 0; i < 32; ++i) { const f32x4 a = *(const LAS f32x4*)(scr + (32 * kh + i) * 64 + 4 * c4); acc[i] += (a.x * p0 + a.y * p1) + (a.z * p2 + a.w * p3); }
    }
    bf16* op = WT + (size_t)(n0 + n) * DM + k0 + 32 * kh;
#pragma unroll
    for (int q = 0; q < 4; ++q) *(GAS v4u*)(op + 8 * q) = (v4u){pk2(acc[8 * q], acc[8 * q + 1]), pk2(acc[8 * q + 2], acc[8 * q + 3]), pk2(acc[8 * q + 4], acc[8 * q + 5]), pk2(acc[8 * q + 6], acc[8 * q + 7])};
    LDS_WAIT(); asm volatile("" ::: "memory");
}
__device__ __forceinline__ void p0_mods_item(const KArgs& A, float* mods, int item, int lane) {
    const int l = item / 576, r = item % 576, kc = r / 36, cb = r % 36;
    const float* W = A.in[I_ADAW] + (size_t)l * DM * 9216 + (size_t)(kc * 64) * 9216 + cb * 256 + lane * 4;
    const int k = kc * 64 + lane;
    const float s0 = silu_acc(A.in[I_CCTX][k]), s1 = silu_acc(A.in[I_C][k]), s2 = silu_acc(A.in[I_C][DM + k]);
    f32x4 a0 = {0.f, 0.f, 0.f, 0.f}, a1 = a0, a2 = a0;
#pragma unroll 8
    for (int kk = 0; kk < 64; ++kk) {
        const f32x4 w = *(const f32x4*)(W + (size_t)kk * 9216);
        const float c0 = __builtin_bit_cast(float, __builtin_amdgcn_readlane(__builtin_bit_cast(int, s0), kk));
        const float c1 = __builtin_bit_cast(float, __builtin_amdgcn_readlane(__builtin_bit_cast(int, s1), kk));
        const float c2 = __builtin_bit_cast(float, __builtin_amdgcn_readlane(__builtin_bit_cast(int, s2), kk));
        a0 += w * c0; a1 += w * c1; a2 += w * c2;
    }
    if (kc == 0) { const f32x4 b = *(const f32x4*)(A.in[I_ADAB] + (size_t)l * 9216 + cb * 256 + lane * 4); a0 += b; a1 += b; a2 += b; }
    float* mp = mods + (size_t)l * 3 * 9216 + cb * 256 + lane * 4;
#pragma unroll
    for (int i = 0; i < 4; ++i) { atomicAdd(mp + i, a0[i]); atomicAdd(mp + 9216 + i, a1[i]); atomicAdd(mp + 2 * 9216 + i, a2[i]); }
}
__device__ __forceinline__ void p0_tw_item(bf16* TW, int L, int item, int lane) {
    const int nks = L / 16, ks = item % nks, kh = (item / nks) & 1, rt = item / (2 * nks), k = 32 * rt + (lane & 31), h = lane >> 5;
    unsigned w[4];
#pragma unroll
    for (int i = 0; i < 4; ++i) { float v[2];
#pragma unroll
        for (int e = 0; e < 2; ++e) { const int j = 2 * i + e, kk = 16 * ks + 8 * (j >> 2) + 4 * h + (j & 3); const int ang = (k * kk) & (L - 1);
            float sn, cs; sincospif(2.0f * (float)ang / (float)L, &sn, &cs); v[e] = kh ? sn : cs; }
        w[i] = pk2(v[0], v[1]); }
    *(GAS v4u*)(TW + (size_t)item * 512 + lane * 8) = (v4u){w[0], w[1], w[2], w[3]};
}
__device__ __forceinline__ void p0_wcs_item(const KArgs& A, bf16* WCS, int item, int lane) {
    const int lg = item >> 7, n = item & 127, d = n & 63; const bool sn = n >= 64;
    const float* Wf = A.in[I_FNETW] + (size_t)lg * 4096 + d;
    float acc = 0.f;
    for (int m = 0; m < 64; ++m) { float s, c; sincospif(2.0f * (float)((m * lane) & 63) / 64.0f, &s, &c); acc += (sn ? -s : c) * Wf[m * 64]; }
    WCS[(size_t)item * 64 + lane] = (bf16)f2bf(acc);
}
__device__ __forceinline__ void p0_misc_item(const KArgs& A, float* rope, float* scal, int lane) {
    for (int e = lane; e < 1024; e += 64) { const int pos = e >> 4, i = e & 15; const float inv = 1.0f / powf(10000.0f, (float)(2 * i) / 32.0f); const float ang = (float)pos * inv;
        rope[e] = cosf(ang); rope[1024 + e] = sinf(ang); }
#pragma unroll
    for (int l = 0; l < 2; ++l) {
        const float d1 = wave_sum(A.in[I_LQ1][l * 64 + lane] * A.in[I_LK1][l * 64 + lane]), d2 = wave_sum(A.in[I_LQ2][l * 64 + lane] * A.in[I_LK2][l * 64 + lane]);
        const float lam_init = 0.8f - 0.6f * expf(-0.3f * (float)l);
        if (lane == 0) scal[l] = expf(d1) - expf(d2) + lam_init;
    }
}
constexpr int IT_MODS = 2 * 16 * 36, IT_TWI = (DM / 64) * (NWI / 32), IT_TWO = (FF / 64) * (DM / 32), IT_TWIN = (DM / 64) * (NIN / 32), IT_TWOUT = (DM / 64) * (DM / 32);
constexpr int IT_TRL = 2 * IT_TWI + 2 * IT_TWO + IT_TWIN + IT_TWOUT;
constexpr int IT_TW1024 = 32 * 2 * 64, IT_TW256 = 8 * 2 * 16, IT_WCS = 2 * 4 * 128;
constexpr int P0_ITEMS = IT_MODS + 2 * IT_TRL + IT_TW1024 + IT_TW256 + IT_WCS + 1;
__device__ __forceinline__ void p0_prologue(const KArgs& A, LAS unsigned char* lds, int gw, int NGW, int wave, int lane, bool skip_mods = false) {
    LAS float* scr = (LAS float*)(lds + wave * 16384);
    unsigned char* ws = A.ws;
    float* mods = (float*)(ws + WS_CTL) + CW_MODS;
    for (int it = gw; it < P0_ITEMS; it += NGW) {
        int r = it;
        if (r < IT_MODS) { if (!skip_mods) p0_mods_item(A, mods, r, lane); continue; } r -= IT_MODS;
        if (r < 2 * IT_TRL) { const int l = r / IT_TRL; r %= IT_TRL; unsigned char* wl = ws + WS_W + (size_t)l * SZ_WLAYER;
            if (r < IT_TWI) { p0_transpose_item(A.in[I_F1WI] + (size_t)l * DM * NWI, DM, NWI, (bf16*)(wl + OFF_WI1), true, scr, r, lane); continue; } r -= IT_TWI;
            if (r < IT_TWO) { p0_transpose_item(A.in[I_F1WO] + (size_t)l * FF * DM, FF, DM, (bf16*)(wl + OFF_WO1), false, scr, r, lane); continue; } r -= IT_TWO;
            if (r < IT_TWI) { p0_transpose_item(A.in[I_F2WI] + (size_t)l * DM * NWI, DM, NWI, (bf16*)(wl + OFF_WI2), true, scr, r, lane); continue; } r -= IT_TWI;
            if (r < IT_TWO) { p0_transpose_item(A.in[I_F2WO] + (size_t)l * FF * DM, FF, DM, (bf16*)(wl + OFF_WO2), false, scr, r, lane); continue; } r -= IT_TWO;
            if (r < IT_TWIN) { const int nblk = NIN / 32, kb = r / nblk, nb = r % nblk;
                if (nb < 8) p0_fold_item(A.in[I_WIN] + (size_t)l * DM * NIN, A.in[I_POOLW] + (size_t)l * 4 * 4096, (bf16*)(wl + OFF_WIN), scr, kb, nb, lane);
                else p0_transpose_item(A.in[I_WIN] + (size_t)l * DM * NIN, DM, NIN, (bf16*)(wl + OFF_WIN), false, scr, r, lane);
                continue; } r -= IT_TWIN;
            p0_transpose_item(A.in[I_WOUT] + (size_t)l * DM * DM, DM, DM, (bf16*)(wl + OFF_WOUT), false, scr, r, lane); continue; }
        r -= 2 * IT_TRL;
        if (r < IT_TW1024) { p0_tw_item((bf16*)(ws + WS_TW1024), 1024, r, lane); continue; } r -= IT_TW1024;
        if (r < IT_TW256) { p0_tw_item((bf16*)(ws + WS_TW256), 256, r, lane); continue; } r -= IT_TW256;
        if (r < IT_WCS) { p0_wcs_item(A, (bf16*)(ws + WS_WCS), r, lane); continue; }
        p0_misc_item(A, (float*)(ws + WS_ROPE), (float*)(ws + WS_SCAL), lane);
    }
}
__device__ __forceinline__ void norm_phase(const float* x0, const float* x1, bf16* XN, const float* g, const float* mods_l, int sub, int gw, int NGW, int lane) {
    for (int m = gw; m < M_TOK; m += NGW) {
        const float* xrow = m < M_CTX ? x0 + (size_t)m * DM : x1 + (size_t)(m - M_CTX) * DM;
        const int set = m < M_CTX ? 0 : 1 + ((m - M_CTX) >> 10);
        const float* shift = mods_l + (size_t)(set * 9 + 3 * sub) * DM; const float* scale = shift + DM;
        const GAS f32x4* xr = (const GAS f32x4*)xrow + lane;
        f32x4 v[4]; float ss = 0.f;
#pragma unroll
        for (int j = 0; j < 4; ++j) { v[j] = xr[64 * j]; ss += (v[j].x * v[j].x + v[j].y * v[j].y) + (v[j].z * v[j].z + v[j].w * v[j].w); }
        const float rstd = 1.0f / sqrtf(wave_sum(ss) * (1.0f / DM) + EPS);
        GAS unsigned long long* o8 = (GAS unsigned long long*)(XN + (size_t)m * DM) + lane;
#pragma unroll
        for (int j = 0; j < 4; ++j) { const f32x4 gg = *((const f32x4*)g + 64 * j + lane), sc = *((const f32x4*)scale + 64 * j + lane), sh = *((const f32x4*)shift + 64 * j + lane);
            const f32x4 h = (v[j] * rstd) * gg * (sc + 1.0f) + sh;
            o8[64 * j] = (unsigned long long)pk2(h.x, h.y) | ((unsigned long long)pk2(h.z, h.w) << 32); }
    }
}
__device__ __forceinline__ float prep_qk_lane(const bool ISK, const KArgs& A, int l, const bf16* src, bool lat, int t, int seq, int g, const float* rope, bf16* dstF, float* kout) {
    float x[64];
    { v4u w[8];
#pragma unroll
      for (int p = 0; p < 8; ++p) w[p] = *(const GAS v4u*)(src + p * 8);
#pragma unroll
      for (int p = 0; p < 8; ++p) { const unsigned ww[4] = {w[p].x, w[p].y, w[p].z, w[p].w};
#pragma unroll
          for (int i = 0; i < 4; ++i) { x[8 * p + 2 * i] = bf2f(ww[i] & 0xffffu); x[8 * p + 2 * i + 1] = bf2f(ww[i] >> 16); } } }
    float ss = 0.f;
#pragma unroll
    for (int i = 0; i < 64; ++i) ss += x[i] * x[i];
    const float rs = 1.0f / sqrtf(ss * (1.0f / 64.0f) + EPS);
    const float* gg = A.in[ISK ? I_KG : I_QG] + l * 64;
#pragma unroll
    for (int i = 0; i < 16; ++i) { const f32x4 gv = *(const f32x4*)(gg + 4 * i); x[4 * i] *= rs * gv.x; x[4 * i + 1] *= rs * gv.y; x[4 * i + 2] *= rs * gv.z; x[4 * i + 3] *= rs * gv.w; }
    if (lat) {
#pragma unroll
        for (int hb = 0; hb < 2; ++hb) {
            const int pos = hb ? (t & 63) : (t >> 6); const float* cs = rope + pos * 16; const float* sn = cs + 1024;
#pragma unroll
            for (int i = 0; i < 4; ++i) { const f32x4 c4 = *(const f32x4*)(cs + 4 * i), s4 = *(const f32x4*)(sn + 4 * i); const float cc[4] = {c4.x, c4.y, c4.z, c4.w}, sv[4] = {s4.x, s4.y, s4.z, s4.w};
#pragma unroll
                for (int e = 0; e < 4; ++e) { const int d = 32 * hb + 4 * i + e; const float x1 = x[d], x2 = x[d + 16]; x[d] = x1 * cc[e] - x2 * sv[e]; x[d + 16] = x2 * cc[e] + x1 * sv[e]; } }
        }
    }
    float nn = 0.f;
    if (!ISK) {
#pragma unroll
        for (int i = 0; i < 64; ++i) x[i] *= 0.125f * 1.4426950408889634f; }
#pragma unroll
    for (int i = 0; i < 64; ++i) nn += x[i] * x[i];
#pragma unroll
    for (int p = 0; p < 8; ++p) *(GAS v4u*)(dstF + ((p >> 1) * 64 + (p & 1) * 32) * 8) = (v4u){pk2(x[8 * p], x[8 * p + 1]), pk2(x[8 * p + 2], x[8 * p + 3]), pk2(x[8 * p + 4], x[8 * p + 5]), pk2(x[8 * p + 6], x[8 * p + 7])};
    if (ISK && kout) {
#pragma unroll
        for (int i = 0; i < 16; ++i) *(f32x4*)(kout + 4 * i) = (f32x4){x[4 * i], x[4 * i + 1], x[4 * i + 2], x[4 * i + 3]}; }
    return nn;
}
__device__ __forceinline__ void prep_token_batch(const KArgs& A, int l, int row0, int lane, const bf16* U, bf16* QB, bf16* KB, float* QN, unsigned* kmax, const float* rope) {
    const int r = lane >> 3, g = lane & 7, row = row0 + r;
    const bool lat = row0 >= M_CTX;
    const int t = (lat ? (row0 - M_CTX) & 1023 : row0 & 255) + r;
    const int seq = lat ? 32 + ((row0 - M_CTX) >> 10) : row0 >> 8;
    const int key = lat ? 256 + t : t;
    const size_t qchunk = lat ? 2048 + (size_t)((seq - 32) * 8 + g) * 32 + (t >> 5) : (size_t)(seq * 8 + g) * 8 + (t >> 5);
    const size_t kchunk = lat ? 2048 + (size_t)((seq - 32) * 8 + g) * 40 + (key >> 5) : (size_t)(seq * 8 + g) * 8 + (key >> 5);
    float nk = 0.f;
#pragma unroll 1
    for (int isk = 0; isk < 2; ++isk) {
        const bf16* src = U + (size_t)row * NIN + (isk ? 1024 : 512) + g * 64;
        bf16* dst = isk ? KB + kchunk * 2048 + (key & 31) * 8 : QB + qchunk * 2048 + (t & 31) * 8;
        float* kout = (isk && !lat) ? A.out + OUT_K + ((size_t)((row >> 8) * 2 + l) * 256 + t) * 512 + g * 64 : nullptr;
        const float nn = prep_qk_lane(isk != 0, A, l, src, lat, t, seq, g, rope, dst, kout);
        if (isk) nk = nn; else QN[(size_t)row * 8 + g] = sqrtf(nn) * 1.01f;
    }
    nk = fmaxf(nk, __shfl_xor(nk, 8)); nk = fmaxf(nk, __shfl_xor(nk, 16)); nk = fmaxf(nk, __shfl_xor(nk, 32));
    if (r == 0) atomicMax(kmax + seq * 8 + g, __builtin_bit_cast(unsigned, sqrtf(nk) * 1.01f));
}
__device__ __forceinline__ void prep_cachek_batch(const KArgs& A, int l, int item, int lane, bf16* KB, unsigned* kmax) {
    const int b = item >> 5, r = lane >> 3, g = lane & 7, jrow = (item & 31) * 8 + r;
    const float* src = A.in[I_CK] + ((size_t)(b * 2 + l) * 256 + jrow) * 512 + g * 64;
    f32x4 w[16];
#pragma unroll
    for (int i = 0; i < 16; ++i) w[i] = *(const f32x4*)(src + 4 * i);
    float nk = 0.f;
#pragma unroll
    for (int i = 0; i < 16; ++i) nk += (w[i].x * w[i].x + w[i].y * w[i].y) + (w[i].z * w[i].z + w[i].w * w[i].w);
    bf16* dst = KB + (2048 + (size_t)(b * 8 + g) * 40 + (jrow >> 5)) * 2048 + (jrow & 31) * 8;
#pragma unroll
    for (int p = 0; p < 8; ++p) *(GAS v4u*)(dst + ((p >> 1) * 64 + (p & 1) * 32) * 8) = (v4u){pk2(w[2 * p].x, w[2 * p].y), pk2(w[2 * p].z, w[2 * p].w), pk2(w[2 * p + 1].x, w[2 * p + 1].y), pk2(w[2 * p + 1].z, w[2 * p + 1].w)};
    nk = fmaxf(nk, __shfl_xor(nk, 8)); nk = fmaxf(nk, __shfl_xor(nk, 16)); nk = fmaxf(nk, __shfl_xor(nk, 32));
    if (r == 0) atomicMax(kmax + (32 + b) * 8 + g, __builtin_bit_cast(unsigned, sqrtf(nk) * 1.01f));
}
__device__ __forceinline__ void prep_vt_item(const KArgs& A, int l, int kind, int item, int lane, const bf16* U, bf16* VF, LAS unsigned char* scr) {
    LAS bf16* T = (LAS bf16*)scr;
    const int ch = item & (kind == 1 ? 31 : 7), sh = item >> (kind == 1 ? 5 : 3), h = sh & 3, s = sh >> 2;
    const size_t chunk = kind == 0 ? (size_t)(s * 4 + h) * 8 + ch : 1024 + (size_t)(s * 4 + h) * 40 + (kind == 1 ? 8 + ch : ch);
    const int kr = lane >> 4, dc = (lane & 15) * 8;
    if (kind < 2) { const int row0 = (kind == 0 ? s * 256 : M_CTX + s * 1024) + ch * 32;
        v4u w[8];
#pragma unroll
        for (int i = 0; i < 8; ++i) w[i] = *(const GAS v4u*)(U + (size_t)(row0 + 4 * i + kr) * NIN + 1536 + h * 128 + dc);
#pragma unroll
        for (int i = 0; i < 8; ++i) *(LAS v4u*)(T + (4 * i + kr) * 128 + dc) = w[i];
    } else { const float* src = A.in[I_CV] + ((size_t)(s * 2 + l) * 256 + ch * 32) * 512 + h * 128 + dc;
        f32x4 w0[8], w1[8];
#pragma unroll
        for (int i = 0; i < 8; ++i) { w0[i] = *(const f32x4*)(src + (size_t)(4 * i + kr) * 512); w1[i] = *(const f32x4*)(src + (size_t)(4 * i + kr) * 512 + 4); }
#pragma unroll
        for (int i = 0; i < 8; ++i) *(LAS v4u*)(T + (4 * i + kr) * 128 + dc) = (v4u){pk2(w0[i].x, w0[i].y), pk2(w0[i].z, w0[i].w), pk2(w1[i].x, w1[i].y), pk2(w1[i].z, w1[i].w)}; }
    LDS_WAIT(); asm volatile("" ::: "memory");
    const int r32 = lane & 31, hi = lane >> 5;
#pragma unroll
    for (int it = 0; it < 8; ++it) { const int s2 = it >> 2, d = it & 3; const LAS bf16* tp = T + (16 * s2 + 4 * hi) * 128 + d * 32 + r32;
        unsigned e[8];
#pragma unroll
        for (int jj = 0; jj < 8; ++jj) e[jj] = tp[(8 * (jj >> 2) + (jj & 3)) * 128];
        *(GAS v4u*)(VF + chunk * 4096 + (size_t)(it * 64 + lane) * 8) = (v4u){e[0] | (e[1] << 16), e[2] | (e[3] << 16), e[4] | (e[5] << 16), e[6] | (e[7] << 16)}; }
    LDS_WAIT(); asm volatile("" ::: "memory");
}
__device__ __forceinline__ void prep_yt_item(int l, int item, int lane, const bf16* U, const bf16* WCS, bf16* YTC, bf16* YTL) {
    const int g = item & 3, rb = item >> 2, row0 = rb * 32, r32 = lane & 31, hi = lane >> 5;
    bf16* Y; int L, lp0;
    if (row0 < M_CTX) { L = 256; lp0 = row0 & 255; Y = YTC + (size_t)(((row0 >> 8) * 4 + g) * 128) * 256; }
    else { L = 1024; lp0 = (row0 - M_CTX) & 1023; Y = YTL + (size_t)((((row0 - M_CTX) >> 10) * 4 + g) * 128) * 1024; }
    const bf16* xp = U + (size_t)(row0 + r32) * NIN + 256 + g * 64 + hi * 8;
    const bf16* wp = WCS + (size_t)((l * 4 + g) * 128 + r32) * 64 + hi * 8;
    bf16x8 xa[4];
#pragma unroll
    for (int ks = 0; ks < 4; ++ks) xa[ks] = *(const GAS bf16x8*)(xp + ks * 16);
    bf16x8 wb[4][4];
#pragma unroll
    for (int nb = 0; nb < 4; ++nb)
#pragma unroll
        for (int ks = 0; ks < 4; ++ks) wb[nb][ks] = *(const GAS bf16x8*)(wp + (size_t)nb * 32 * 64 + ks * 16);
#pragma unroll
    for (int nb = 0; nb < 4; ++nb) { f32x16 acc = {};
#pragma unroll
        for (int ks = 0; ks < 4; ++ks) acc = __builtin_amdgcn_mfma_f32_32x32x16_bf16(xa[ks], wb[nb][ks], acc, 0, 0, 0);
#pragma unroll
        for (int s2 = 0; s2 < 2; ++s2)
            *(GAS v4u*)(Y + ((size_t)nb * (L >> 4) + (lp0 >> 4) + s2) * 512 + lane * 8) =
                (v4u){pk2(acc[8 * s2], acc[8 * s2 + 1]), pk2(acc[8 * s2 + 2], acc[8 * s2 + 3]), pk2(acc[8 * s2 + 4], acc[8 * s2 + 5]), pk2(acc[8 * s2 + 6], acc[8 * s2 + 7])}; }
}
constexpr int PR_TOK = M_TOK / 8, PR_CK = 512 / 8, PR_VT0 = 32 * 4 * 8, PR_VT1 = 2 * 4 * 32, PR_VT2 = 2 * 4 * 8, PR_YT = (M_TOK / 32) * 4;
constexpr int PR_ITEMS = PR_TOK + PR_CK + PR_VT0 + PR_VT1 + PR_VT2 + PR_YT;
__device__ __forceinline__ void prep_phase(const KArgs& A, int l, LAS unsigned char* lds, int gw, int NGW, int wave, int lane, int sel = 15) {
    asm volatile("" : "+v"(lane));
    unsigned char* ws = A.ws;
    const bf16* U = (const bf16*)(ws + WS_U); bf16* QB = (bf16*)(ws + WS_QB); bf16* KB = (bf16*)(ws + WS_KB);
    float* QN = (float*)(ws + WS_QN); unsigned* kmax = (unsigned*)(ws + WS_CTL) + CW_KMAX + l * NSEQ * 8; const float* rope = (const float*)(ws + WS_ROPE);
    LAS unsigned char* scr = lds + wave * 16384;
#pragma unroll 1
    for (int it = gw; it < PR_ITEMS; it += NGW) {
        asm volatile("" : "+v"(lane));
        int r = it;
        if (r < PR_TOK) { if (sel & 1) prep_token_batch(A, l, r * 8, lane, U, QB, KB, QN, kmax, rope); continue; } r -= PR_TOK;
        if (r < PR_YT) { if (sel & 2) prep_yt_item(l, r, lane, U, (const bf16*)(ws + WS_WCS), (bf16*)(ws + WS_YTC), (bf16*)(ws + WS_YTL)); continue; } r -= PR_YT;
        if (r < PR_VT0) { if (sel & 4) prep_vt_item(A, l, 0, r, lane, U, (bf16*)(ws + WS_VTC), scr); continue; } r -= PR_VT0;
        if (r < PR_VT1) { if (sel & 4) prep_vt_item(A, l, 1, r, lane, U, (bf16*)(ws + WS_VTC), scr); continue; } r -= PR_VT1;
        if (r < PR_VT2) { if (sel & 4) prep_vt_item(A, l, 2, r, lane, U, (bf16*)(ws + WS_VTC), scr); continue; } r -= PR_VT2;
        if (sel & 8) prep_cachek_batch(A, l, r, lane, KB, kmax);
    }
}
#define WG_BAR() do { asm volatile("s_waitcnt vmcnt(0) lgkmcnt(0)" ::: "memory"); __builtin_amdgcn_s_barrier(); asm volatile("" ::: "memory"); } while (0)
__device__ __forceinline__ void lds_fadd(LAS float* p, float v) { (void)__hip_atomic_fetch_add(p, v, __ATOMIC_RELAXED, __HIP_MEMORY_SCOPE_WORKGROUP); }
#define ATT_LOADK(dst, kp_) do { _Pragma("unroll") for (int ds_ = 0; ds_ < 4; ++ds_) dst[ds_] = *(const GAS bf16x8*)((kp_) + ds_ * 512); } while (0)
#define ATT_LOADV(dst, vp_) do { _Pragma("unroll") for (int i_ = 0; i_ < 8; ++i_) dst[i_] = *(const GAS bf16x8*)((vp_) + i_ * 512); } while (0)
#define ATT_QK(kf_) f32x16 S_; do { _Pragma("unroll") for (int r_ = 0; r_ < 16; ++r_) S_[r_] = nm; \
        _Pragma("unroll") for (int ds_ = 0; ds_ < 4; ++ds_) S_ = __builtin_amdgcn_mfma_f32_32x32x16_bf16(kf_[ds_], qf[ds_], S_, 0, 0, 0); } while (0)
#define ATT_PV(vf_) do { bf16x8 pa_[2]; \
        _Pragma("unroll") for (int s2_ = 0; s2_ < 2; ++s2_) { unsigned w_[4]; \
            _Pragma("unroll") for (int i_ = 0; i_ < 4; ++i_) { const float a_ = __builtin_amdgcn_exp2f(S_[8 * s2_ + 2 * i_]), b_ = __builtin_amdgcn_exp2f(S_[8 * s2_ + 2 * i_ + 1]); lsum += a_ + b_; w_[i_] = pk2(a_, b_); } \
            pa_[s2_] = __builtin_bit_cast(bf16x8, (v4u){w_[0], w_[1], w_[2], w_[3]}); } \
        _Pragma("unroll") for (int s2_ = 0; s2_ < 2; ++s2_) _Pragma("unroll") for (int d_ = 0; d_ < 4; ++d_) O[d_] = __builtin_amdgcn_mfma_f32_32x32x16_bf16(pa_[s2_], vf_[s2_ * 4 + d_], O[d_], 0, 0, 0); } while (0)
constexpr int LX_OFF = RING_BYTES + 1024;
__device__ __forceinline__ void attn_unit(const KArgs& A, int l, int seq, int h, int qb, LAS unsigned char* lds, int tid, int wave, int lane) {
    asm volatile("" : "+v"(tid), "+v"(lane));
    unsigned char* ws = A.ws; asm volatile("" : "+s"(ws));
    const bf16* QF = (const bf16*)(ws + WS_QB); const bf16* KF = (const bf16*)(ws + WS_KB); const bf16* VF = (const bf16*)(ws + WS_VTC); const float* QN = (const float*)(ws + WS_QN);
    const unsigned* kmax = (const unsigned*)(ws + WS_CTL) + CW_KMAX + l * NSEQ * 8;
    const bool lat = seq >= 32;
    const int qrow0 = lat ? M_CTX + (seq - 32) * 1024 + qb * 64 : seq * 256 + qb * 64;
    const int qs = wave & 1, ks = wave >> 1, r32 = lane & 31, hi = lane >> 5;
    const int nt = lat ? 10 : 2;
    const int qrow = qrow0 + qs * 32 + r32;
    LAS float* PO = (LAS float*)lds + wave * 4096;
    LAS float* PL = (LAS float*)(lds + LX_OFF);
    float acc[16];
#pragma unroll
    for (int i = 0; i < 16; ++i) acc[i] = 0.f;
    const float lam = ((const float*)(ws + WS_SCAL))[l];
#pragma unroll 1
    for (int c = 0; c < 2; ++c) {
        const size_t qchunk = lat ? 2048 + (size_t)((seq - 32) * 8 + h * 2 + c) * 32 + (qb * 2 + qs) : (size_t)(seq * 8 + h * 2 + c) * 8 + (qb * 2 + qs);
        const size_t kchunk = lat ? 2048 + (size_t)((seq - 32) * 8 + h * 2 + c) * 40 + ks * nt : (size_t)(seq * 8 + h * 2 + c) * 8 + ks * nt;
        const size_t vchunk = lat ? 1024 + (size_t)((seq - 32) * 4 + h) * 40 + ks * nt : (size_t)(seq * 4 + h) * 8 + ks * nt;
        const bf16* kp = KF + kchunk * 2048 + lane * 8; const bf16* vp = VF + vchunk * 4096 + lane * 8;
        bf16x8 qf[4], kf[4], vf[8];
        ATT_LOADK(qf, QF + qchunk * 2048 + lane * 8);
        ATT_LOADK(kf, kp); ATT_LOADV(vf, vp);
        const float nm = -QN[(size_t)qrow * 8 + h * 2 + c] * __builtin_bit_cast(float, kmax[seq * 8 + h * 2 + c]);
        f32x16 O[4];
#pragma unroll
        for (int d = 0; d < 4; ++d) O[d] = (f32x16){};
        float lsum = 0.f;
#pragma unroll 1
        for (int t = 0; t < nt; ++t) {
            ATT_QK(kf);
            __builtin_amdgcn_sched_barrier(0);
            if (t + 1 < nt) ATT_LOADK(kf, kp + (size_t)(t + 1) * 2048);
            ATT_PV(vf);
            __builtin_amdgcn_sched_barrier(0);
            if (t + 1 < nt) ATT_LOADV(vf, vp + (size_t)(t + 1) * 4096);
        }
        lsum += __shfl_xor(lsum, 32);
        if (hi == 0) PL[wave * 32 + r32] = lsum;
#pragma unroll
        for (int d = 0; d < 4; ++d)
#pragma unroll
            for (int r = 0; r < 16; ++r) { const int row = crow(r, hi); PO[row * 128 + ((d * 32 + r32) ^ ((row & 1) << 5))] = O[d][r]; }
        WG_BAR();
        {
            const int row = tid >> 3, a = tid & 7, q2 = row >> 5, r5 = row & 31;
            const float lt = (PL[(0 + q2) * 32 + r5] + PL[(2 + q2) * 32 + r5]) + (PL[(4 + q2) * 32 + r5] + PL[(6 + q2) * 32 + r5]);
            const float sc = c == 0 ? 1.0f / lt : -lam / lt;
#pragma unroll
            for (int i = 0; i < 4; ++i) { const int col = (32 * i + 4 * a) ^ ((r5 & 1) << 5);
                f32x4 v = *(const LAS f32x4*)((LAS float*)lds + (0 + q2) * 4096 + r5 * 128 + col);
                v += *(const LAS f32x4*)((LAS float*)lds + (2 + q2) * 4096 + r5 * 128 + col);
                v += *(const LAS f32x4*)((LAS float*)lds + (4 + q2) * 4096 + r5 * 128 + col);
                v += *(const LAS f32x4*)((LAS float*)lds + (6 + q2) * 4096 + r5 * 128 + col);
#pragma unroll
                for (int e = 0; e < 4; ++e) acc[4 * i + e] += v[e] * sc; }
        }
        WG_BAR();
    }
    {
        const int row = tid >> 3, a = tid & 7;
        const float lam_init = 0.8f - 0.6f * expf(-0.3f * (float)l);
        float ss = 0.f;
#pragma unroll
        for (int i = 0; i < 16; ++i) ss += acc[i] * acc[i];
#pragma unroll
        for (int of = 1; of < 8; of <<= 1) ss += __shfl_xor(ss, of);
        const float sc = (1.0f - lam_init) / sqrtf(ss * (1.0f / 128.0f) + EPS);
        const float* g = A.in[I_AOG] + l * 128 + 4 * a;
        bf16* mp = (bf16*)(ws + WS_MIX) + (size_t)(qrow0 + row) * DM + 512 + h * 128 + 4 * a;
#pragma unroll
        for (int i = 0; i < 4; ++i) { const f32x4 gv = *(const f32x4*)(g + 32 * i);
            *(GAS u32x2*)(mp + 32 * i) = (u32x2){pk2(acc[4 * i] * sc * gv[0], acc[4 * i + 1] * sc * gv[1]), pk2(acc[4 * i + 2] * sc * gv[2], acc[4 * i + 3] * sc * gv[3])}; }
    }
}
__device__ __forceinline__ void fourier_unit(const KArgs& A, int seq, int g, int rb, LAS unsigned char* lds, int tid, int wave, int lane) {
    asm volatile("" : "+v"(tid), "+v"(lane));
    unsigned char* ws = A.ws; asm volatile("" : "+s"(ws));
    const bool lat = seq >= 32; const int L = lat ? 1024 : 256, nks = L >> 4;
    const bf16* TW = lat ? (const bf16*)(ws + WS_TW1024) : (const bf16*)(ws + WS_TW256);
    const bf16* Y = lat ? (const bf16*)(ws + WS_YTL) + (size_t)(((seq - 32) * 4 + g) * 128) * 1024 : (const bf16*)(ws + WS_YTC) + (size_t)((seq * 4 + g) * 128) * 256;
    const int row0 = (lat ? M_CTX + (seq - 32) * 1024 : seq * 256) + rb * 128;
    const int rt = wave & 3, kh = wave >> 2, r32 = lane & 31, hi = lane >> 5;
    const bf16* ap = TW + ((size_t)((rb * 4 + rt) * 2 + kh) * nks) * 512 + lane * 8;
    const bf16* bp0 = Y + ((size_t)(kh * 2 + 0) * nks) * 512 + lane * 8;
    const bf16* bp1 = Y + ((size_t)(kh * 2 + 1) * nks) * 512 + lane * 8;
    f32x16 acc0 = {}, acc1 = {};
#pragma unroll 4
    for (int ks = 0; ks < nks; ++ks) { const bf16x8 a = *(const GAS bf16x8*)(ap + (size_t)ks * 512), b0 = *(const GAS bf16x8*)(bp0 + (size_t)ks * 512), b1 = *(const GAS bf16x8*)(bp1 + (size_t)ks * 512);
        acc0 = __builtin_amdgcn_mfma_f32_32x32x16_bf16(a, b0, acc0, 0, 0, 0); acc1 = __builtin_amdgcn_mfma_f32_32x32x16_bf16(a, b1, acc1, 0, 0, 0); }
    LAS float* C = (LAS float*)lds + rt * 2048;
    if (kh == 1) {
#pragma unroll
        for (int r = 0; r < 16; ++r) { C[crow(r, hi) * 64 + r32] = acc0[r]; C[crow(r, hi) * 64 + 32 + r32] = acc1[r]; } }
    WG_BAR();
    if (kh == 0) { const float s = lat ? (1.0f / 256.0f) : (1.0f / 128.0f);
        bf16* mp = (bf16*)(ws + WS_MIX) + (size_t)(row0 + rt * 32) * DM + 256 + g * 64 + r32;
#pragma unroll
        for (int r = 0; r < 16; ++r) { const int row = crow(r, hi);
            mp[(size_t)row * DM] = (bf16)f2bf((acc0[r] + C[row * 64 + r32]) * s); mp[(size_t)row * DM + 32] = (bf16)f2bf((acc1[r] + C[row * 64 + 32 + r32]) * s); } }
    WG_BAR();
}
template <int HALF> __device__ __forceinline__ void pool_item_g(const KArgs& A, int l, int chunk, int g, int lane, unsigned char* ws) {
    const bf16* U = (const bf16*)(ws + WS_U);
    const int row0 = chunk * 64;
    int sstart, L; if (row0 < M_CTX) { sstart = row0 & ~255; L = 256; } else { sstart = M_CTX + ((row0 - M_CTX) & ~1023); L = 1024; }
    const int sub = lane >> 4, c4 = (lane & 15) * 4, p0 = row0 - sstart + 16 * sub;
    constexpr int NR = 16 + 2 * HALF;
    f32x4 z[NR];
#pragma unroll
    for (int i = 0; i < NR; ++i) { const int pos = p0 - HALF + i; u32x2 w = {0u, 0u};
        if (pos >= 0 && pos < L) w = *(const GAS u32x2*)(U + (size_t)(sstart + pos) * NIN + g * 64 + c4);
        z[i] = (f32x4){bf2f(w.x & 0xffffu), bf2f(w.x >> 16), bf2f(w.y & 0xffffu), bf2f(w.y >> 16)}; }
    const f32x4 sc = *(const f32x4*)(A.in[I_POOLS] + l * 256 + g * 64 + c4);
    f32x4 run = {0.f, 0.f, 0.f, 0.f};
#pragma unroll
    for (int i = 0; i < 2 * HALF; ++i) run += z[i];
    bf16* mp = (bf16*)(ws + WS_MIX) + (size_t)(sstart + p0) * DM + g * 64 + c4;
#pragma unroll
    for (int t = 0; t < 16; ++t) { const int pos = p0 + t; const int cnt = min(pos + HALF, L) - max(pos - HALF, 0);
        const f32x4 y = (run * (1.0f / (float)cnt) - z[t + HALF]) * sc;
        *(GAS u32x2*)(mp + (size_t)t * DM) = (u32x2){pk2(y.x, y.y), pk2(y.z, y.w)};
        if (t < 15) run += z[t + 2 * HALF] - z[t]; }
}
__device__ __forceinline__ void pool_item(const KArgs& A, int l, int item, int lane) {
    asm volatile("" : "+v"(lane));
    unsigned char* ws = A.ws; asm volatile("" : "+s"(ws));
    const int g = item & 3, chunk = item >> 2;
    if (g == 0) pool_item_g<1>(A, l, chunk, 0, lane, ws); else if (g == 1) pool_item_g<2>(A, l, chunk, 1, lane, ws);
    else if (g == 2) pool_item_g<4>(A, l, chunk, 2, lane, ws); else pool_item_g<8>(A, l, chunk, 3, lane, ws);
}
constexpr int MX_LATT = 2 * 4 * 16, MX_CATT = 32 * 4 * 4, MX_LFOU = 2 * 4 * 8, MX_CFOU = 32 * 4 * 2, MX_POOL = (M_TOK / 64) * 4;
__device__ __forceinline__ void mix_phase(const KArgs& A, int l, LAS unsigned char* lds, int vcu, int G, int tid, int wave, int lane, int sel = 31) {
    if (sel & 5) {
#pragma unroll 1
        for (int it = vcu; it < MX_LATT + MX_CATT; it += G) {
            const bool isl = it < MX_LATT; const int r = it - MX_LATT;
            const int seq = isl ? 32 + (it >> 6) : r >> 4, hh = isl ? (it >> 4) & 3 : (r >> 2) & 3, qb = isl ? it & 15 : r & 3;
            if (sel & (isl ? 1 : 4)) attn_unit(A, l, seq, hh, qb, lds, tid, wave, lane);
        }
    }
    constexpr int O1 = MX_LATT + MX_CATT;
    if (sel & 10) {
#pragma unroll 1
        for (int it = ((vcu - O1) % G + G) % G; it < MX_LFOU + MX_CFOU; it += G) {
            const bool isl = it < MX_LFOU; const int r = it - MX_LFOU;
            const int seq = isl ? 32 + (it >> 5) : r >> 3, gg = isl ? (it >> 3) & 3 : (r >> 1) & 3, rb = isl ? it & 7 : r & 1;
            if (sel & (isl ? 2 : 8)) fourier_unit(A, seq, gg, rb, lds, tid, wave, lane);
        }
    }
    constexpr int O2 = O1 + MX_LFOU + MX_CFOU;
    if (sel & 16) {
        const int gw2 = (((vcu - O2) % G + G) % G) * NWAVES + wave;
#pragma unroll 1
        for (int it = gw2; it < MX_POOL; it += G * NWAVES) pool_item(A, l, it, lane);
    }
}
#define CAS __attribute__((address_space(4)))
#ifndef PROBE_KIND
#define PROBE_KIND -1
#endif
#ifndef PROBE_SEL
#define PROBE_SEL 31
#endif
#ifndef PROBE_N
#define PROBE_N 1
#endif
constexpr bool probe_match(int P, int kind) {
    if (kind < 0) return false;
    if (kind == 7) return P < NPHASES - 1;
    if (P == 0) return kind == 0;
    const int l = (P - 1) / 11, k = (P - 1) % 11;
    if (kind == 1) return k == 0 || k == 3 || k == 8;
    if (kind == 2) return k == 1 || k == 9;
    if (kind == 3) return k == 2 && l == 0;
    if (kind == 4) return k == 4;
    if (kind == 5) return k == 5;
    if (kind == 6) return k == 6;
    return false;
}
template <int PH> __device__ __forceinline__ void run_phase(const bool DUP, const KArgs& A, LAS unsigned char* lds, int tid, int lane, int wave, int G, int bx, int vcu, int gw, int NGW) {
    unsigned char* ws = A.ws;
    float* X = A.out;
    const float* mods = (const float*)(ws + WS_CTL) + CW_MODS;
    bf16* XN = (bf16*)(ws + WS_XN); bf16* GBUF = (bf16*)(ws + WS_GB); bf16* UB = (bf16*)(ws + WS_U); bf16* MIXB = (bf16*)(ws + WS_MIX);
    if constexpr (PH == 0) {
#ifndef SKIP_P0
        p0_prologue(A, lds, gw, NGW, wave, lane, DUP);
#endif
    } else {
        constexpr int l = (PH - 1) / 11, k = (PH - 1) % 11;
        const float* mods_l = mods + (size_t)l * 3 * 9216;
        unsigned char* wl = ws + WS_W + (size_t)l * SZ_WLAYER;
        const float* ng = A.in[I_NG] + (size_t)l * 3 * DM;
        if constexpr (k == 0) { if (l == 0) norm_phase(A.in[I_XP], A.in[I_XS], XN, ng, mods_l, 0, gw, NGW, lane); else norm_phase(X, X + OUT_YS, XN, ng, mods_l, 0, gw, NGW, lane); }
        else if constexpr (k == 3) norm_phase(X, X + OUT_YS, XN, ng + DM, mods_l, 1, gw, NGW, lane);
        else if constexpr (k == 8) norm_phase(X, X + OUT_YS, XN, ng + 2 * DM, mods_l, 2, gw, NGW, lane);
        else if constexpr (k == 1 || k == 9) {
            pg8::Gemm g{XN, (const bf16*)(wl + (k == 1 ? OFF_WI1 : OFF_WI2)), M_TOK, NWI, DM}; pg8::StaticOrder S; S.init(M_TOK, NWI, G, bx);
            pg8::EpiSwiglu E{GBUF, FF};
            pg8::gemm_phase<pg8::EpiSwiglu, pg8::StaticOrder, true, true>(lds, g, S, E);
        } else if constexpr (k == 2 || k == 10) {
            pg8::Gemm g{GBUF, (const bf16*)(wl + (k == 2 ? OFF_WO1 : OFF_WO2)), M_TOK, DM, FF}; pg8::StaticOrder S; S.init(M_TOK, DM, G, bx, 160);
            constexpr bool first = (k == 2 && l == 0);
            pg8::EpiResGate<1> E{first ? A.in[I_XP] : X, first ? A.in[I_XS] : X + OUT_YS, X, mods_l, k == 2 ? 2 : 8, 0.5f};
            pg8::gemm_phase<pg8::EpiResGate<1>, pg8::StaticOrder, true, true, 1>(lds, g, S, E);
        } else if constexpr (k == 4) {
            pg8::Gemm g{XN, (const bf16*)(wl + OFF_WIN), M_TOK, NIN, DM}; pg8::StaticOrder S; S.init(M_TOK, NIN, G, bx, 160);
            pg8::EpiU<1> E{UB, A.out + OUT_V, l};
            pg8::gemm_phase<pg8::EpiU<1>, pg8::StaticOrder, true, true, 1>(lds, g, S, E);
        } else if constexpr (k == 5) {
#ifndef SKIP_PREP
            prep_phase(A, l, lds, gw, NGW, wave, lane, DUP ? PROBE_SEL : 15);
#endif
        } else if constexpr (k == 6) {
#ifndef SKIP_MIX
            mix_phase(A, l, lds, vcu, G, tid, wave, lane, DUP ? PROBE_SEL : 31);
#endif
        } else if constexpr (k == 7) {
            pg8::Gemm g{MIXB, (const bf16*)(wl + OFF_WOUT), M_TOK, DM, DM}; pg8::StaticOrder S; S.init(M_TOK, DM, G, bx, 160);
            pg8::EpiResGate<1> E{X, X + OUT_YS, X, mods_l, 5, 1.0f};
            pg8::gemm_phase<pg8::EpiResGate<1>, pg8::StaticOrder, true, true, 1>(lds, g, S, E);
        }
    }
}
__global__ void __launch_bounds__(NWAVES * 64, 2) hyb_fwd(KArgs A) {
    extern __shared__ __attribute__((aligned(16))) unsigned char lds_raw[];
    LAS unsigned char* lds = (LAS unsigned char*)lds_raw;
    volatile LAS unsigned* MISC = (volatile LAS unsigned*)(lds + MISC_OFF);
    const int tid = threadIdx.x, lane = tid & 63, wave = __builtin_amdgcn_readfirstlane(tid >> 6);
    const int G = gridDim.x, bx = blockIdx.x, vcu = (G % 8 == 0) ? (bx % 8) * (G / 8) + bx / 8 : bx;
    const int gw = vcu * NWAVES + wave, NGW = G * NWAVES;
    gu32* ctl = (gu32*)(A.ws + WS_CTL);
    for (int u = tid; u < (LDS_BYTES - LDSCTL_OFF) / 4; u += NWAVES * 64) ((LAS unsigned*)(lds + LDSCTL_OFF))[u] = 0u;
    __syncthreads();
    const int lo = A.ph_lo, hi = A.ph_hi;
    XcdBarrier bar; bar.bar = (unsigned*)(ctl + CW_BAR); bar.x = 0; bar.st = nullptr;
    if (hi - lo > 1) bar = xcd_barrier_post((unsigned*)(ctl + CW_BAR), MISC + 8);
#define PHASE(P) if (lo <= (P) && (P) < hi) { _Pragma("unroll 1") for (int rep_ = 0; rep_ < (probe_match(P, PROBE_KIND) ? 1 + PROBE_N : 1); ++rep_) { \
        if (PROBE_KIND != 7 || rep_ == 0) run_phase<P>(rep_ > 0, A, lds, tid, lane, wave, G, bx, vcu, gw, NGW); if ((P) + 1 < hi || rep_ + 1 < (probe_match(P, PROBE_KIND) ? 1 + PROBE_N : 1)) xcd_barrier(bar); } }
    PHASE(0) PHASE(1) PHASE(2) PHASE(3) PHASE(4) PHASE(5) PHASE(6) PHASE(7) PHASE(8) PHASE(9) PHASE(10) PHASE(11)
    PHASE(12) PHASE(13) PHASE(14) PHASE(15) PHASE(16) PHASE(17) PHASE(18) PHASE(19) PHASE(20) PHASE(21) PHASE(22)
#undef PHASE
}

#ifndef N_LAUNCH_MODE
#define N_LAUNCH_MODE 1
#endif
extern "C" void kernel_launch(void* const* d_in, const int* in_sizes, int n_in, void* d_out, int out_size, void* d_ws, size_t ws_size, hipStream_t stream) {
    static int grid = 0;
    if (grid == 0) {
        if (n_in != 25 || ws_size < WS_END) { fprintf(stderr, "kernel_launch: unexpected n_in %d / ws %zu\n", n_in, ws_size); grid = -1; return; }
        int dev = 0, cus = 0, per_cu = 0;
        if (hipGetDevice(&dev) != hipSuccess || hipDeviceGetAttribute(&cus, hipDeviceAttributeMultiprocessorCount, dev) != hipSuccess) { grid = -1; return; }
        if (hipFuncSetAttribute((const void*)hyb_fwd, hipFuncAttributeMaxDynamicSharedMemorySize, LDS_BYTES) != hipSuccess) { fprintf(stderr, "kernel_launch: hipFuncSetAttribute failed\n"); grid = -1; return; }
        if (hipOccupancyMaxActiveBlocksPerMultiprocessor(&per_cu, (const void*)hyb_fwd, NWAVES * 64, LDS_BYTES) != hipSuccess || per_cu < 1) { fprintf(stderr, "kernel_launch: occupancy query says %d blocks per CU\n", per_cu); }
        (void)hipGetLastError();
        grid = cus;
    }
    if (grid < 0) return;
    if (hipMemsetAsync((char*)d_ws + WS_CTL, 0, CTL_ZERO_BYTES, stream) != hipSuccess) return;
    KArgs a{};
    for (int i = 0; i < 25; ++i) a.in[i] = (const float*)d_in[i];
    a.out = (float*)d_out; a.ws = (unsigned char*)d_ws;
#if N_LAUNCH_MODE == 0
    for (int p = 0; p < NPHASES; ++p) { a.ph_lo = p; a.ph_hi = p + 1; hipLaunchKernelGGL(hyb_fwd, dim3(grid), dim3(NWAVES * 64), LDS_BYTES, stream, a); }
#else
    a.ph_lo = 0; a.ph_hi = NPHASES; hipLaunchKernelGGL(hyb_fwd, dim3(grid), dim3(NWAVES * 64), LDS_BYTES, stream, a);
#endif
}
```

```cpp
#include <hip/hip_runtime.h>
#include <cstdio>
#include <cstdint>
namespace pg8 {
#define PG8_LAS __attribute__((address_space(3)))
typedef unsigned short bf16_t;
typedef short bf16x8 __attribute__((ext_vector_type(8)));
typedef float f32x4 __attribute__((ext_vector_type(4)));
typedef unsigned u32x4 __attribute__((ext_vector_type(4)));
constexpr int BM = 256, BK = 64, HALF = 128, HTB = HALF * BK * 2  , STAGE_BYTES = 8 * HTB, NXCD = 8, WGM = 8;

__host__ __device__ __forceinline__ int lds_byte(int r, int c) { const int st = (r >> 4) * 2 + (c >> 5), rr = r & 15, cc = c & 31, ob = rr * 64 + cc * 2; return st * 1024 + (ob ^ (((ob >> 9) & 1) << 5)); }
__host__ __device__ __forceinline__ void stage_rc(int b, int& R, int& C) { const int st = b / 1024, sb = b % 1024, swz = sb ^ (((sb >> 9) & 1) << 5); R = (st >> 1) * 16 + swz / 64; C = (st & 1) * 32 + (swz % 64) / 2; }
__host__ __device__ __forceinline__ int perm32(int rho) { const int n = rho >> 4, i = rho & 15; return 8 * (i >> 2) + 4 * n + (i & 3); }

struct Unit { int pm, pn; };
struct Gemm { const bf16_t* A; const bf16_t* Bt; int M, N, K; };

struct StaticOrder {
    int nM, nN, nwg, G, c;
    __host__ __device__ void init(int M, int N, int G_, int c_, int TM = BM) { nM = M / TM; nN = N / BM; nwg = nM * nN; G = G_; c = c_; }
    __host__ __device__ bool next(int i, Unit& u) const {
        const long L = (long)i * G + c; if (L >= nwg) return false;
        int wgid = (int)L; { const int q = nwg / NXCD, r = nwg % NXCD, xcd = wgid % NXCD, off = wgid / NXCD; wgid = (xcd < r ? xcd * (q + 1) : r * (q + 1) + (xcd - r) * q) + off; }
        const int nig = WGM * nN, gid = wgid / nig, fm = gid * WGM, gsz = (nM - fm) < WGM ? (nM - fm) : WGM;
        u.pm = fm + ((wgid % nig) % gsz); u.pn = (wgid % nig) / gsz; return true;
    }
    __device__ __forceinline__ void a_ready(const Unit&) const {}
    __device__ __forceinline__ void done(const Unit&) const {}
};

__device__ __forceinline__ unsigned cvt_pk_bf16(float lo, float hi) { unsigned r; asm volatile("v_cvt_pk_bf16_f32 %0, %1, %2" : "=v"(r) : "v"(lo), "v"(hi)); return r; }
typedef float f32x2 __attribute__((ext_vector_type(2)));
template <class Epi, class Sched, bool ALIGN_EPI = false, bool SP2 = false, int M1 = 4>
__device__ __forceinline__ void gemm_phase(PG8_LAS unsigned char* lds, const Gemm g, const Sched& S, const Epi& E) {
    const int tid = threadIdx.x, wid = __builtin_amdgcn_readfirstlane(tid >> 6), lane = tid & 63, wr = wid >> 2, wc = wid & 3, fr = lane & 15, fq = lane >> 4;
    const int K = g.K, nt = K / BK;
    unsigned voffA[2], voffB[2];
#pragma unroll
    for (int i = 0; i < 2; ++i) { int R, C; stage_rc(tid * 16 + i * 8192, R, C); const int Rb = Epi::PERM ? ((R & ~31) + perm32(R & 31)) : R;
        voffA[i] = (unsigned)(R * K + C) * 2u; voffB[i] = (unsigned)(Rb * K + C) * 2u; }
    unsigned voffA1[2], ldsA1[2];
#pragma unroll
    for (int i = 0; i < 2; ++i) { if (M1 == 4) { voffA1[i] = voffA[i]; ldsA1[i] = (unsigned)wid * 1024u + i * 8192u; }
        else { int R, C; stage_rc((wid & 3) * 1024 + lane * 16, R, C); voffA1[i] = (unsigned)(R * K + C) * 2u; ldsA1[i] = (unsigned)(wid & 3) * 1024u; } }
    unsigned voffA1d; { int R, C; stage_rc((wid & 3) * 1024 + lane * 4, R, C); voffA1d = (unsigned)(R * K + C) * 2u; }
    const size_t kstep = (size_t)(BK * 2);
    const size_t hstep = (size_t)HALF * K * 2;
    const size_t tstep = 2 * hstep;
    const size_t tstepA = (size_t)(HALF + 32 * M1) * K * 2;
    const unsigned ldsw = (unsigned)wid * 1024u;
    const int aoff = lds_byte(wr * 64 + fr, fq * 8), boff = lds_byte(wc * 32 + fr, fq * 8), aoff1 = lds_byte(wr * 16 * M1 + fr, fq * 8);
#define PG8_SA(b, h) (((b) * 2 + (h)) * HTB)
#define PG8_SB(b, h) ((4 + (b) * 2 + (h)) * HTB)
#define PG8_STAGE(bufoff, gbase, voff) do { _Pragma("unroll") for (int _i = 0; _i < 2; ++_i) \
        __builtin_amdgcn_global_load_lds((const unsigned*)((const char*)(gbase) + (voff)[_i]), (PG8_LAS unsigned*)(lds + (bufoff) + ldsw + _i * 8192), 16, 0, 0); } while (0)
#define PG8_STAGE_A1(bufoff, gbase) do { if (M1 == 4) { _Pragma("unroll") for (int _i = 0; _i < 2; ++_i) \
        __builtin_amdgcn_global_load_lds((const unsigned*)((const char*)(gbase) + voffA1[_i]), (PG8_LAS unsigned*)(lds + (bufoff) + ldsA1[_i]), 16, 0, 0); } \
      else {   \
        if (wid < 4) __builtin_amdgcn_global_load_lds((const unsigned*)((const char*)(gbase) + voffA1[0]), (PG8_LAS unsigned*)(lds + (bufoff) + ldsA1[0]), 16, 0, 0); \
        else __builtin_amdgcn_global_load_lds((const unsigned*)((const char*)(gbase) + voffA1d), (PG8_LAS unsigned*)(lds + (bufoff) + ldsA1[0]), 4, 0, 0); \
        __builtin_amdgcn_global_load_lds((const unsigned*)((const char*)(gbase) + voffA1d), (PG8_LAS unsigned*)(lds + (bufoff) + ldsA1[0]), 4, 0, 0); } } while (0)
#define PG8_LDA(dst, b, h) do { _Pragma("unroll") for (int m = 0; m < ((h) ? M1 : 4); ++m) _Pragma("unroll") for (int k = 0; k < 2; ++k) dst[m][k] = *(const PG8_LAS bf16x8*)(lds + PG8_SA(b, h) + ((h) ? aoff1 : aoff) + m * 2048 + k * 1024); } while (0)
#define PG8_LDB(dst, b, h) do { _Pragma("unroll") for (int n = 0; n < 2; ++n) _Pragma("unroll") for (int k = 0; k < 2; ++k) dst[n][k] = *(const PG8_LAS bf16x8*)(lds + PG8_SB(b, h) + boff + n * 2048 + k * 1024); } while (0)
#define PG8_MMA(ai, bj, At, Bt) do { __builtin_amdgcn_s_setprio(1); _Pragma("unroll") for (int m = 0; m < ((ai) ? M1 : 4); ++m) _Pragma("unroll") for (int n = 0; n < 2; ++n) _Pragma("unroll") for (int k = 0; k < 2; ++k) \
        acc[ai][bj][m][n] = __builtin_amdgcn_mfma_f32_16x16x32_bf16(Bt[n][k], At[m][k], acc[ai][bj][m][n], 0, 0, 0); __builtin_amdgcn_s_setprio(0); } while (0)
#define PG8_WAIT_V(n) asm volatile("s_waitcnt vmcnt(" #n ")" ::: "memory")
#define PG8_WAIT_L(n) asm volatile("s_waitcnt lgkmcnt(" #n ")" ::: "memory")
#define PG8_BAR __builtin_amdgcn_s_barrier()
#define PG8_SCHED __builtin_amdgcn_sched_barrier(0)
    Unit cur, nxt; int ui = 0;
    if (!S.next(0, cur)) return;
    f32x4 acc[2][2][4][2];
#pragma unroll
    for (int a = 0; a < 2; ++a)
#pragma unroll
        for (int b = 0; b < 2; ++b)
#pragma unroll
            for (int m = 0; m < 4; ++m)
#pragma unroll
                for (int n = 0; n < 2; ++n) acc[a][b][m][n] = (f32x4){0.f, 0.f, 0.f, 0.f};
    bf16x8 At[4][2], B0[2][2], B1[2][2];
    const char* cA = (const char*)g.A + (size_t)cur.pm * tstepA; const char* cB = (const char*)g.Bt + (size_t)cur.pn * tstep;
    S.a_ready(cur);
    if constexpr (SP2) {
        PG8_STAGE(PG8_SB(0, 0), cB, voffB); PG8_STAGE(PG8_SB(0, 1), cB + hstep, voffB); PG8_STAGE(PG8_SA(0, 0), cA, voffA); PG8_STAGE_A1(PG8_SA(0, 1), cA + hstep);
        if (wr == 1) PG8_BAR;
        PG8_WAIT_V(2); PG8_BAR;
        PG8_STAGE(PG8_SB(1, 0), cB + kstep, voffB); PG8_STAGE(PG8_SA(1, 0), cA + kstep, voffA); PG8_STAGE(PG8_SB(1, 1), cB + hstep + kstep, voffB);
        PG8_WAIT_V(6); PG8_BAR;
    } else {
        PG8_STAGE(PG8_SB(0, 0), cB, voffB); PG8_STAGE(PG8_SA(0, 0), cA, voffA); PG8_STAGE(PG8_SB(0, 1), cB + hstep, voffB); PG8_STAGE_A1(PG8_SA(0, 1), cA + hstep);
        if (wr == 1) PG8_BAR;
        PG8_WAIT_V(4); PG8_BAR;
        PG8_STAGE(PG8_SB(1, 0), cB + kstep, voffB); PG8_STAGE(PG8_SA(1, 0), cA + kstep, voffA); PG8_STAGE(PG8_SB(1, 1), cB + hstep + kstep, voffB);
        PG8_WAIT_V(6); PG8_BAR;
    }
    for (;;) {
        const bool has_next = S.next(ui + 1, nxt);
        const char* nA = has_next ? (const char*)g.A + (size_t)nxt.pm * tstepA : cA; const char* nB = has_next ? (const char*)g.Bt + (size_t)nxt.pn * tstep : cB;
        for (int t = 0; t < nt; t += 2) {
            const bool last = (t == nt - 2);
            const char* a1 = cA + (size_t)(t + 1) * kstep;
            const char* a2 = last ? nA : cA + (size_t)(t + 2) * kstep; const char* b2 = last ? nB : cB + (size_t)(t + 2) * kstep;
            const char* a3 = a2 + kstep; const char* b3 = b2 + kstep;
            if (last && has_next) S.a_ready(nxt);
            if constexpr (SP2) {
            PG8_LDB(B0, 0, 0); PG8_LDB(B1, 0, 1); PG8_SCHED; PG8_LDA(At, 0, 0); PG8_STAGE_A1(PG8_SA(1, 1), a1 + hstep);
            PG8_WAIT_V(8); PG8_WAIT_L(0); PG8_BAR; PG8_MMA(0, 0, At, B0); PG8_MMA(0, 1, At, B1); PG8_BAR; PG8_SCHED;
            PG8_LDA(At, 0, 1); PG8_STAGE(PG8_SB(0, 0), b2, voffB); PG8_STAGE(PG8_SB(0, 1), b2 + hstep, voffB); PG8_STAGE(PG8_SA(0, 0), a2, voffA);
            PG8_WAIT_V(8); PG8_WAIT_L(0); PG8_BAR; PG8_MMA(1, 0, At, B0); PG8_MMA(1, 1, At, B1); PG8_BAR; PG8_SCHED;
            PG8_LDB(B0, 1, 0); PG8_LDB(B1, 1, 1); PG8_SCHED; PG8_LDA(At, 1, 0); PG8_STAGE_A1(PG8_SA(0, 1), a2 + hstep);
            PG8_WAIT_V(8); PG8_WAIT_L(0); PG8_BAR; PG8_MMA(0, 0, At, B0); PG8_MMA(0, 1, At, B1); PG8_BAR; PG8_SCHED;
            PG8_LDA(At, 1, 1); PG8_STAGE(PG8_SB(1, 0), b3, voffB); PG8_STAGE(PG8_SB(1, 1), b3 + hstep, voffB); PG8_STAGE(PG8_SA(1, 0), a3, voffA);
            PG8_WAIT_V(8); PG8_WAIT_L(0); PG8_BAR; PG8_MMA(1, 0, At, B0); PG8_MMA(1, 1, At, B1); PG8_BAR; PG8_SCHED;
            } else {
            PG8_LDB(B0, 0, 0); PG8_SCHED; PG8_LDA(At, 0, 0); PG8_STAGE_A1(PG8_SA(1, 1), a1 + hstep);
            PG8_WAIT_L(8); PG8_BAR; PG8_WAIT_L(0); PG8_MMA(0, 0, At, B0); PG8_BAR; PG8_SCHED;
            PG8_LDB(B1, 0, 1); PG8_STAGE(PG8_SB(0, 0), b2, voffB);
            PG8_BAR; PG8_WAIT_L(0); PG8_MMA(0, 1, At, B1); PG8_BAR;
            PG8_LDA(At, 0, 1); PG8_STAGE(PG8_SA(0, 0), a2, voffA);
            PG8_BAR; PG8_WAIT_L(0); PG8_MMA(1, 0, At, B0); PG8_BAR; PG8_SCHED;
            PG8_STAGE(PG8_SB(0, 1), b2 + hstep, voffB);
            PG8_WAIT_V(6); PG8_BAR; PG8_MMA(1, 1, At, B1); PG8_BAR;
            PG8_LDB(B0, 1, 0); PG8_SCHED; PG8_LDA(At, 1, 0); PG8_STAGE_A1(PG8_SA(0, 1), a2 + hstep);
            PG8_WAIT_L(8); PG8_BAR; PG8_WAIT_L(0); PG8_MMA(0, 0, At, B0); PG8_BAR; PG8_SCHED;
            PG8_LDB(B1, 1, 1); PG8_STAGE(PG8_SB(1, 0), b3, voffB);
            PG8_BAR; PG8_WAIT_L(0); PG8_MMA(0, 1, At, B1); PG8_BAR;
            PG8_LDA(At, 1, 1); PG8_STAGE(PG8_SA(1, 0), a3, voffA);
            PG8_BAR; PG8_WAIT_L(0); PG8_MMA(1, 0, At, B0); PG8_BAR; PG8_SCHED;
            PG8_STAGE(PG8_SB(1, 1), b3 + hstep, voffB);
            PG8_WAIT_V(6); PG8_BAR; PG8_MMA(1, 1, At, B1); PG8_BAR;
            }
        }
        if constexpr (ALIGN_EPI) { if (wr == 0) PG8_BAR; }
        if constexpr (!Epi::AFTER_DRAIN) { E(acc, cur, wr, wc, fr, fq); S.done(cur); }
        if (!has_next) break;
#pragma unroll
        for (int a = 0; a < 2; ++a)
#pragma unroll
            for (int b = 0; b < 2; ++b)
#pragma unroll
                for (int m = 0; m < 4; ++m)
#pragma unroll
                    for (int n = 0; n < 2; ++n) acc[a][b][m][n] = (f32x4){0.f, 0.f, 0.f, 0.f};
        cur = nxt; cA = nA; cB = nB; ++ui;
        if constexpr (ALIGN_EPI) { if (wr == 1) PG8_BAR; }
    }
    PG8_WAIT_V(0);
    if constexpr (!ALIGN_EPI) { if (wr == 0) PG8_BAR; }
    PG8_BAR;
    if constexpr (Epi::AFTER_DRAIN) { E.fused(acc, cur, wr, wc, fr, fq, lds, wid, lane); S.done(cur); }
#undef PG8_SA
#undef PG8_SB
#undef PG8_STAGE
#undef PG8_STAGE_A1
#undef PG8_LDA
#undef PG8_LDB
#undef PG8_MMA
#undef PG8_WAIT_V
#undef PG8_WAIT_L
#undef PG8_BAR
#undef PG8_SCHED
}
}
constexpr int M_TOK = 10240, M_CTX = 8192, DM = 1024, FF = 2816, NWI = 5632, NIN = 2048;
constexpr int LCTX = 256, LLAT = 1024, LKLAT = 1280, NSEQ = 34;
constexpr float EPS = 1e-6f;

namespace pg8 {
__device__ __forceinline__ float silu_f(float x) { return x * __builtin_amdgcn_rcpf(1.0f + __builtin_amdgcn_exp2f(-1.4426950408889634f * x)); }
struct EpiSwiglu {
    static constexpr bool PERM = true, AFTER_DRAIN = false;
    bf16_t* O; int ldc;
    __device__ __forceinline__ void operator()(const f32x4 (&acc)[2][2][4][2], const Unit& u, int wr, int wc, int fr, int fq) const {
        const int row0 = u.pm * BM + wr * 64 + fr, col0 = u.pn * HALF + wc * 32 + 8 * fq;
#pragma unroll
        for (int ai = 0; ai < 2; ++ai)
#pragma unroll
            for (int m = 0; m < 4; ++m) { bf16_t* rowp = O + (size_t)(row0 + ai * HALF + m * 16) * ldc + col0;
                const f32x4 a0 = acc[ai][0][m][0], a1 = acc[ai][0][m][1], b0 = acc[ai][1][m][0], b1 = acc[ai][1][m][1];
                u32x4 w;
                w.x = cvt_pk_bf16(silu_f(a0[0]) * b0[0], silu_f(a0[1]) * b0[1]); w.y = cvt_pk_bf16(silu_f(a0[2]) * b0[2], silu_f(a0[3]) * b0[3]);
                w.z = cvt_pk_bf16(silu_f(a1[0]) * b1[0], silu_f(a1[1]) * b1[1]); w.w = cvt_pk_bf16(silu_f(a1[2]) * b1[2], silu_f(a1[3]) * b1[3]);
                *(u32x4*)rowp = w; }
    }
};
template <int M1> struct EpiResGate {
    static constexpr bool PERM = false, AFTER_DRAIN = false;
    static constexpr int TM = HALF + 32 * M1;
    const float* base0; const float* base1;
    float* out; const float* mods;
    int idx; float gs;
    __device__ __forceinline__ void operator()(const f32x4 (&acc)[2][2][4][2], const Unit& u, int wr, int wc, int fr, int fq) const {
        const int col0 = u.pn * BM + wc * 32 + 4 * fq;
#pragma unroll
        for (int ai = 0; ai < 2; ++ai)
#pragma unroll
            for (int m = 0; m < (ai ? M1 : 4); ++m) {
                const int rb = u.pm * TM + (ai ? HALF + wr * 16 * M1 : wr * 64) + m * 16;
                const int set = rb < M_CTX ? 0 : 1 + ((rb - M_CTX) >> 10);
                const float* mv = mods + (size_t)(set * 9 + idx) * DM + col0;
                const float* bp = (rb < M_CTX ? base0 + (size_t)rb * DM : base1 + (size_t)(rb - M_CTX) * DM) + (size_t)fr * DM + col0;
                float* op = out + (size_t)(rb + fr) * DM + col0;
#pragma unroll
                for (int bj = 0; bj < 2; ++bj)
#pragma unroll
                    for (int n = 0; n < 2; ++n) { const f32x4 gv = *(const f32x4*)(mv + bj * HALF + n * 16) * gs; const f32x4 b = *(const f32x4*)(bp + bj * HALF + n * 16);
                        *(f32x4*)(op + bj * HALF + n * 16) = b + gv * acc[ai][bj][m][n]; } }
    }
};
template <int M1> struct EpiU {
    static constexpr bool PERM = true, AFTER_DRAIN = false;
    static constexpr int TM = HALF + 32 * M1;
    bf16_t* U; float* outV; int layer;
    __device__ __forceinline__ void operator()(const f32x4 (&acc)[2][2][4][2], const Unit& u, int wr, int wc, int fr, int fq) const {
        const int col0 = u.pn * BM + wc * 32 + 8 * fq;
#pragma unroll
        for (int ai = 0; ai < 2; ++ai)
#pragma unroll
            for (int m = 0; m < (ai ? M1 : 4); ++m) { const int rb = u.pm * TM + (ai ? HALF + wr * 16 * M1 : wr * 64) + m * 16, row = rb + fr; bf16_t* rowp = U + (size_t)row * NIN + col0;
                const bool vout = (u.pn >= 6) && (rb < M_CTX);
#pragma unroll
                for (int bj = 0; bj < 2; ++bj) { const f32x4 v0 = acc[ai][bj][m][0], v1 = acc[ai][bj][m][1];
                    u32x4 w; w.x = cvt_pk_bf16(v0[0], v0[1]); w.y = cvt_pk_bf16(v0[2], v0[3]); w.z = cvt_pk_bf16(v1[0], v1[1]); w.w = cvt_pk_bf16(v1[2], v1[3]);
                    *(u32x4*)(rowp + bj * HALF) = w;
                    if (vout) { float* vp = outV + ((size_t)((row >> 8) * 2 + layer) * 256 + (row & 255)) * 512 + (col0 + bj * HALF - 1536);
                        *(f32x4*)vp = v0; *(f32x4*)(vp + 4) = v1; } } }
    }
};
}
constexpr size_t MiB = 1u << 20;
constexpr size_t WS_CTL = 0, CTL_ZERO_BYTES = 512 * 1024;
constexpr size_t SZ_WI = (size_t)NWI * DM * 2, SZ_WO = (size_t)DM * FF * 2, SZ_WIN = (size_t)NIN * DM * 2, SZ_WOUT = (size_t)DM * DM * 2;
constexpr size_t WS_W = 2 * MiB;
constexpr size_t OFF_WI1 = 0, OFF_WO1 = OFF_WI1 + SZ_WI, OFF_WI2 = OFF_WO1 + SZ_WO, OFF_WO2 = OFF_WI2 + SZ_WI, OFF_WIN = OFF_WO2 + SZ_WO, OFF_WOUT = OFF_WIN + SZ_WIN, SZ_WLAYER = OFF_WOUT + SZ_WOUT;
constexpr size_t WS_TW1024 = 84 * MiB;
constexpr size_t WS_TW256 = 88 * MiB;
constexpr size_t WS_WCS = WS_TW256 + 512 * 1024;
constexpr size_t WS_ROPE = WS_WCS + 256 * 1024;
constexpr size_t WS_SCAL = WS_ROPE + 16 * 1024;
constexpr size_t WS_XN = 90 * MiB;
constexpr size_t WS_MIX = 110 * MiB;
constexpr size_t WS_GB = 130 * MiB;
constexpr size_t WS_U = 130 * MiB;
constexpr size_t WS_QB = 170 * MiB;
constexpr size_t WS_KB = 185 * MiB;
constexpr size_t WS_VTC = 196 * MiB;
constexpr size_t WS_VTL = 204 * MiB;
constexpr size_t WS_YTC = 207 * MiB;
constexpr size_t WS_YTL = 215 * MiB;
constexpr size_t WS_QN = 217 * MiB;
constexpr size_t WS_END = 218 * MiB;
static_assert(WS_W + 2 * SZ_WLAYER <= WS_TW1024 && WS_SCAL + 64 <= WS_XN && WS_GB + (size_t)M_TOK * FF * 2 <= WS_KB && WS_QB + (size_t)M_TOK * 512 * 2 <= WS_KB, "ws map");
constexpr int CW_TMO = 0, CW_BAR = 4096, CW_KMAX = 8192  , CW_MODS = 16384  ;
static_assert((CW_MODS + 2 * 3 * 9 * 1024) * 4 <= (int)CTL_ZERO_BYTES, "ctl");
constexpr int RING_BYTES = 131072, LDSCTL_OFF = RING_BYTES, MISC_OFF = LDSCTL_OFF + 320, LDS_BYTES = 147456;
constexpr int NWAVES = 8;
constexpr int NPHASES = 23;
#define GAS __attribute__((address_space(1)))
#define LAS __attribute__((address_space(3)))
typedef unsigned short bf16;
typedef unsigned v4u __attribute__((ext_vector_type(4)));
typedef float f32x4 __attribute__((ext_vector_type(4)));
typedef short bf16x8 __attribute__((ext_vector_type(8)));
typedef GAS unsigned gu32;
typedef GAS unsigned long long gu64;
#define RLX_AGENT __ATOMIC_RELAXED, __HIP_MEMORY_SCOPE_AGENT
#define LDS_WAIT() asm volatile("s_waitcnt lgkmcnt(0)" ::: "memory")
#define VM_WAIT() asm volatile("s_waitcnt vmcnt(0)" ::: "memory")
__device__ __forceinline__ unsigned long long rt() { return __builtin_amdgcn_s_memrealtime(); }
__device__ __forceinline__ unsigned f2bf(float f) { unsigned u = __builtin_bit_cast(unsigned, f); return (u + 0x7fffu + ((u >> 16) & 1u)) >> 16; }
typedef float f32x2_t __attribute__((ext_vector_type(2))); typedef __bf16 bf16x2_t __attribute__((ext_vector_type(2)));
__device__ __forceinline__ unsigned pk2(float lo, float hi) { f32x2_t v = {lo, hi}; bf16x2_t b = __builtin_convertvector(v, bf16x2_t); return __builtin_bit_cast(unsigned, b); }
#define XB_TMO      128
#define XB_XCNT(j)  (256  + 64 * (j))
#define XB_XSUB(j)  (1280 + 64 * (j))
#define XB_XGEN(j)  (2304 + 64 * (j))
#define XB_TOP      3328
#define XB_TOPGEN   3392
#define XCD_BAR_WORDS 3456
#define XB_SPIN_CAP (1u << 18)

__device__ __forceinline__ unsigned xb_ld(unsigned* p)              { return __hip_atomic_load(p, __ATOMIC_RELAXED, __HIP_MEMORY_SCOPE_AGENT); }
__device__ __forceinline__ unsigned xb_add(unsigned* p, unsigned v) { return __hip_atomic_fetch_add(p, v, __ATOMIC_RELAXED, __HIP_MEMORY_SCOPE_AGENT); }
__device__ __forceinline__ unsigned xb_xcc_id() { return (unsigned)__builtin_amdgcn_s_getreg((3 << 11) | 20) & 0xFu; }
#define XB_SPIN(cond, bar) do { unsigned _sp = 0; while (cond) { __builtin_amdgcn_s_sleep(1); \
    if ((++_sp & 255u) == 0u) { if (xb_ld(&(bar)[XB_TMO])) break; if (_sp > XB_SPIN_CAP) { atomicAdd(&(bar)[XB_TMO], 1u); break; } } } } while (0)

struct XcdBarrier {
    unsigned* bar; unsigned x;
    volatile LAS unsigned* st;
};

__device__ __forceinline__ XcdBarrier xcd_barrier_post(unsigned* bar, volatile LAS unsigned* st) {
    XcdBarrier b; b.bar = bar; b.x = xb_xcc_id(); b.st = st;
    if (threadIdx.x == 0) (void)xb_add(&bar[XB_XCNT(b.x)], 1u);
    return b;
}
__device__ __forceinline__ void xcd_barrier_complete(unsigned* bar, unsigned x, unsigned& nloc, unsigned& nx) {
    const unsigned G = gridDim.x * gridDim.y * gridDim.z;
    unsigned sum, cnt, mine, sp = 0u;
    for (;;) {
        sum = 0u; cnt = 0u; mine = 0u;
#pragma unroll
        for (unsigned j = 0; j < 16; ++j) { const unsigned c = xb_ld(&bar[XB_XCNT(j)]); sum += c; cnt += (c > 0u) ? 1u : 0u; mine = (j == x) ? c : mine; }
        if (sum == G) break;
        __builtin_amdgcn_s_sleep(1);
        if ((++sp & 255u) == 0u) { if (xb_ld(&bar[XB_TMO])) break; if (sp > XB_SPIN_CAP) { atomicAdd(&bar[XB_TMO], 1u); break; } }
    }
    nloc = mine > 0u ? mine : 1u; nx = cnt > 0u ? cnt : 1u;
}

__device__ __forceinline__ void xcd_barrier(const XcdBarrier& b) {
    asm volatile("s_waitcnt vmcnt(0)" ::: "memory");
    __syncthreads();
    if (threadIdx.x == 0) {
        unsigned* bar = b.bar;
        __builtin_amdgcn_s_waitcnt(0);
        unsigned nloc = b.st[0], nx = b.st[1];
        if (nloc == 0u) { xcd_barrier_complete(bar, b.x, nloc, nx); b.st[0] = nloc; b.st[1] = nx; }
        const unsigned old = xb_add(&bar[XB_XSUB(b.x)], 1u);
        const unsigned gen = old / nloc;
        if (old + 1u == (gen + 1u) * nloc) {
            __builtin_amdgcn_fence(__ATOMIC_RELEASE, "agent");
            asm volatile("s_waitcnt vmcnt(0)" ::: "memory");
            const unsigned og = xb_add(&bar[XB_TOP], 1u);
            const unsigned tg = og / nx;
            if (og + 1u == (tg + 1u) * nx) xb_add(&bar[XB_TOPGEN], 1u);
            else XB_SPIN(xb_ld(&bar[XB_TOPGEN]) == tg, bar);
            __builtin_amdgcn_fence(__ATOMIC_ACQUIRE, "agent");
            xb_add(&bar[XB_XGEN(b.x)], 1u);
            asm volatile("s_waitcnt vmcnt(0)" ::: "memory");
        } else {
            XB_SPIN(xb_ld(&bar[XB_XGEN(b.x)]) == gen, bar);
            __builtin_amdgcn_fence(__ATOMIC_ACQUIRE, "agent");
            asm volatile("s_waitcnt vmcnt(0)" ::: "memory");
        }
    }
    __syncthreads();
}
typedef float f32x16 __attribute__((ext_vector_type(16)));
typedef unsigned u32x2 __attribute__((ext_vector_type(2)));
__device__ __forceinline__ float bf2f(unsigned h) { return __builtin_bit_cast(float, h << 16); }
__device__ __forceinline__ float wave_sum(float v) {
#pragma unroll
    for (int o = 1; o < 64; o <<= 1) v += __shfl_xor(v, o);
    return v;
}
__device__ __forceinline__ int crow(int r, int hi) { return (r & 3) + 8 * (r >> 2) + 4 * hi; }
__device__ __forceinline__ float silu_acc(float x) { return x / (1.0f + expf(-x)); }

struct KArgs { const float* in[25]; float* out; unsigned char* ws; int ph_lo, ph_hi; };
enum { I_XP = 0, I_XS, I_CK, I_CV, I_C, I_CCTX, I_NG, I_ADAW, I_ADAB, I_F1WI, I_F1WO, I_F2WI, I_F2WO, I_WIN, I_WOUT, I_QG, I_KG, I_LQ1, I_LK1, I_LQ2, I_LK2, I_AOG, I_POOLW, I_POOLS, I_FNETW };
constexpr size_t OUT_YS = (size_t)M_CTX * DM, OUT_K = (size_t)M_TOK * DM, OUT_V = OUT_K + (size_t)32 * 2 * 256 * 512;

__device__ __forceinline__ void p0_transpose_item(const float* W, int K, int N, bf16* WT, bool swi, LAS float* scr, int item, int lane) {
    const int nblk = N / 32, kb = item / nblk, nb = item % nblk, k0 = 64 * kb, n0 = 32 * nb;
    int r0 = n0;
    if (swi) { const int half = n0 / FF, jj = n0 % FF; r0 = (jj / 128) * 256 + half * 128 + (jj % 128); }
#pragma unroll 8
    for (int i = 0; i < 32; ++i) { const int kk = 2 * i + (lane >> 5); scr[kk * 33 + (lane & 31)] = W[(size_t)(k0 + kk) * N + n0 + (lane & 31)]; }
    LDS_WAIT(); asm volatile("" ::: "memory");
    const int c = lane & 7;
#pragma unroll
    for (int j = 0; j < 4; ++j) { const int n = (lane >> 3) + 8 * j; const LAS float* s = scr + (8 * c) * 33 + n;
        v4u o; o.x = pk2(s[0 * 33], s[1 * 33]); o.y = pk2(s[2 * 33], s[3 * 33]); o.z = pk2(s[4 * 33], s[5 * 33]); o.w = pk2(s[6 * 33], s[7 * 33]);
        *(GAS v4u*)(WT + (size_t)(r0 + n) * K + k0 + 8 * c) = o; }
    LDS_WAIT(); asm volatile("" ::: "memory");
}
__device__ __forceinline__ void p0_fold_item(const float* Win, const float* PW, bf16* WT, LAS float* scr, int kb, int nb, int lane) {
    const int k0 = 64 * kb, n0 = 32 * nb, g = n0 >> 6, kh = lane >> 5, n = lane & 31;
    for (int kk = 0; kk < 64; ++kk) scr[kk * 64 + lane] = Win[(size_t)(k0 + kk) * NIN + g * 64 + lane];
    LDS_WAIT(); asm volatile("" ::: "memory");
    float acc[32];
#pragma unroll
    for (int i = 0; i < 32; ++i) acc[i] = 0.f;
    const float* pw = PW + (size_t)g * 4096 + (n0 & 63) + n;
#pragma unroll 1
    for (int c4 = 0; c4 < 16; ++c4) {
        const float p0 = pw[(4 * c4) * 64], p1 = pw[(4 * c4 + 1) * 64], p2 = pw[(4 * c4 + 2) * 64], p3 = pw[(4 * c4 + 3) * 64];
#pragma unroll
        for (int i = 0; i < 32; ++i) { const f32x4 a = *(const LAS f32x4*)(scr + (32 * kh + i) * 64 + 4 * c4); acc[i] += (a.x * p0 + a.y * p1) + (a.z * p2 + a.w * p3); }
    }
    bf16* op = WT + (size_t)(n0 + n) * DM + k0 + 32 * kh;
#pragma unroll
    for (int q = 0; q < 4; ++q) *(GAS v4u*)(op + 8 * q) = (v4u){pk2(acc[8 * q], acc[8 * q + 1]), pk2(acc[8 * q + 2], acc[8 * q + 3]), pk2(acc[8 * q + 4], acc[8 * q + 5]), pk2(acc[8 * q + 6], acc[8 * q + 7])};
    LDS_WAIT(); asm volatile("" ::: "memory");
}
__device__ __forceinline__ void p0_mods_item(const KArgs& A, float* mods, int item, int lane) {
    const int l = item / 576, r = item % 576, kc = r / 36, cb = r % 36;
    const float* W = A.in[I_ADAW] + (size_t)l * DM * 9216 + (size_t)(kc * 64) * 9216 + cb * 256 + lane * 4;
    const int k = kc * 64 + lane;
    const float s0 = silu_acc(A.in[I_CCTX][k]), s1 = silu_acc(A.in[I_C][k]), s2 = silu_acc(A.in[I_C][DM + k]);
    f32x4 a0 = {0.f, 0.f, 0.f, 0.f}, a1 = a0, a2 = a0;
#pragma unroll 8
    for (int kk = 0; kk < 64; ++kk) {
        const f32x4 w = *(const f32x4*)(W + (size_t)kk * 9216);
        const float c0 = __builtin_bit_cast(float, __builtin_amdgcn_readlane(__builtin_bit_cast(int, s0), kk));
        const float c1 = __builtin_bit_cast(float, __builtin_amdgcn_readlane(__builtin_bit_cast(int, s1), kk));
        const float c2 = __builtin_bit_cast(float, __builtin_amdgcn_readlane(__builtin_bit_cast(int, s2), kk));
        a0 += w * c0; a1 += w * c1; a2 += w * c2;
    }
    if (kc == 0) { const f32x4 b = *(const f32x4*)(A.in[I_ADAB] + (size_t)l * 9216 + cb * 256 + lane * 4); a0 += b; a1 += b; a2 += b; }
    float* mp = mods + (size_t)l * 3 * 9216 + cb * 256 + lane * 4;
#pragma unroll
    for (int i = 0; i < 4; ++i) { atomicAdd(mp + i, a0[i]); atomicAdd(mp + 9216 + i, a1[i]); atomicAdd(mp + 2 * 9216 + i, a2[i]); }
}
__device__ __forceinline__ void p0_tw_item(bf16* TW, int L, int item, int lane) {
    const int nks = L / 16, ks = item % nks, kh = (item / nks) & 1, rt = item / (2 * nks), k = 32 * rt + (lane & 31), h = lane >> 5;
    unsigned w[4];
#pragma unroll
    for (int i = 0; i < 4; ++i) { float v[2];
#pragma unroll
        for (int e = 0; e < 2; ++e) { const int j = 2 * i + e, kk = 16 * ks + 8 * (j >> 2) + 4 * h + (j & 3); const int ang = (k * kk) & (L - 1);
            float sn, cs; sincospif(2.0f * (float)ang / (float)L, &sn, &cs); v[e] = kh ? sn : cs; }
        w[i] = pk2(v[0], v[1]); }
    *(GAS v4u*)(TW + (size_t)item * 512 + lane * 8) = (v4u){w[0], w[1], w[2], w[3]};
}
__device__ __forceinline__ void p0_wcs_item(const KArgs& A, bf16* WCS, int item, int lane) {
    const int lg = item >> 7, n = item & 127, d = n & 63; const bool sn = n >= 64;
    const float* Wf = A.in[I_FNETW] + (size_t)lg * 4096 + d;
    float acc = 0.f;
    for (int m = 0; m < 64; ++m) { float s, c; sincospif(2.0f * (float)((m * lane) & 63) / 64.0f, &s, &c); acc += (sn ? -s : c) * Wf[m * 64]; }
    WCS[(size_t)item * 64 + lane] = (bf16)f2bf(acc);
}
__device__ __forceinline__ void p0_misc_item(const KArgs& A, float* rope, float* scal, int lane) {
    for (int e = lane; e < 1024; e += 64) { const int pos = e >> 4, i = e & 15; const float inv = 1.0f / powf(10000.0f, (float)(2 * i) / 32.0f); const float ang = (float)pos * inv;
        rope[e] = cosf(ang); rope[1024 + e] = sinf(ang); }
#pragma unroll
    for (int l = 0; l < 2; ++l) {
        const float d1 = wave_sum(A.in[I_LQ1][l * 64 + lane] * A.in[I_LK1][l * 64 + lane]), d2 = wave_sum(A.in[I_LQ2][l * 64 + lane] * A.in[I_LK2][l * 64 + lane]);
        const float lam_init = 0.8f - 0.6f * expf(-0.3f * (float)l);
        if (lane == 0) scal[l] = expf(d1) - expf(d2) + lam_init;
    }
}
constexpr int IT_MODS = 2 * 16 * 36, IT_TWI = (DM / 64) * (NWI / 32), IT_TWO = (FF / 64) * (DM / 32), IT_TWIN = (DM / 64) * (NIN / 32), IT_TWOUT = (DM / 64) * (DM / 32);
constexpr int IT_TRL = 2 * IT_TWI + 2 * IT_TWO + IT_TWIN + IT_TWOUT;
constexpr int IT_TW1024 = 32 * 2 * 64, IT_TW256 = 8 * 2 * 16, IT_WCS = 2 * 4 * 128;
__device__ __forceinline__ void p0_layer_item(const KArgs& A, int l, int r, LAS float* scr, int lane) {
    unsigned char* wl = A.ws + WS_W + (size_t)l * SZ_WLAYER;
    if (r < IT_TWI) { p0_transpose_item(A.in[I_F1WI] + (size_t)l * DM * NWI, DM, NWI, (bf16*)(wl + OFF_WI1), true, scr, r, lane); return; } r -= IT_TWI;
    if (r < IT_TWO) { p0_transpose_item(A.in[I_F1WO] + (size_t)l * FF * DM, FF, DM, (bf16*)(wl + OFF_WO1), false, scr, r, lane); return; } r -= IT_TWO;
    if (r < IT_TWI) { p0_transpose_item(A.in[I_F2WI] + (size_t)l * DM * NWI, DM, NWI, (bf16*)(wl + OFF_WI2), true, scr, r, lane); return; } r -= IT_TWI;
    if (r < IT_TWO) { p0_transpose_item(A.in[I_F2WO] + (size_t)l * FF * DM, FF, DM, (bf16*)(wl + OFF_WO2), false, scr, r, lane); return; } r -= IT_TWO;
    if (r < IT_TWIN) { const int nblk = NIN / 32, kb = r / nblk, nb = r % nblk;
        if (nb < 8) p0_fold_item(A.in[I_WIN] + (size_t)l * DM * NIN, A.in[I_POOLW] + (size_t)l * 4 * 4096, (bf16*)(wl + OFF_WIN), scr, kb, nb, lane);
        else p0_transpose_item(A.in[I_WIN] + (size_t)l * DM * NIN, DM, NIN, (bf16*)(wl + OFF_WIN), false, scr, r, lane);
        return; } r -= IT_TWIN;
    p0_transpose_item(A.in[I_WOUT] + (size_t)l * DM * DM, DM, DM, (bf16*)(wl + OFF_WOUT), false, scr, r, lane);
}
constexpr int IT_MODL = 16 * 36;
constexpr int P0_SET0 = IT_MODL + IT_TWI + IT_TW1024 + IT_TW256 + IT_WCS + 1, P0_SET1 = IT_TRL - IT_TWI, P0_SET2 = IT_MODL + IT_TRL;
__device__ __forceinline__ void p0_items(const KArgs& A, LAS unsigned char* lds, int set, int widx, int nw, int wave, int lane, bool skip_mods = false) {
    LAS float* scr = (LAS float*)(lds + wave * 16384);
    unsigned char* ws = A.ws;
    float* mods = (float*)(ws + WS_CTL) + CW_MODS;
    const int nit = set == 0 ? P0_SET0 : set == 1 ? P0_SET1 : P0_SET2;
#pragma unroll 1
    for (int it = widx; it < nit; it += nw) {
        asm volatile("" : "+v"(lane));
        int r = it;
        if (set == 1) { p0_layer_item(A, 0, r + IT_TWI, scr, lane); continue; }
        if (r < IT_MODL) { if (!skip_mods) p0_mods_item(A, mods, (set == 2 ? IT_MODL : 0) + r, lane); continue; } r -= IT_MODL;
        if (set == 2) { p0_layer_item(A, 1, r, scr, lane); continue; }
        if (r < IT_TWI) { p0_layer_item(A, 0, r, scr, lane); continue; } r -= IT_TWI;
        if (r < IT_TW1024) { p0_tw_item((bf16*)(ws + WS_TW1024), 1024, r, lane); continue; } r -= IT_TW1024;
        if (r < IT_TW256) { p0_tw_item((bf16*)(ws + WS_TW256), 256, r, lane); continue; } r -= IT_TW256;
        if (r < IT_WCS) { p0_wcs_item(A, (bf16*)(ws + WS_WCS), r, lane); continue; }
        p0_misc_item(A, (float*)(ws + WS_ROPE), (float*)(ws + WS_SCAL), lane);
    }
}
__device__ __forceinline__ void norm_phase(const float* x0, const float* x1, bf16* XN, const float* g, const float* mods_l, int sub, int gw, int NGW, int lane) {
    for (int m = gw; m < M_TOK; m += NGW) {
        const float* xrow = m < M_CTX ? x0 + (size_t)m * DM : x1 + (size_t)(m - M_CTX) * DM;
        const int set = m < M_CTX ? 0 : 1 + ((m - M_CTX) >> 10);
        const float* shift = mods_l + (size_t)(set * 9 + 3 * sub) * DM; const float* scale = shift + DM;
        const GAS f32x4* xr = (const GAS f32x4*)xrow + lane;
        f32x4 v[4]; float ss = 0.f;
#pragma unroll
        for (int j = 0; j < 4; ++j) { v[j] = xr[64 * j]; ss += (v[j].x * v[j].x + v[j].y * v[j].y) + (v[j].z * v[j].z + v[j].w * v[j].w); }
        const float rstd = 1.0f / sqrtf(wave_sum(ss) * (1.0f / DM) + EPS);
        GAS unsigned long long* o8 = (GAS unsigned long long*)(XN + (size_t)m * DM) + lane;
#pragma unroll
        for (int j = 0; j < 4; ++j) { const f32x4 gg = *((const f32x4*)g + 64 * j + lane), sc = *((const f32x4*)scale + 64 * j + lane), sh = *((const f32x4*)shift + 64 * j + lane);
            const f32x4 h = (v[j] * rstd) * gg * (sc + 1.0f) + sh;
            o8[64 * j] = (unsigned long long)pk2(h.x, h.y) | ((unsigned long long)pk2(h.z, h.w) << 32); }
    }
}
__device__ __forceinline__ float prep_qk_lane(const bool ISK, const KArgs& A, int l, const bf16* src, bool lat, int t, int seq, int g, const float* rope, bf16* dstF, float* kout) {
    float x[64];
    { v4u w[8];
#pragma unroll
      for (int p = 0; p < 8; ++p) w[p] = *(const GAS v4u*)(src + p * 8);
#pragma unroll
      for (int p = 0; p < 8; ++p) { const unsigned ww[4] = {w[p].x, w[p].y, w[p].z, w[p].w};
#pragma unroll
          for (int i = 0; i < 4; ++i) { x[8 * p + 2 * i] = bf2f(ww[i] & 0xffffu); x[8 * p + 2 * i + 1] = bf2f(ww[i] >> 16); } } }
    float ss = 0.f;
#pragma unroll
    for (int i = 0; i < 64; ++i) ss += x[i] * x[i];
    const float rs = 1.0f / sqrtf(ss * (1.0f / 64.0f) + EPS);
    const float* gg = A.in[ISK ? I_KG : I_QG] + l * 64;
#pragma unroll
    for (int i = 0; i < 16; ++i) { const f32x4 gv = *(const f32x4*)(gg + 4 * i); x[4 * i] *= rs * gv.x; x[4 * i + 1] *= rs * gv.y; x[4 * i + 2] *= rs * gv.z; x[4 * i + 3] *= rs * gv.w; }
    if (lat) {
#pragma unroll
        for (int hb = 0; hb < 2; ++hb) {
            const int pos = hb ? (t & 63) : (t >> 6); const float* cs = rope + pos * 16; const float* sn = cs + 1024;
#pragma unroll
            for (int i = 0; i < 4; ++i) { const f32x4 c4 = *(const f32x4*)(cs + 4 * i), s4 = *(const f32x4*)(sn + 4 * i); const float cc[4] = {c4.x, c4.y, c4.z, c4.w}, sv[4] = {s4.x, s4.y, s4.z, s4.w};
#pragma unroll
                for (int e = 0; e < 4; ++e) { const int d = 32 * hb + 4 * i + e; const float x1 = x[d], x2 = x[d + 16]; x[d] = x1 * cc[e] - x2 * sv[e]; x[d + 16] = x2 * cc[e] + x1 * sv[e]; } }
        }
    }
    float nn = 0.f;
    if (!ISK) {
#pragma unroll
        for (int i = 0; i < 64; ++i) x[i] *= 0.125f * 1.4426950408889634f; }
#pragma unroll
    for (int i = 0; i < 64; ++i) nn += x[i] * x[i];
#pragma unroll
    for (int p = 0; p < 8; ++p) *(GAS v4u*)(dstF + ((p >> 1) * 64 + (p & 1) * 32) * 8) = (v4u){pk2(x[8 * p], x[8 * p + 1]), pk2(x[8 * p + 2], x[8 * p + 3]), pk2(x[8 * p + 4], x[8 * p + 5]), pk2(x[8 * p + 6], x[8 * p + 7])};
    if (ISK && kout) {
#pragma unroll
        for (int i = 0; i < 16; ++i) *(f32x4*)(kout + 4 * i) = (f32x4){x[4 * i], x[4 * i + 1], x[4 * i + 2], x[4 * i + 3]}; }
    return nn;
}
__device__ __forceinline__ void prep_token_batch(const KArgs& A, int l, int row0, int lane, const bf16* U, bf16* QB, bf16* KB, float* QN, unsigned* kmax, const float* rope) {
    const int r = lane >> 3, g = lane & 7, row = row0 + r;
    const bool lat = row0 >= M_CTX;
    const int t = (lat ? (row0 - M_CTX) & 1023 : row0 & 255) + r;
    const int seq = lat ? 32 + ((row0 - M_CTX) >> 10) : row0 >> 8;
    const int key = lat ? 256 + t : t;
    const size_t qchunk = lat ? 2048 + (size_t)((seq - 32) * 8 + g) * 32 + (t >> 5) : (size_t)(seq * 8 + g) * 8 + (t >> 5);
    const size_t kchunk = lat ? 2048 + (size_t)((seq - 32) * 8 + g) * 40 + (key >> 5) : (size_t)(seq * 8 + g) * 8 + (key >> 5);
    float nk = 0.f;
#pragma unroll 1
    for (int isk = 0; isk < 2; ++isk) {
        const bf16* src = U + (size_t)row * NIN + (isk ? 1024 : 512) + g * 64;
        bf16* dst = isk ? KB + kchunk * 2048 + (key & 31) * 8 : QB + qchunk * 2048 + (t & 31) * 8;
        float* kout = (isk && !lat) ? A.out + OUT_K + ((size_t)((row >> 8) * 2 + l) * 256 + t) * 512 + g * 64 : nullptr;
        const float nn = prep_qk_lane(isk != 0, A, l, src, lat, t, seq, g, rope, dst, kout);
        if (isk) nk = nn; else QN[(size_t)row * 8 + g] = sqrtf(nn) * 1.01f;
    }
    nk = fmaxf(nk, __shfl_xor(nk, 8)); nk = fmaxf(nk, __shfl_xor(nk, 16)); nk = fmaxf(nk, __shfl_xor(nk, 32));
    if (r == 0) atomicMax(kmax + seq * 8 + g, __builtin_bit_cast(unsigned, sqrtf(nk) * 1.01f));
}
__device__ __forceinline__ void prep_cachek_batch(const KArgs& A, int l, int item, int lane, bf16* KB, unsigned* kmax) {
    const int b = item >> 5, r = lane >> 3, g = lane & 7, jrow = (item & 31) * 8 + r;
    const float* src = A.in[I_CK] + ((size_t)(b * 2 + l) * 256 + jrow) * 512 + g * 64;
    f32x4 w[16];
#pragma unroll
    for (int i = 0; i < 16; ++i) w[i] = *(const f32x4*)(src + 4 * i);
    float nk = 0.f;
#pragma unroll
    for (int i = 0; i < 16; ++i) nk += (w[i].x * w[i].x + w[i].y * w[i].y) + (w[i].z * w[i].z + w[i].w * w[i].w);
    bf16* dst = KB + (2048 + (size_t)(b * 8 + g) * 40 + (jrow >> 5)) * 2048 + (jrow & 31) * 8;
#pragma unroll
    for (int p = 0; p < 8; ++p) *(GAS v4u*)(dst + ((p >> 1) * 64 + (p & 1) * 32) * 8) = (v4u){pk2(w[2 * p].x, w[2 * p].y), pk2(w[2 * p].z, w[2 * p].w), pk2(w[2 * p + 1].x, w[2 * p + 1].y), pk2(w[2 * p + 1].z, w[2 * p + 1].w)};
    nk = fmaxf(nk, __shfl_xor(nk, 8)); nk = fmaxf(nk, __shfl_xor(nk, 16)); nk = fmaxf(nk, __shfl_xor(nk, 32));
    if (r == 0) atomicMax(kmax + (32 + b) * 8 + g, __builtin_bit_cast(unsigned, sqrtf(nk) * 1.01f));
}
__device__ __forceinline__ void prep_vt_item(const KArgs& A, int l, int kind, int item, int lane, const bf16* U, bf16* VF, LAS unsigned char* scr) {
    LAS bf16* T = (LAS bf16*)scr;
    const int ch = item & (kind == 1 ? 31 : 7), sh = item >> (kind == 1 ? 5 : 3), h = sh & 3, s = sh >> 2;
    const size_t chunk = kind == 0 ? (size_t)(s * 4 + h) * 8 + ch : 1024 + (size_t)(s * 4 + h) * 40 + (kind == 1 ? 8 + ch : ch);
    const int kr = lane >> 4, dc = (lane & 15) * 8;
    if (kind < 2) { const int row0 = (kind == 0 ? s * 256 : M_CTX + s * 1024) + ch * 32;
        v4u w[8];
#pragma unroll
        for (int i = 0; i < 8; ++i) w[i] = *(const GAS v4u*)(U + (size_t)(row0 + 4 * i + kr) * NIN + 1536 + h * 128 + dc);
#pragma unroll
        for (int i = 0; i < 8; ++i) *(LAS v4u*)(T + (4 * i + kr) * 128 + dc) = w[i];
    } else { const float* src = A.in[I_CV] + ((size_t)(s * 2 + l) * 256 + ch * 32) * 512 + h * 128 + dc;
        f32x4 w0[8], w1[8];
#pragma unroll
        for (int i = 0; i < 8; ++i) { w0[i] = *(const f32x4*)(src + (size_t)(4 * i + kr) * 512); w1[i] = *(const f32x4*)(src + (size_t)(4 * i + kr) * 512 + 4); }
#pragma unroll
        for (int i = 0; i < 8; ++i) *(LAS v4u*)(T + (4 * i + kr) * 128 + dc) = (v4u){pk2(w0[i].x, w0[i].y), pk2(w0[i].z, w0[i].w), pk2(w1[i].x, w1[i].y), pk2(w1[i].z, w1[i].w)}; }
    LDS_WAIT(); asm volatile("" ::: "memory");
    const int r32 = lane & 31, hi = lane >> 5;
#pragma unroll
    for (int it = 0; it < 8; ++it) { const int s2 = it >> 2, d = it & 3; const LAS bf16* tp = T + (16 * s2 + 4 * hi) * 128 + d * 32 + r32;
        unsigned e[8];
#pragma unroll
        for (int jj = 0; jj < 8; ++jj) e[jj] = tp[(8 * (jj >> 2) + (jj & 3)) * 128];
        *(GAS v4u*)(VF + chunk * 4096 + (size_t)(it * 64 + lane) * 8) = (v4u){e[0] | (e[1] << 16), e[2] | (e[3] << 16), e[4] | (e[5] << 16), e[6] | (e[7] << 16)}; }
    LDS_WAIT(); asm volatile("" ::: "memory");
}
__device__ __forceinline__ void prep_yt_item(int l, int item, int lane, const bf16* U, const bf16* WCS, bf16* YTC, bf16* YTL) {
    const int g = item & 3, rb = item >> 2, row0 = rb * 32, r32 = lane & 31, hi = lane >> 5;
    bf16* Y; int L, lp0;
    if (row0 < M_CTX) { L = 256; lp0 = row0 & 255; Y = YTC + (size_t)(((row0 >> 8) * 4 + g) * 128) * 256; }
    else { L = 1024; lp0 = (row0 - M_CTX) & 1023; Y = YTL + (size_t)((((row0 - M_CTX) >> 10) * 4 + g) * 128) * 1024; }
    const bf16* xp = U + (size_t)(row0 + r32) * NIN + 256 + g * 64 + hi * 8;
    const bf16* wp = WCS + (size_t)((l * 4 + g) * 128 + r32) * 64 + hi * 8;
    bf16x8 xa[4];
#pragma unroll
    for (int ks = 0; ks < 4; ++ks) xa[ks] = *(const GAS bf16x8*)(xp + ks * 16);
    bf16x8 wb[4][4];
#pragma unroll
    for (int nb = 0; nb < 4; ++nb)
#pragma unroll
        for (int ks = 0; ks < 4; ++ks) wb[nb][ks] = *(const GAS bf16x8*)(wp + (size_t)nb * 32 * 64 + ks * 16);
#pragma unroll
    for (int nb = 0; nb < 4; ++nb) { f32x16 acc = {};
#pragma unroll
        for (int ks = 0; ks < 4; ++ks) acc = __builtin_amdgcn_mfma_f32_32x32x16_bf16(xa[ks], wb[nb][ks], acc, 0, 0, 0);
#pragma unroll
        for (int s2 = 0; s2 < 2; ++s2)
            *(GAS v4u*)(Y + ((size_t)nb * (L >> 4) + (lp0 >> 4) + s2) * 512 + lane * 8) =
                (v4u){pk2(acc[8 * s2], acc[8 * s2 + 1]), pk2(acc[8 * s2 + 2], acc[8 * s2 + 3]), pk2(acc[8 * s2 + 4], acc[8 * s2 + 5]), pk2(acc[8 * s2 + 6], acc[8 * s2 + 7])}; }
}
constexpr int PR_TOK = M_TOK / 8, PR_CK = 512 / 8, PR_VT0 = 32 * 4 * 8, PR_VT1 = 2 * 4 * 32, PR_VT2 = 2 * 4 * 8, PR_YT = (M_TOK / 32) * 4;
constexpr int PR_ITEMS = PR_TOK + PR_CK + PR_VT0 + PR_VT1 + PR_VT2 + PR_YT;
__device__ __forceinline__ void prep_phase(const KArgs& A, int l, LAS unsigned char* lds, int gw, int NGW, int wave, int lane, int sel = 15) {
    asm volatile("" : "+v"(lane));
    unsigned char* ws = A.ws;
    const bf16* U = (const bf16*)(ws + WS_U); bf16* QB = (bf16*)(ws + WS_QB); bf16* KB = (bf16*)(ws + WS_KB);
    float* QN = (float*)(ws + WS_QN); unsigned* kmax = (unsigned*)(ws + WS_CTL) + CW_KMAX + l * NSEQ * 8; const float* rope = (const float*)(ws + WS_ROPE);
    LAS unsigned char* scr = lds + wave * 16384;
#pragma unroll 1
    for (int it = gw; it < PR_ITEMS; it += NGW) {
        asm volatile("" : "+v"(lane));
        int r = it;
        if (r < PR_TOK) { if (sel & 1) prep_token_batch(A, l, r * 8, lane, U, QB, KB, QN, kmax, rope); continue; } r -= PR_TOK;
        if (r < PR_YT) { if (sel & 2) prep_yt_item(l, r, lane, U, (const bf16*)(ws + WS_WCS), (bf16*)(ws + WS_YTC), (bf16*)(ws + WS_YTL)); continue; } r -= PR_YT;
        if (r < PR_VT0) { if (sel & 4) prep_vt_item(A, l, 0, r, lane, U, (bf16*)(ws + WS_VTC), scr); continue; } r -= PR_VT0;
        if (r < PR_VT1) { if (sel & 4) prep_vt_item(A, l, 1, r, lane, U, (bf16*)(ws + WS_VTC), scr); continue; } r -= PR_VT1;
        if (r < PR_VT2) { if (sel & 4) prep_vt_item(A, l, 2, r, lane, U, (bf16*)(ws + WS_VTC), scr); continue; } r -= PR_VT2;
        if (sel & 8) prep_cachek_batch(A, l, r, lane, KB, kmax);
    }
}
#define WG_BAR() do { asm volatile("s_waitcnt vmcnt(0) lgkmcnt(0)" ::: "memory"); __builtin_amdgcn_s_barrier(); asm volatile("" ::: "memory"); } while (0)
__device__ __forceinline__ void lds_fadd(LAS float* p, float v) { (void)__hip_atomic_fetch_add(p, v, __ATOMIC_RELAXED, __HIP_MEMORY_SCOPE_WORKGROUP); }
#define ATT_LOADK(dst, kp_) do { _Pragma("unroll") for (int ds_ = 0; ds_ < 4; ++ds_) dst[ds_] = *(const GAS bf16x8*)((kp_) + ds_ * 512); } while (0)
#define ATT_LOADV(dst, vp_) do { _Pragma("unroll") for (int i_ = 0; i_ < 8; ++i_) dst[i_] = *(const GAS bf16x8*)((vp_) + i_ * 512); } while (0)
#define ATT_QK(kf_) f32x16 S_; do { _Pragma("unroll") for (int r_ = 0; r_ < 16; ++r_) S_[r_] = nm; \
        _Pragma("unroll") for (int ds_ = 0; ds_ < 4; ++ds_) S_ = __builtin_amdgcn_mfma_f32_32x32x16_bf16(kf_[ds_], qf[ds_], S_, 0, 0, 0); } while (0)
#define ATT_PV(vf_) do { bf16x8 pa_[2]; \
        _Pragma("unroll") for (int s2_ = 0; s2_ < 2; ++s2_) { unsigned w_[4]; \
            _Pragma("unroll") for (int i_ = 0; i_ < 4; ++i_) { const float a_ = __builtin_amdgcn_exp2f(S_[8 * s2_ + 2 * i_]), b_ = __builtin_amdgcn_exp2f(S_[8 * s2_ + 2 * i_ + 1]); lsum += a_ + b_; w_[i_] = pk2(a_, b_); } \
            pa_[s2_] = __builtin_bit_cast(bf16x8, (v4u){w_[0], w_[1], w_[2], w_[3]}); } \
        _Pragma("unroll") for (int s2_ = 0; s2_ < 2; ++s2_) _Pragma("unroll") for (int d_ = 0; d_ < 4; ++d_) O[d_] = __builtin_amdgcn_mfma_f32_32x32x16_bf16(pa_[s2_], vf_[s2_ * 4 + d_], O[d_], 0, 0, 0); } while (0)
constexpr int LX_OFF = RING_BYTES + 1024;
__device__ __forceinline__ void attn_unit(const KArgs& A, int l, int seq, int h, int qb, LAS unsigned char* lds, int tid, int wave, int lane) {
    asm volatile("" : "+v"(tid), "+v"(lane));
    unsigned char* ws = A.ws; asm volatile("" : "+s"(ws));
    const bf16* QF = (const bf16*)(ws + WS_QB); const bf16* KF = (const bf16*)(ws + WS_KB); const bf16* VF = (const bf16*)(ws + WS_VTC); const float* QN = (const float*)(ws + WS_QN);
    const unsigned* kmax = (const unsigned*)(ws + WS_CTL) + CW_KMAX + l * NSEQ * 8;
    const bool lat = seq >= 32;
    const int qrow0 = lat ? M_CTX + (seq - 32) * 1024 + qb * 64 : seq * 256 + qb * 64;
    const int qs = wave & 1, ks = wave >> 1, r32 = lane & 31, hi = lane >> 5;
    const int nt = lat ? 10 : 2;
    const int qrow = qrow0 + qs * 32 + r32;
    LAS float* PO = (LAS float*)lds + wave * 4096;
    LAS float* PL = (LAS float*)(lds + LX_OFF);
    float acc[16];
#pragma unroll
    for (int i = 0; i < 16; ++i) acc[i] = 0.f;
    const float lam = ((const float*)(ws + WS_SCAL))[l];
#pragma unroll 1
    for (int c = 0; c < 2; ++c) {
        const size_t qchunk = lat ? 2048 + (size_t)((seq - 32) * 8 + h * 2 + c) * 32 + (qb * 2 + qs) : (size_t)(seq * 8 + h * 2 + c) * 8 + (qb * 2 + qs);
        const size_t kchunk = lat ? 2048 + (size_t)((seq - 32) * 8 + h * 2 + c) * 40 + ks * nt : (size_t)(seq * 8 + h * 2 + c) * 8 + ks * nt;
        const size_t vchunk = lat ? 1024 + (size_t)((seq - 32) * 4 + h) * 40 + ks * nt : (size_t)(seq * 4 + h) * 8 + ks * nt;
        const bf16* kp = KF + kchunk * 2048 + lane * 8; const bf16* vp = VF + vchunk * 4096 + lane * 8;
        bf16x8 qf[4], kf[4], vf[8];
        ATT_LOADK(qf, QF + qchunk * 2048 + lane * 8);
        ATT_LOADK(kf, kp); ATT_LOADV(vf, vp);
        const float nm = -QN[(size_t)qrow * 8 + h * 2 + c] * __builtin_bit_cast(float, kmax[seq * 8 + h * 2 + c]);
        f32x16 O[4];
#pragma unroll
        for (int d = 0; d < 4; ++d) O[d] = (f32x16){};
        float lsum = 0.f;
#pragma unroll 1
        for (int t = 0; t < nt; ++t) {
            ATT_QK(kf);
            __builtin_amdgcn_sched_barrier(0);
            if (t + 1 < nt) ATT_LOADK(kf, kp + (size_t)(t + 1) * 2048);
            ATT_PV(vf);
            __builtin_amdgcn_sched_barrier(0);
            if (t + 1 < nt) ATT_LOADV(vf, vp + (size_t)(t + 1) * 4096);
        }
        lsum += __shfl_xor(lsum, 32);
        if (hi == 0) PL[wave * 32 + r32] = lsum;
#pragma unroll
        for (int d = 0; d < 4; ++d)
#pragma unroll
            for (int r = 0; r < 16; ++r) { const int row = crow(r, hi); PO[row * 128 + ((d * 32 + r32) ^ ((row & 1) << 5))] = O[d][r]; }
        WG_BAR();
        {
            const int row = tid >> 3, a = tid & 7, q2 = row >> 5, r5 = row & 31;
            const float lt = (PL[(0 + q2) * 32 + r5] + PL[(2 + q2) * 32 + r5]) + (PL[(4 + q2) * 32 + r5] + PL[(6 + q2) * 32 + r5]);
            const float sc = c == 0 ? 1.0f / lt : -lam / lt;
#pragma unroll
            for (int i = 0; i < 4; ++i) { const int col = (32 * i + 4 * a) ^ ((r5 & 1) << 5);
                f32x4 v = *(const LAS f32x4*)((LAS float*)lds + (0 + q2) * 4096 + r5 * 128 + col);
                v += *(const LAS f32x4*)((LAS float*)lds + (2 + q2) * 4096 + r5 * 128 + col);
                v += *(const LAS f32x4*)((LAS float*)lds + (4 + q2) * 4096 + r5 * 128 + col);
                v += *(const LAS f32x4*)((LAS float*)lds + (6 + q2) * 4096 + r5 * 128 + col);
#pragma unroll
                for (int e = 0; e < 4; ++e) acc[4 * i + e] += v[e] * sc; }
        }
        WG_BAR();
    }
    {
        const int row = tid >> 3, a = tid & 7;
        const float lam_init = 0.8f - 0.6f * expf(-0.3f * (float)l);
        float ss = 0.f;
#pragma unroll
        for (int i = 0; i < 16; ++i) ss += acc[i] * acc[i];
#pragma unroll
        for (int of = 1; of < 8; of <<= 1) ss += __shfl_xor(ss, of);
        const float sc = (1.0f - lam_init) / sqrtf(ss * (1.0f / 128.0f) + EPS);
        const float* g = A.in[I_AOG] + l * 128 + 4 * a;
        bf16* mp = (bf16*)(ws + WS_MIX) + (size_t)(qrow0 + row) * DM + 512 + h * 128 + 4 * a;
#pragma unroll
        for (int i = 0; i < 4; ++i) { const f32x4 gv = *(const f32x4*)(g + 32 * i);
            *(GAS u32x2*)(mp + 32 * i) = (u32x2){pk2(acc[4 * i] * sc * gv[0], acc[4 * i + 1] * sc * gv[1]), pk2(acc[4 * i + 2] * sc * gv[2], acc[4 * i + 3] * sc * gv[3])}; }
    }
}
__device__ __forceinline__ void fourier_unit(const KArgs& A, int seq, int g, int rb, LAS unsigned char* lds, int tid, int wave, int lane) {
    asm volatile("" : "+v"(tid), "+v"(lane));
    unsigned char* ws = A.ws; asm volatile("" : "+s"(ws));
    const bool lat = seq >= 32; const int L = lat ? 1024 : 256, nks = L >> 4;
    const bf16* TW = lat ? (const bf16*)(ws + WS_TW1024) : (const bf16*)(ws + WS_TW256);
    const bf16* Y = lat ? (const bf16*)(ws + WS_YTL) + (size_t)(((seq - 32) * 4 + g) * 128) * 1024 : (const bf16*)(ws + WS_YTC) + (size_t)((seq * 4 + g) * 128) * 256;
    const int row0 = (lat ? M_CTX + (seq - 32) * 1024 : seq * 256) + rb * 128;
    const int rt = wave & 3, kh = wave >> 2, r32 = lane & 31, hi = lane >> 5;
    const bf16* ap = TW + ((size_t)((rb * 4 + rt) * 2 + kh) * nks) * 512 + lane * 8;
    const bf16* bp0 = Y + ((size_t)(kh * 2 + 0) * nks) * 512 + lane * 8;
    const bf16* bp1 = Y + ((size_t)(kh * 2 + 1) * nks) * 512 + lane * 8;
    f32x16 acc0 = {}, acc1 = {};
#pragma unroll 4
    for (int ks = 0; ks < nks; ++ks) { const bf16x8 a = *(const GAS bf16x8*)(ap + (size_t)ks * 512), b0 = *(const GAS bf16x8*)(bp0 + (size_t)ks * 512), b1 = *(const GAS bf16x8*)(bp1 + (size_t)ks * 512);
        acc0 = __builtin_amdgcn_mfma_f32_32x32x16_bf16(a, b0, acc0, 0, 0, 0); acc1 = __builtin_amdgcn_mfma_f32_32x32x16_bf16(a, b1, acc1, 0, 0, 0); }
    LAS float* C = (LAS float*)lds + rt * 2048;
    if (kh == 1) {
#pragma unroll
        for (int r = 0; r < 16; ++r) { C[crow(r, hi) * 64 + r32] = acc0[r]; C[crow(r, hi) * 64 + 32 + r32] = acc1[r]; } }
    WG_BAR();
    if (kh == 0) { const float s = lat ? (1.0f / 256.0f) : (1.0f / 128.0f);
        bf16* mp = (bf16*)(ws + WS_MIX) + (size_t)(row0 + rt * 32) * DM + 256 + g * 64 + r32;
#pragma unroll
        for (int r = 0; r < 16; ++r) { const int row = crow(r, hi);
            mp[(size_t)row * DM] = (bf16)f2bf((acc0[r] + C[row * 64 + r32]) * s); mp[(size_t)row * DM + 32] = (bf16)f2bf((acc1[r] + C[row * 64 + 32 + r32]) * s); } }
    WG_BAR();
}
template <int HALF> __device__ __forceinline__ void pool_item_g(const KArgs& A, int l, int chunk, int g, int lane, unsigned char* ws) {
    const bf16* U = (const bf16*)(ws + WS_U);
    const int row0 = chunk * 64;
    int sstart, L; if (row0 < M_CTX) { sstart = row0 & ~255; L = 256; } else { sstart = M_CTX + ((row0 - M_CTX) & ~1023); L = 1024; }
    const int sub = lane >> 4, c4 = (lane & 15) * 4, p0 = row0 - sstart + 16 * sub;
    constexpr int NR = 16 + 2 * HALF;
    f32x4 z[NR];
#pragma unroll
    for (int i = 0; i < NR; ++i) { const int pos = p0 - HALF + i; u32x2 w = {0u, 0u};
        if (pos >= 0 && pos < L) w = *(const GAS u32x2*)(U + (size_t)(sstart + pos) * NIN + g * 64 + c4);
        z[i] = (f32x4){bf2f(w.x & 0xffffu), bf2f(w.x >> 16), bf2f(w.y & 0xffffu), bf2f(w.y >> 16)}; }
    const f32x4 sc = *(const f32x4*)(A.in[I_POOLS] + l * 256 + g * 64 + c4);
    f32x4 run = {0.f, 0.f, 0.f, 0.f};
#pragma unroll
    for (int i = 0; i < 2 * HALF; ++i) run += z[i];
    bf16* mp = (bf16*)(ws + WS_MIX) + (size_t)(sstart + p0) * DM + g * 64 + c4;
#pragma unroll
    for (int t = 0; t < 16; ++t) { const int pos = p0 + t; const int cnt = min(pos + HALF, L) - max(pos - HALF, 0);
        const f32x4 y = (run * (1.0f / (float)cnt) - z[t + HALF]) * sc;
        *(GAS u32x2*)(mp + (size_t)t * DM) = (u32x2){pk2(y.x, y.y), pk2(y.z, y.w)};
        if (t < 15) run += z[t + 2 * HALF] - z[t]; }
}
__device__ __forceinline__ void pool_item(const KArgs& A, int l, int item, int lane) {
    asm volatile("" : "+v"(lane));
    unsigned char* ws = A.ws; asm volatile("" : "+s"(ws));
    const int g = item & 3, chunk = item >> 2;
    if (g == 0) pool_item_g<1>(A, l, chunk, 0, lane, ws); else if (g == 1) pool_item_g<2>(A, l, chunk, 1, lane, ws);
    else if (g == 2) pool_item_g<4>(A, l, chunk, 2, lane, ws); else pool_item_g<8>(A, l, chunk, 3, lane, ws);
}
constexpr int MX_LATT = 2 * 4 * 16, MX_CATT = 32 * 4 * 4, MX_LFOU = 2 * 4 * 8, MX_CFOU = 32 * 4 * 2, MX_POOL = (M_TOK / 64) * 4;
__device__ __forceinline__ void mix_phase(const KArgs& A, int l, LAS unsigned char* lds, int vcu, int G, int tid, int wave, int lane, int sel = 31) {
    if (sel & 5) {
#pragma unroll 1
        for (int it = vcu; it < MX_LATT + MX_CATT; it += G) {
            const bool isl = it < MX_LATT; const int r = it - MX_LATT;
            const int seq = isl ? 32 + (it >> 6) : r >> 4, hh = isl ? (it >> 4) & 3 : (r >> 2) & 3, qb = isl ? it & 15 : r & 3;
            if (sel & (isl ? 1 : 4)) attn_unit(A, l, seq, hh, qb, lds, tid, wave, lane);
        }
    }
    constexpr int O1 = MX_LATT + MX_CATT;
    if (sel & 10) {
#pragma unroll 1
        for (int it = ((vcu - O1) % G + G) % G; it < MX_LFOU + MX_CFOU; it += G) {
            const bool isl = it < MX_LFOU; const int r = it - MX_LFOU;
            const int seq = isl ? 32 + (it >> 5) : r >> 3, gg = isl ? (it >> 3) & 3 : (r >> 1) & 3, rb = isl ? it & 7 : r & 1;
            if (sel & (isl ? 2 : 8)) fourier_unit(A, seq, gg, rb, lds, tid, wave, lane);
        }
    }
    constexpr int O2 = O1 + MX_LFOU + MX_CFOU;
    if (sel & 16) {
        const int gw2 = (((vcu - O2) % G + G) % G) * NWAVES + wave;
#pragma unroll 1
        for (int it = gw2; it < MX_POOL; it += G * NWAVES) pool_item(A, l, it, lane);
    }
}
#define CAS __attribute__((address_space(4)))
#ifndef PROBE_KIND
#define PROBE_KIND -1
#endif
#ifndef PROBE_SEL
#define PROBE_SEL 31
#endif
#ifndef PROBE_N
#define PROBE_N 1
#endif
constexpr bool probe_match(int P, int kind) {
    if (kind < 0) return false;
    if (kind == 7) return P < NPHASES - 1;
    if (P == 0) return kind == 0;
    const int l = (P - 1) / 11, k = (P - 1) % 11;
    if (kind == 1) return k == 0 || k == 3 || k == 8;
    if (kind == 2) return k == 1 || k == 9;
    if (kind == 3) return k == 2 && l == 0;
    if (kind == 4) return k == 4;
    if (kind == 5) return k == 5;
    if (kind == 6) return k == 6;
    return false;
}
template <int PH> __device__ __forceinline__ void run_phase(const bool DUP, const KArgs& A, LAS unsigned char* lds, int tid, int lane, int wave, int G, int bx, int vcu, int gw, int NGW) {
    unsigned char* ws = A.ws;
    float* X = A.out;
    const float* mods = (const float*)(ws + WS_CTL) + CW_MODS;
    bf16* XN = (bf16*)(ws + WS_XN); bf16* GBUF = (bf16*)(ws + WS_GB); bf16* UB = (bf16*)(ws + WS_U); bf16* MIXB = (bf16*)(ws + WS_MIX);
    if constexpr (PH == 0) {
#ifndef SKIP_P0
        p0_items(A, lds, 0, gw, NGW, wave, lane, DUP);
#endif
    } else {
        constexpr int l = (PH - 1) / 11, k = (PH - 1) % 11;
        const float* mods_l = mods + (size_t)l * 3 * 9216;
        unsigned char* wl = ws + WS_W + (size_t)l * SZ_WLAYER;
        const float* ng = A.in[I_NG] + (size_t)l * 3 * DM;
        if constexpr (k == 0) { if (l == 0) norm_phase(A.in[I_XP], A.in[I_XS], XN, ng, mods_l, 0, gw, NGW, lane); else norm_phase(X, X + OUT_YS, XN, ng, mods_l, 0, gw, NGW, lane); }
        else if constexpr (k == 3) norm_phase(X, X + OUT_YS, XN, ng + DM, mods_l, 1, gw, NGW, lane);
        else if constexpr (k == 8) norm_phase(X, X + OUT_YS, XN, ng + 2 * DM, mods_l, 2, gw, NGW, lane);
        else if constexpr (k == 1 || k == 9) {
            pg8::Gemm g{XN, (const bf16*)(wl + (k == 1 ? OFF_WI1 : OFF_WI2)), M_TOK, NWI, DM}; pg8::StaticOrder S; S.init(M_TOK, NWI, G, bx);
            pg8::EpiSwiglu E{GBUF, FF};
            pg8::gemm_phase<pg8::EpiSwiglu, pg8::StaticOrder, true, true>(lds, g, S, E);
            if constexpr (l == 0) {
                constexpr int nfull = (M_TOK / 256) * (NWI / 256) % 256;
                if (!DUP && G == 256 && bx >= nfull) p0_items(A, lds, k == 1 ? 1 : 2, (bx - nfull) * NWAVES + wave, (256 - nfull) * NWAVES, wave, lane);
                else if (!DUP && G != 256) p0_items(A, lds, k == 1 ? 1 : 2, gw, NGW, wave, lane);
            }
        } else if constexpr (k == 2 || k == 10) {
            pg8::Gemm g{GBUF, (const bf16*)(wl + (k == 2 ? OFF_WO1 : OFF_WO2)), M_TOK, DM, FF}; pg8::StaticOrder S; S.init(M_TOK, DM, G, bx, 160);
            constexpr bool first = (k == 2 && l == 0);
            pg8::EpiResGate<1> E{first ? A.in[I_XP] : X, first ? A.in[I_XS] : X + OUT_YS, X, mods_l, k == 2 ? 2 : 8, 0.5f};
            pg8::gemm_phase<pg8::EpiResGate<1>, pg8::StaticOrder, true, true, 1>(lds, g, S, E);
        } else if constexpr (k == 4) {
            pg8::Gemm g{XN, (const bf16*)(wl + OFF_WIN), M_TOK, NIN, DM}; pg8::StaticOrder S; S.init(M_TOK, NIN, G, bx, 160);
            pg8::EpiU<1> E{UB, A.out + OUT_V, l};
            pg8::gemm_phase<pg8::EpiU<1>, pg8::StaticOrder, true, true, 1>(lds, g, S, E);
        } else if constexpr (k == 5) {
#ifndef SKIP_PREP
            prep_phase(A, l, lds, gw, NGW, wave, lane, DUP ? PROBE_SEL : 15);
#endif
        } else if constexpr (k == 6) {
#ifndef SKIP_MIX
            mix_phase(A, l, lds, vcu, G, tid, wave, lane, DUP ? PROBE_SEL : 31);
#endif
        } else if constexpr (k == 7) {
            pg8::Gemm g{MIXB, (const bf16*)(wl + OFF_WOUT), M_TOK, DM, DM}; pg8::StaticOrder S; S.init(M_TOK, DM, G, bx, 160);
            pg8::EpiResGate<1> E{X, X + OUT_YS, X, mods_l, 5, 1.0f};
            pg8::gemm_phase<pg8::EpiResGate<1>, pg8::StaticOrder, true, true, 1>(lds, g, S, E);
        }
    }
}
__global__ void __launch_bounds__(NWAVES * 64, 2) hyb_fwd(KArgs A) {
    extern __shared__ __attribute__((aligned(16))) unsigned char lds_raw[];
    LAS unsigned char* lds = (LAS unsigned char*)lds_raw;
    volatile LAS unsigned* MISC = (volatile LAS unsigned*)(lds + MISC_OFF);
    const int tid = threadIdx.x, lane = tid & 63, wave = __builtin_amdgcn_readfirstlane(tid >> 6);
    const int G = gridDim.x, bx = blockIdx.x, vcu = (G % 8 == 0) ? (bx % 8) * (G / 8) + bx / 8 : bx;
    const int gw = vcu * NWAVES + wave, NGW = G * NWAVES;
    gu32* ctl = (gu32*)(A.ws + WS_CTL);
    for (int u = tid; u < (LDS_BYTES - LDSCTL_OFF) / 4; u += NWAVES * 64) ((LAS unsigned*)(lds + LDSCTL_OFF))[u] = 0u;
    __syncthreads();
    const int lo = A.ph_lo, hi = A.ph_hi;
    XcdBarrier bar; bar.bar = (unsigned*)(ctl + CW_BAR); bar.x = 0; bar.st = nullptr;
    if (hi - lo > 1) bar = xcd_barrier_post((unsigned*)(ctl + CW_BAR), MISC + 8);
#define PHASE(P) if (lo <= (P) && (P) < hi) { _Pragma("unroll 1") for (int rep_ = 0; rep_ < (probe_match(P, PROBE_KIND) ? 1 + PROBE_N : 1); ++rep_) { \
        if (PROBE_KIND != 7 || rep_ == 0) run_phase<P>(rep_ > 0, A, lds, tid, lane, wave, G, bx, vcu, gw, NGW); if ((P) + 1 < hi || rep_ + 1 < (probe_match(P, PROBE_KIND) ? 1 + PROBE_N : 1)) xcd_barrier(bar); } }
    PHASE(0) PHASE(1) PHASE(2) PHASE(3) PHASE(4) PHASE(5) PHASE(6) PHASE(7) PHASE(8) PHASE(9) PHASE(10) PHASE(11)
    PHASE(12) PHASE(13) PHASE(14) PHASE(15) PHASE(16) PHASE(17) PHASE(18) PHASE(19) PHASE(20) PHASE(21) PHASE(22)
#undef PHASE
}

#ifndef N_LAUNCH_MODE
#define N_LAUNCH_MODE 1
#endif
extern "C" void kernel_launch(void* const* d_in, const int* in_sizes, int n_in, void* d_out, int out_size, void* d_ws, size_t ws_size, hipStream_t stream) {
    static int grid = 0;
    if (grid == 0) {
        if (n_in != 25 || ws_size < WS_END) { fprintf(stderr, "kernel_launch: unexpected n_in %d / ws %zu\n", n_in, ws_size); grid = -1; return; }
        int dev = 0, cus = 0, per_cu = 0;
        if (hipGetDevice(&dev) != hipSuccess || hipDeviceGetAttribute(&cus, hipDeviceAttributeMultiprocessorCount, dev) != hipSuccess) { grid = -1; return; }
        if (hipFuncSetAttribute((const void*)hyb_fwd, hipFuncAttributeMaxDynamicSharedMemorySize, LDS_BYTES) != hipSuccess) { fprintf(stderr, "kernel_launch: hipFuncSetAttribute failed\n"); grid = -1; return; }
        if (hipOccupancyMaxActiveBlocksPerMultiprocessor(&per_cu, (const void*)hyb_fwd, NWAVES * 64, LDS_BYTES) != hipSuccess || per_cu < 1) { fprintf(stderr, "kernel_launch: occupancy query says %d blocks per CU\n", per_cu); }
        (void)hipGetLastError();
        grid = cus;
    }
    if (grid < 0) return;
    if (hipMemsetAsync((char*)d_ws + WS_CTL, 0, CTL_ZERO_BYTES, stream) != hipSuccess) return;
    KArgs a{};
    for (int i = 0; i < 25; ++i) a.in[i] = (const float*)d_in[i];
    a.out = (float*)d_out; a.ws = (unsigned char*)d_ws;
#if N_LAUNCH_MODE == 0
    for (int p = 0; p < NPHASES; ++p) { a.ph_lo = p; a.ph_hi = p + 1; hipLaunchKernelGGL(hyb_fwd, dim3(grid), dim3(NWAVES * 64), LDS_BYTES, stream, a); }
#else
    a.ph_lo = 0; a.ph_hi = NPHASES; hipLaunchKernelGGL(hyb_fwd, dim3(grid), dim3(NWAVES * 64), LDS_BYTES, stream, a);
#endif
}
```
